# Optimizing an MI355X kernel written in HIP

```python
import jax
import jax.numpy as jnp
from jax import lax
import numpy as np

D_MODEL = 1024
BATCH = 16
SEQ = 4096
DEPTH = 2

GRID_W = 64
CTX_LEN = 256
HEAD_DIM = 64
ROPE_THETA = 10000.0
A_HEADS = 8
A_KV_HEADS = 2
Q_BLOCK = 128
NA_HEADS = 8
NA_WIN_R = 8
NA_WIN_C = 16
ML_HEADS = 4
ML_HEAD_DIM = 128
ML_CHUNK = 64
N_BRANCH = 3
BRANCH_W = 512
N_GROUPS = 4
EXPERTS_PER_GROUP = 8
N_EXPERTS = N_GROUPS * EXPERTS_PER_GROUP
TOP_K = 2
D_EXPERT = 256
EPS = 1e-6
NEG_INF = -1e30
IN_SPLITS = (
    A_HEADS * HEAD_DIM, A_KV_HEADS * HEAD_DIM, A_KV_HEADS * HEAD_DIM,
    NA_HEADS * HEAD_DIM, NA_HEADS * HEAD_DIM, NA_HEADS * HEAD_DIM,
    ML_HEADS * ML_HEAD_DIM, ML_HEADS * ML_HEAD_DIM, ML_HEADS * ML_HEAD_DIM, ML_HEADS * ML_HEAD_DIM,
    2 * 2 * ML_HEADS,
    N_BRANCH * D_MODEL,
)
IN_WIDTH = sum(IN_SPLITS)

kernel_name = 'hybrid_gqa_natten_mlstm_hmoe_dit'


def rms_norm(x, gain):
    x32 = x.astype(jnp.float32)
    y = x32 * lax.rsqrt(jnp.mean(x32 * x32, axis=-1, keepdims=True) + EPS)
    return (y * gain.astype(jnp.float32)).astype(x.dtype)


def modulate(h, shift, scale):
    return h * (1 + scale) + shift


def split_cols(p):
    out, start = [], 0
    for w in IN_SPLITS:
        out.append(p[..., start:start + w])
        start += w
    return out


def to_heads(a, n_heads, head_dim):
    return a.reshape(a.shape[:2] + (n_heads, head_dim))


def axial_rope(n_tok, dtype):
    t = jnp.arange(n_tok)
    row = (t // GRID_W).astype(jnp.float32)
    col = (t % GRID_W).astype(jnp.float32)
    n_freq = HEAD_DIM // 4
    inv = ROPE_THETA ** (-jnp.arange(n_freq, dtype=jnp.float32) / n_freq)
    ang = jnp.concatenate([row[:, None] * inv, col[:, None] * inv], axis=-1)
    return jnp.cos(ang).astype(dtype), jnp.sin(ang).astype(dtype)


def apply_rope(x, cos, sin):
    half = x.shape[-1] // 2
    x1, x2 = x[..., :half], x[..., half:]
    cs, sn = cos[None, :, None, :], sin[None, :, None, :]
    return jnp.concatenate([x1 * cs - x2 * sn, x2 * cs + x1 * sn], axis=-1)


def gqa_attend(q, k, v):
    s = jnp.einsum('bqkgd,bskd->bkgqs', q, k).astype(jnp.float32) * HEAD_DIM ** -0.5
    p = jax.nn.softmax(s, axis=-1).astype(v.dtype)
    return jnp.einsum('bkgqs,bskd->bqkgd', p, v)


def gqa_branch(q, k, v, q_c, k_c, v_c, need_ctx):
    bsz, n_tok = q.shape[:2]
    grp = A_HEADS // A_KV_HEADS
    kk = jnp.concatenate([k, k_c], axis=1)
    vv = jnp.concatenate([v, v_c], axis=1)
    nb = n_tok // Q_BLOCK
    qb = q.reshape(bsz, nb, Q_BLOCK, A_KV_HEADS, grp, HEAD_DIM).swapaxes(0, 1)
    o = lax.map(lambda qq: gqa_attend(qq, kk, vv), qb)
    y = o.swapaxes(0, 1).reshape(bsz, n_tok, A_HEADS * HEAD_DIM)
    yc = None
    if need_ctx:
        n_ctx = q_c.shape[1]
        yc = gqa_attend(q_c.reshape(bsz, n_ctx, A_KV_HEADS, grp, HEAD_DIM), k_c, v_c)
        yc = yc.reshape(bsz, n_ctx, A_HEADS * HEAD_DIM)
    return y, yc


def na_branch(q, k, v, q_c, k_c, v_c, rpb, rows, need_ctx):
    bsz = q.shape[0]
    win_r = min(NA_WIN_R, rows)
    qg = q.reshape(bsz, rows, GRID_W, NA_HEADS, HEAD_DIM).swapaxes(0, 1)
    kg = k.reshape(bsz, rows, GRID_W, NA_HEADS, HEAD_DIM)
    vg = v.reshape(bsz, rows, GRID_W, NA_HEADS, HEAD_DIM)
    col = jnp.arange(GRID_W)
    col_start = jnp.clip(col - NA_WIN_C // 2, 0, GRID_W - NA_WIN_C)
    col_mask = (col[None, :] >= col_start[:, None]) & (col[None, :] < col_start[:, None] + NA_WIN_C)
    dc_idx = jnp.clip(col[None, :] - col[:, None] + NA_WIN_C - 1, 0, 2 * NA_WIN_C - 2)
    scale = HEAD_DIM ** -0.5

    def row_block(args):
        r, qb = args
        rs = jnp.clip(r - win_r // 2, 0, rows - win_r)
        kb = lax.dynamic_slice_in_dim(kg, rs, win_r, axis=1)
        vb = lax.dynamic_slice_in_dim(vg, rs, win_r, axis=1)
        dr_idx = rs + jnp.arange(win_r) - r + NA_WIN_R - 1
        bias = rpb[:, dr_idx[None, :, None], dc_idx[:, None, :]].astype(jnp.float32)
        s_loc = jnp.einsum('bqhd,bjkhd->bhqjk', qb, kb).astype(jnp.float32) * scale + bias
        s_loc = jnp.where(col_mask[:, None, :], s_loc, NEG_INF)
        s_loc = s_loc.reshape(bsz, NA_HEADS, GRID_W, win_r * GRID_W)
        s_ctx = jnp.einsum('bqhd,bshd->bhqs', qb, k_c).astype(jnp.float32) * scale
        p = jax.nn.softmax(jnp.concatenate([s_loc, s_ctx], axis=-1), axis=-1).astype(v.dtype)
        p_loc = p[..., :win_r * GRID_W].reshape(bsz, NA_HEADS, GRID_W, win_r, GRID_W)
        p_ctx = p[..., win_r * GRID_W:]
        return (jnp.einsum('bhqjk,bjkhd->bqhd', p_loc, vb)
                + jnp.einsum('bhqs,bshd->bqhd', p_ctx, v_c))

    o = lax.map(row_block, (jnp.arange(rows), qg))
    y = o.swapaxes(0, 1).reshape(bsz, rows * GRID_W, NA_HEADS * HEAD_DIM)
    yc = None
    if need_ctx:
        n_ctx = q_c.shape[1]
        yc = gqa_attend(q_c[:, :, :, None, :], k_c, v_c).reshape(bsz, n_ctx, NA_HEADS * HEAD_DIM)
    return y, yc


def mlstm_chunk_step(carry, xs):
    c_mat, n_vec, m = carry
    q, k, v, ig, lf = xs
    lc = q.shape[2]
    lower = jnp.tril(jnp.ones((lc, lc), dtype=bool))
    b = jnp.cumsum(lf, axis=-1)
    a = b + m[..., None]
    dmat = jnp.where(lower, b[..., :, None] - b[..., None, :] + ig[..., None, :], NEG_INF)
    m_t = jnp.maximum(a, dmat.max(axis=-1))
    w_inter = jnp.exp(a - m_t)
    s = jnp.einsum('bhtd,bhsd->bhts', q, k) * jnp.exp(dmat - m_t[..., None])
    num = w_inter[..., None] * jnp.einsum('bhtd,bhde->bhte', q, c_mat) + jnp.einsum('bhts,bhse->bhte', s, v)
    den = w_inter * jnp.einsum('bhtd,bhd->bht', q, n_vec) + s.sum(axis=-1)
    h = num / jnp.maximum(jnp.abs(den), jnp.exp(-m_t))[..., None]
    b_end = b[..., -1]
    log_w = b_end[..., None] - b + ig
    m_new = jnp.maximum(b_end + m, log_w.max(axis=-1))
    g_inter = jnp.exp(b_end + m - m_new)
    g_s = jnp.exp(log_w - m_new[..., None])
    kg = k * g_s[..., None]
    c_new = g_inter[..., None, None] * c_mat + jnp.einsum('bhsd,bhse->bhde', kg, v)
    n_new = g_inter[..., None] * n_vec + kg.sum(axis=2)
    return (c_new, n_new, m_new), h


def mlstm_scan(q, k, v, ig, lf, state):
    bsz, n_tok, nh, hd = q.shape
    nc = n_tok // ML_CHUNK
    chunks = lambda a: a.reshape(bsz, nc, ML_CHUNK, nh, hd).transpose(1, 0, 3, 2, 4)
    gchunks = lambda a: a.reshape(bsz, nc, ML_CHUNK, nh).transpose(1, 0, 3, 2)
    state, h = lax.scan(mlstm_chunk_step, state, (chunks(q), chunks(k), chunks(v), gchunks(ig), gchunks(lf)))
    return h.transpose(1, 0, 3, 2, 4).reshape(bsz, n_tok, nh, hd), state


def maybe_flip(a, direction):
    return jnp.flip(a, axis=1) if direction == 1 else a


def mlstm_branch(q, k, v, o, pre, q_c, k_c, v_c, o_c, pre_c, g_ml, need_ctx):
    dt = q.dtype
    bsz = q.shape[0]
    f32 = jnp.float32
    qs, vs, ks = q.astype(f32), v.astype(f32), k.astype(f32) * ML_HEAD_DIM ** -0.5
    qcs, vcs, kcs = q_c.astype(f32), v_c.astype(f32), k_c.astype(f32) * ML_HEAD_DIM ** -0.5
    ig, lf = pre[:, :, :, 0, :], jax.nn.log_sigmoid(pre[:, :, :, 1, :])
    ig_c, lf_c = pre_c[:, :, :, 0, :], jax.nn.log_sigmoid(pre_c[:, :, :, 1, :])
    state0 = (jnp.zeros((bsz, ML_HEADS, ML_HEAD_DIM, ML_HEAD_DIM), f32),
              jnp.zeros((bsz, ML_HEADS, ML_HEAD_DIM), f32),
              jnp.zeros((bsz, ML_HEADS), f32))
    h_lat = jnp.zeros(qs.shape, f32)
    h_ctx = jnp.zeros(qcs.shape, f32)
    for d in range(2):
        hc_d, st = mlstm_scan(maybe_flip(qcs, d), maybe_flip(kcs, d), maybe_flip(vcs, d),
                              maybe_flip(ig_c[:, :, d], d), maybe_flip(lf_c[:, :, d], d), state0)
        hl_d, _ = mlstm_scan(maybe_flip(qs, d), maybe_flip(ks, d), maybe_flip(vs, d),
                             maybe_flip(ig[:, :, d], d), maybe_flip(lf[:, :, d], d), st)
        h_lat = h_lat + maybe_flip(hl_d, d)
        h_ctx = h_ctx + maybe_flip(hc_d, d)
    gain = g_ml.reshape(ML_HEADS, ML_HEAD_DIM)

    def finish(hsum, og):
        hn = rms_norm(hsum, gain).astype(dt)
        out = hn * jax.nn.sigmoid(og).reshape(hn.shape)
        return out.reshape(hn.shape[0], hn.shape[1], ML_HEADS * ML_HEAD_DIM)

    y = finish(h_lat, o)
    yc = finish(h_ctx, o_c) if need_ctx else None
    return y, yc


def token_mixers(h, hc, w_in, b_merge, g_qk, rpb, b_mlstm, g_ml, w_branch, w_out, rows, cos, sin, need_ctx):
    bsz, n_tok, _ = h.shape
    n_ctx = hc.shape[1]
    pl = split_cols(h @ w_in)
    pc = split_cols(hc @ w_in)
    qa = apply_rope(rms_norm(to_heads(pl[0], A_HEADS, HEAD_DIM), g_qk[0]), cos, sin)
    ka = apply_rope(rms_norm(to_heads(pl[1], A_KV_HEADS, HEAD_DIM), g_qk[1]), cos, sin)
    va = to_heads(pl[2], A_KV_HEADS, HEAD_DIM)
    qa_c = rms_norm(to_heads(pc[0], A_HEADS, HEAD_DIM), g_qk[0])
    ka_c = rms_norm(to_heads(pc[1], A_KV_HEADS, HEAD_DIM), g_qk[1])
    va_c = to_heads(pc[2], A_KV_HEADS, HEAD_DIM)
    ya, ya_c = gqa_branch(qa, ka, va, qa_c, ka_c, va_c, need_ctx)
    qb = rms_norm(to_heads(pl[3], NA_HEADS, HEAD_DIM), g_qk[2])
    kb = rms_norm(to_heads(pl[4], NA_HEADS, HEAD_DIM), g_qk[3])
    vb = to_heads(pl[5], NA_HEADS, HEAD_DIM)
    qb_c = rms_norm(to_heads(pc[3], NA_HEADS, HEAD_DIM), g_qk[2])
    kb_c = rms_norm(to_heads(pc[4], NA_HEADS, HEAD_DIM), g_qk[3])
    vb_c = to_heads(pc[5], NA_HEADS, HEAD_DIM)
    yb, yb_c = na_branch(qb, kb, vb, qb_c, kb_c, vb_c, rpb, rows, need_ctx)
    pre = (pl[10].reshape(bsz, n_tok, 2, 2, ML_HEADS) + b_mlstm).astype(jnp.float32)
    pre_c = (pc[10].reshape(bsz, n_ctx, 2, 2, ML_HEADS) + b_mlstm).astype(jnp.float32)
    ym, ym_c = mlstm_branch(to_heads(pl[6], ML_HEADS, ML_HEAD_DIM), to_heads(pl[7], ML_HEADS, ML_HEAD_DIM),
                            to_heads(pl[8], ML_HEADS, ML_HEAD_DIM), pl[9], pre,
                            to_heads(pc[6], ML_HEADS, ML_HEAD_DIM), to_heads(pc[7], ML_HEADS, ML_HEAD_DIM),
                            to_heads(pc[8], ML_HEADS, ML_HEAD_DIM), pc[9], pre_c, g_ml, need_ctx)

    def merge(outs, gate_cols, n):
        gates = jax.nn.sigmoid(gate_cols.reshape(bsz, n, N_BRANCH, D_MODEL) + b_merge)
        merged = gates[:, :, 0] * (outs[0] @ w_branch[0])
        for br in range(1, N_BRANCH):
            merged = merged + gates[:, :, br] * (outs[br] @ w_branch[br])
        return merged @ w_out

    y = merge((ya, yb, ym), pl[11], n_tok)
    yc = merge((ya_c, yb_c, ym_c), pc[11], n_ctx) if need_ctx else None
    return y, yc


def hier_moe(h, w_group, b_group, w_router, b_router, w_gate_up, w_down):
    shp = h.shape
    t = h.reshape(-1, D_MODEL)
    lg = (t @ w_group + b_group).astype(jnp.float32)
    pg = jax.nn.softmax(lg, axis=-1)
    gsel = jnp.argmax(lg, axis=-1)
    le = (t @ w_router + b_router).astype(jnp.float32).reshape(-1, N_GROUPS, EXPERTS_PER_GROUP)
    le_sel = jnp.take_along_axis(le, gsel[:, None, None], axis=1)[:, 0]
    pe = jax.nn.softmax(le_sel, axis=-1)
    top_p, top_i = lax.top_k(pe, TOP_K)
    pg_sel = jnp.take_along_axis(pg, gsel[:, None], axis=1)
    wts = pg_sel * top_p / jnp.sum(top_p, axis=-1, keepdims=True)
    eid = gsel[:, None] * EXPERTS_PER_GROUP + top_i
    dense_w = jnp.sum(jax.nn.one_hot(eid, N_EXPERTS, dtype=jnp.float32) * wts[..., None], axis=1).astype(t.dtype)
    out = jnp.zeros_like(t)
    for e in range(N_EXPERTS):
        gu = t @ w_gate_up[e]
        y = (jax.nn.silu(gu[:, :D_EXPERT]) * gu[:, D_EXPERT:]) @ w_down[e]
        out = out + dense_w[:, e:e + 1] * y
    return out.reshape(shp)


def setup_inputs(seed: int = 0) -> dict:
    key = jax.random.key(seed)
    ks = jax.random.split(key, 24)
    f32 = jnp.float32
    nrm = lambda k, shape, s: jax.random.normal(k, shape, f32) * s
    b_ml_i = nrm(ks[11], (DEPTH, 2, ML_HEADS), 0.1)
    b_ml_f = 3.0 + 3.0 * jax.random.uniform(ks[12], (DEPTH, 2, ML_HEADS), f32)
    return {
        'x': nrm(ks[0], (BATCH, SEQ, D_MODEL), 1.0),
        'c': nrm(ks[1], (BATCH, D_MODEL), 1.0),
        'ctx': nrm(ks[2], (BATCH, CTX_LEN, D_MODEL), 1.0),
        'c_ctx': nrm(ks[3], (D_MODEL,), 1.0),
        'w_mod': nrm(ks[4], (DEPTH, D_MODEL, 6 * D_MODEL), 0.5 * D_MODEL ** -0.5),
        'b_mod': nrm(ks[5], (DEPTH, 6 * D_MODEL), 0.02),
        'g_norm': 1.0 + nrm(ks[6], (DEPTH, 2, D_MODEL), 0.02),
        'w_in': nrm(ks[7], (DEPTH, D_MODEL, IN_WIDTH), D_MODEL ** -0.5),
        'b_merge': nrm(ks[8], (DEPTH, N_BRANCH, D_MODEL), 0.02),
        'g_qk': 1.0 + nrm(ks[9], (DEPTH, 4, HEAD_DIM), 0.02),
        'rpb': nrm(ks[10], (DEPTH, NA_HEADS, 2 * NA_WIN_R - 1, 2 * NA_WIN_C - 1), 0.1),
        'b_mlstm': jnp.stack([b_ml_i, b_ml_f], axis=2),
        'g_ml': 1.0 + nrm(ks[13], (DEPTH, ML_HEADS * ML_HEAD_DIM), 0.02),
        'w_branch': nrm(ks[14], (DEPTH, N_BRANCH, BRANCH_W, D_MODEL), BRANCH_W ** -0.5),
        'w_out': nrm(ks[15], (DEPTH, D_MODEL, D_MODEL), D_MODEL ** -0.5),
        'w_group': nrm(ks[16], (DEPTH, D_MODEL, N_GROUPS), D_MODEL ** -0.5),
        'b_group': nrm(ks[17], (DEPTH, N_GROUPS), 0.01),
        'w_router': nrm(ks[18], (DEPTH, D_MODEL, N_EXPERTS), D_MODEL ** -0.5),
        'b_router': nrm(ks[19], (DEPTH, N_EXPERTS), 0.01),
        'w_gate_up': nrm(ks[20], (DEPTH, N_EXPERTS, D_MODEL, 2 * D_EXPERT), D_MODEL ** -0.5),
        'w_down': nrm(ks[21], (DEPTH, N_EXPERTS, D_EXPERT, D_MODEL), D_EXPERT ** -0.5),
    }


def reference(x, c, ctx, c_ctx, w_mod, b_mod, g_norm, w_in, b_merge, g_qk, rpb, b_mlstm, g_ml,
              w_branch, w_out, w_group, b_group, w_router, b_router, w_gate_up, w_down):
    n_tok = x.shape[1]
    rows = n_tok // GRID_W
    cos, sin = axial_rope(n_tok, x.dtype)
    xc = ctx
    for l in range(DEPTH):
        need_ctx = l < DEPTH - 1
        mod = jax.nn.silu(c) @ w_mod[l] + b_mod[l]
        mod_c = jax.nn.silu(c_ctx) @ w_mod[l] + b_mod[l]
        sh1, sc1, gt1, sh2, sc2, gt2 = jnp.split(mod[:, None, :], 6, axis=-1)
        sh1c, sc1c, gt1c, sh2c, sc2c, gt2c = jnp.split(mod_c, 6, axis=-1)
        h = modulate(rms_norm(x, g_norm[l, 0]), sh1, sc1)
        hc = modulate(rms_norm(xc, g_norm[l, 0]), sh1c, sc1c)
        y, yc = token_mixers(h, hc, w_in[l], b_merge[l], g_qk[l], rpb[l], b_mlstm[l], g_ml[l],
                             w_branch[l], w_out[l], rows, cos, sin, need_ctx)
        x = x + gt1 * y
        h = modulate(rms_norm(x, g_norm[l, 1]), sh2, sc2)
        x = x + gt2 * hier_moe(h, w_group[l], b_group[l], w_router[l], b_router[l], w_gate_up[l], w_down[l])
        if need_ctx:
            xc = xc + gt1c * yc
            hc = modulate(rms_norm(xc, g_norm[l, 1]), sh2c, sc2c)
            xc = xc + gt2c * hier_moe(hc, w_group[l], b_group[l], w_router[l], b_router[l], w_gate_up[l], w_down[l])
    return x
```

```cpp
#include <hip/hip_runtime.h>
#include <cstdio>
#include <cstdint>

constexpr int NB = 16, NLAT = 4096, NCTX = 256, TPS = NLAT + NCTX  , DM = 1024, DEPTH = 2;
constexpr int GBS = 8  , NGRP = NB / GBS, TG = GBS * TPS  , RTG = TG / 256  ;
constexpr int PW = 4352;
constexpr int C_AQ = 0, C_AK = 512, C_AV = 640, C_BQ = 768, C_BK = 1280, C_BV = 1792, C_CQ = 2304, C_CK = 2816, C_CV = 3328, C_CO = 3840;
constexpr int INW = 7440, NPADW = 4608;
constexpr int OW = 1536;
constexpr int NEXP = 32, DEXP = 256;
constexpr float EPS = 1e-6f;
constexpr float LOG2E = 1.4426950408889634f;
constexpr float QSCALE = 0.125f * LOG2E;

#define LAS __attribute__((address_space(3)))
typedef unsigned short bf16;
typedef unsigned v4u __attribute__((ext_vector_type(4)));
typedef unsigned v2u __attribute__((ext_vector_type(2)));
typedef float f32x4 __attribute__((ext_vector_type(4)));
typedef float f32x2 __attribute__((ext_vector_type(2)));
typedef short bf16x8 __attribute__((ext_vector_type(8)));
typedef float f32x16 __attribute__((ext_vector_type(16)));

typedef float f32x2_hw __attribute__((ext_vector_type(2))); typedef __bf16 bf16x2_hw __attribute__((ext_vector_type(2)));
__device__ __forceinline__ unsigned pk2(float lo, float hi) { f32x2_hw v = {lo, hi}; bf16x2_hw b = __builtin_convertvector(v, bf16x2_hw); return __builtin_bit_cast(unsigned, b); }
__device__ __forceinline__ unsigned f2bf(float f) { return pk2(f, 0.f) & 0xffffu; }
__device__ __forceinline__ float bf_lo(unsigned w) { return __builtin_bit_cast(float, w << 16); }
__device__ __forceinline__ float bf_hi(unsigned w) { return __builtin_bit_cast(float, w & 0xffff0000u); }
__device__ __forceinline__ float bf2f(bf16 b) { return __builtin_bit_cast(float, ((unsigned)b) << 16); }
template <int CTRL, int ROWMASK> __device__ __forceinline__ float dpp_f(float identity, float x) {
    return __builtin_bit_cast(float, __builtin_amdgcn_update_dpp(__builtin_bit_cast(int, identity), __builtin_bit_cast(int, x), CTRL, ROWMASK, 0xf, false)); }
__device__ __forceinline__ float wave_scan_add(float x) {
    x += dpp_f<0x111, 0xf>(0.f, x); x += dpp_f<0x112, 0xf>(0.f, x); x += dpp_f<0x114, 0xf>(0.f, x); x += dpp_f<0x118, 0xf>(0.f, x);
    x += dpp_f<0x142, 0xa>(0.f, x); x += dpp_f<0x143, 0xc>(0.f, x); return x; }
__device__ __forceinline__ float wave_scan_max(float x) {
    const float ninf = -INFINITY;
    x = fmaxf(x, dpp_f<0x111, 0xf>(ninf, x)); x = fmaxf(x, dpp_f<0x112, 0xf>(ninf, x)); x = fmaxf(x, dpp_f<0x114, 0xf>(ninf, x)); x = fmaxf(x, dpp_f<0x118, 0xf>(ninf, x));
    x = fmaxf(x, dpp_f<0x142, 0xa>(ninf, x)); x = fmaxf(x, dpp_f<0x143, 0xc>(ninf, x)); return x; }
__device__ __forceinline__ float lane63(float x) { return __builtin_bit_cast(float, __builtin_amdgcn_readlane(__builtin_bit_cast(int, x), 63)); }
__device__ __forceinline__ float wave_sum(float v) { return lane63(wave_scan_add(v)); }
__device__ __forceinline__ float row16_sum(float x) {
    x += dpp_f<0xB1, 0xf>(0.f, x); x += dpp_f<0x4E, 0xf>(0.f, x); x += dpp_f<0x141, 0xf>(0.f, x); x += dpp_f<0x140, 0xf>(0.f, x); return x; }
__device__ __forceinline__ float rcp_(float x) { return __builtin_amdgcn_rcpf(x); }
__device__ __forceinline__ float rsq_(float x) { return __builtin_amdgcn_rsqf(x); }
__device__ __forceinline__ float sigmoidf_(float x) { return rcp_(1.0f + __builtin_amdgcn_exp2f(-LOG2E * x)); }
#define SIG(k, x) sigmoidf_(x)
#define LDS_BARRIER() asm volatile("s_waitcnt lgkmcnt(0)\n\ts_barrier" ::: "memory")
#ifndef DBL_MASK
#define DBL_MASK 0
#endif
#define MLCUT ((DBL_MASK >> 21) & 255)
namespace pg8 {
#define PG8_LAS __attribute__((address_space(3)))
typedef unsigned short bf16_t;
typedef short bf16x8 __attribute__((ext_vector_type(8)));
typedef float f32x4 __attribute__((ext_vector_type(4)));
typedef unsigned u32x4 __attribute__((ext_vector_type(4)));
constexpr int BM = 256, BK = 64, HALF = 128, HTB = HALF * BK * 2  , STAGE_BYTES = 8 * HTB, NXCD = 8, WGM = 8;

__host__ __device__ __forceinline__ int lds_byte(int r, int c) { const int st = (r >> 4) * 2 + (c >> 5), rr = r & 15, cc = c & 31, ob = rr * 64 + cc * 2; return st * 1024 + (ob ^ (((ob >> 9) & 1) << 5)); }
__host__ __device__ __forceinline__ void stage_rc(int b, int& R, int& C) { const int st = b / 1024, sb = b % 1024, swz = sb ^ (((sb >> 9) & 1) << 5); R = (st >> 1) * 16 + swz / 64; C = (st & 1) * 32 + (swz % 64) / 2; }
__host__ __device__ __forceinline__ int perm32(int rho) { const int n = rho >> 4, i = rho & 15; return 8 * (i >> 2) + 4 * n + (i & 3); }

struct Unit { const char* a; const char* b; int pm, pn, aux; const int* gl; int gn; };
struct Gemm { int lda, ldb, K; };

__device__ __forceinline__ unsigned cvt_pk_bf16(float lo, float hi) { return pk2(lo, hi); }

template <class Epi, class Sched, bool ALIGN_EPI = false, bool SP2 = false, bool GATHER = false>
__device__ __forceinline__ void gemm_phase(PG8_LAS unsigned char* lds, const Gemm g, const Sched& S, const Epi& E) {
    int tid = threadIdx.x; asm volatile("" : "+v"(tid));
    const int wid = __builtin_amdgcn_readfirstlane(tid >> 6), lane = tid & 63, wr = wid >> 2, wc = wid & 3, fr = lane & 15, fq = lane >> 4;
    int K = g.K; asm volatile("" : "+s"(K)); const int nt = K / BK;
    unsigned voffA[2][2], voffN[2][2], voffB[2];
    int RA[2], CA[2];
#pragma unroll
    for (int i = 0; i < 2; ++i) { int R, C; stage_rc(tid * 16 + i * 8192, R, C); const int Rb = Epi::PERM ? ((R & ~31) + perm32(R & 31)) : R; RA[i] = R; CA[i] = C;
        voffA[0][i] = (unsigned)(R * g.lda + C) * 2u; voffA[1][i] = (unsigned)((R + HALF) * g.lda + C) * 2u; voffN[0][i] = voffA[0][i]; voffN[1][i] = voffA[1][i]; voffB[i] = (unsigned)(Rb * g.ldb + C) * 2u; }
#define PG8_GOFF(dst, u) do { _Pragma("unroll") for (int h_ = 0; h_ < 2; ++h_) _Pragma("unroll") for (int i_ = 0; i_ < 2; ++i_) { const int r_ = h_ * HALF + RA[i_]; const int idx_ = (r_ < (u).gn) ? (u).gl[r_] : 0; \
        dst[h_][i_] = (unsigned)(idx_ * g.lda + CA[i_]) * 2u; } } while (0)
    const size_t kstep = (size_t)(BK * 2);
    int lda_ = g.lda, ldb_ = g.ldb; asm volatile("" : "+s"(lda_), "+s"(ldb_));
    const size_t hB = (size_t)HALF * ldb_ * 2; (void)lda_;
    const unsigned ldsw = (unsigned)wid * 1024u;
    const int aoff = lds_byte(wr * 64 + fr, fq * 8), boff = lds_byte(wc * 32 + fr, fq * 8);
#define PG8_SA(b, h) (((b) * 2 + (h)) * HTB)
#define PG8_SB(b, h) ((4 + (b) * 2 + (h)) * HTB)
#define PG8_STAGE(bufoff, gbase, voff) do { _Pragma("unroll") for (int _i = 0; _i < 2; ++_i) \
        __builtin_amdgcn_global_load_lds((const unsigned*)((const char*)(gbase) + (voff)[_i]), (PG8_LAS unsigned*)(lds + (bufoff) + ldsw + _i * 8192), 16, 0, 0); } while (0)
#define PG8_STAGE_A(bufoff, gbase, vo, h) do { _Pragma("unroll") for (int _i = 0; _i < 2; ++_i) \
        __builtin_amdgcn_global_load_lds((const unsigned*)((const char*)(gbase) + (vo)[h][_i]), (PG8_LAS unsigned*)(lds + (bufoff) + ldsw + _i * 8192), 16, 0, 0); } while (0)
#define PG8_LDA(dst, b, h) do { _Pragma("unroll") for (int m = 0; m < 4; ++m) _Pragma("unroll") for (int k = 0; k < 2; ++k) dst[m][k] = *(const PG8_LAS bf16x8*)(lds + PG8_SA(b, h) + aoff + m * 2048 + k * 1024); } while (0)
#define PG8_LDB(dst, b, h) do { _Pragma("unroll") for (int n = 0; n < 2; ++n) _Pragma("unroll") for (int k = 0; k < 2; ++k) dst[n][k] = *(const PG8_LAS bf16x8*)(lds + PG8_SB(b, h) + boff + n * 2048 + k * 1024); } while (0)
#define PG8_MMA(ai, bj, At, Bt) do { __builtin_amdgcn_s_setprio(1); _Pragma("unroll") for (int m = 0; m < 4; ++m) _Pragma("unroll") for (int n = 0; n < 2; ++n) _Pragma("unroll") for (int k = 0; k < 2; ++k) \
        acc[ai][bj][m][n] = __builtin_amdgcn_mfma_f32_16x16x32_bf16(Bt[n][k], At[m][k], acc[ai][bj][m][n], 0, 0, 0); __builtin_amdgcn_s_setprio(0); } while (0)
#define PG8_WAIT_V(n) asm volatile("s_waitcnt vmcnt(" #n ")" ::: "memory")
#define PG8_WAIT_L(n) asm volatile("s_waitcnt lgkmcnt(" #n ")" ::: "memory")
#define PG8_BAR __builtin_amdgcn_s_barrier()
#define PG8_SCHED __builtin_amdgcn_sched_barrier(0)
    Unit cur, nxt; int ui = 0;
    if (!S.next(0, cur)) return;
    f32x4 acc[2][2][4][2];
#pragma unroll
    for (int a = 0; a < 2; ++a)
#pragma unroll
        for (int b = 0; b < 2; ++b)
#pragma unroll
            for (int m = 0; m < 4; ++m)
#pragma unroll
                for (int n = 0; n < 2; ++n) acc[a][b][m][n] = (f32x4){0.f, 0.f, 0.f, 0.f};
    bf16x8 At[4][2], B0[2][2], B1[2][2];
    const char* cA = cur.a; const char* cB = cur.b;
    if constexpr (GATHER) PG8_GOFF(voffA, cur);
    if constexpr (SP2) {
        PG8_STAGE(PG8_SB(0, 0), cB, voffB); PG8_STAGE(PG8_SB(0, 1), cB + hB, voffB); PG8_STAGE_A(PG8_SA(0, 0), cA, voffA, 0); PG8_STAGE_A(PG8_SA(0, 1), cA, voffA, 1);
        if (wr == 1) PG8_BAR;
        PG8_WAIT_V(2); PG8_BAR;
        PG8_STAGE(PG8_SB(1, 0), cB + kstep, voffB); PG8_STAGE_A(PG8_SA(1, 0), cA + kstep, voffA, 0); PG8_STAGE(PG8_SB(1, 1), cB + hB + kstep, voffB);
        PG8_WAIT_V(6); PG8_BAR;
    } else {
        PG8_STAGE(PG8_SB(0, 0), cB, voffB); PG8_STAGE_A(PG8_SA(0, 0), cA, voffA, 0); PG8_STAGE(PG8_SB(0, 1), cB + hB, voffB); PG8_STAGE_A(PG8_SA(0, 1), cA, voffA, 1);
        if (wr == 1) PG8_BAR;
        PG8_WAIT_V(4); PG8_BAR;
        PG8_STAGE(PG8_SB(1, 0), cB + kstep, voffB); PG8_STAGE_A(PG8_SA(1, 0), cA + kstep, voffA, 0); PG8_STAGE(PG8_SB(1, 1), cB + hB + kstep, voffB);
        PG8_WAIT_V(6); PG8_BAR;
    }
    for (;;) {
        const bool has_next = S.next(ui + 1, nxt);
        const char* nA = has_next ? nxt.a : cA; const char* nB = has_next ? nxt.b : cB;
        if constexpr (GATHER) { if (has_next) PG8_GOFF(voffN, nxt); else { _Pragma("unroll") for (int h_ = 0; h_ < 2; ++h_) _Pragma("unroll") for (int i_ = 0; i_ < 2; ++i_) voffN[h_][i_] = voffA[h_][i_]; } }
        for (int t = 0; t < nt; t += 2) {
            const bool last = (t == nt - 2);
            const char* a1 = cA + (size_t)(t + 1) * kstep;
            const char* a2 = last ? nA : cA + (size_t)(t + 2) * kstep; const char* b2 = last ? nB : cB + (size_t)(t + 2) * kstep;
            const char* a3 = a2 + kstep; const char* b3 = b2 + kstep;
            unsigned vo2[2][2];
            _Pragma("unroll") for (int h_ = 0; h_ < 2; ++h_) _Pragma("unroll") for (int i_ = 0; i_ < 2; ++i_) vo2[h_][i_] = (GATHER && last) ? voffN[h_][i_] : voffA[h_][i_];
            if constexpr (SP2) {
            PG8_LDB(B0, 0, 0); PG8_LDB(B1, 0, 1); PG8_SCHED; PG8_LDA(At, 0, 0); PG8_STAGE_A(PG8_SA(1, 1), a1, voffA, 1);
            PG8_WAIT_V(8); PG8_WAIT_L(0); PG8_BAR; PG8_MMA(0, 0, At, B0); PG8_MMA(0, 1, At, B1); PG8_BAR; PG8_SCHED;
            PG8_LDA(At, 0, 1); PG8_STAGE(PG8_SB(0, 0), b2, voffB); PG8_STAGE(PG8_SB(0, 1), b2 + hB, voffB); PG8_STAGE_A(PG8_SA(0, 0), a2, vo2, 0);
            PG8_WAIT_V(8); PG8_WAIT_L(0); PG8_BAR; PG8_MMA(1, 0, At, B0); PG8_MMA(1, 1, At, B1); PG8_BAR; PG8_SCHED;
            PG8_LDB(B0, 1, 0); PG8_LDB(B1, 1, 1); PG8_SCHED; PG8_LDA(At, 1, 0); PG8_STAGE_A(PG8_SA(0, 1), a2, vo2, 1);
            PG8_WAIT_V(8); PG8_WAIT_L(0); PG8_BAR; PG8_MMA(0, 0, At, B0); PG8_MMA(0, 1, At, B1); PG8_BAR; PG8_SCHED;
            PG8_LDA(At, 1, 1); PG8_STAGE(PG8_SB(1, 0), b3, voffB); PG8_STAGE(PG8_SB(1, 1), b3 + hB, voffB); PG8_STAGE_A(PG8_SA(1, 0), a3, vo2, 0);
            PG8_WAIT_V(8); PG8_WAIT_L(0); PG8_BAR; PG8_MMA(1, 0, At, B0); PG8_MMA(1, 1, At, B1); PG8_BAR; PG8_SCHED;
            } else {
            PG8_LDB(B0, 0, 0); PG8_SCHED; PG8_LDA(At, 0, 0); PG8_STAGE_A(PG8_SA(1, 1), a1, voffA, 1);
            PG8_WAIT_L(8); PG8_BAR; PG8_WAIT_L(0); PG8_MMA(0, 0, At, B0); PG8_BAR; PG8_SCHED;
            PG8_LDB(B1, 0, 1); PG8_STAGE(PG8_SB(0, 0), b2, voffB);
            PG8_BAR; PG8_WAIT_L(0); PG8_MMA(0, 1, At, B1); PG8_BAR;
            PG8_LDA(At, 0, 1); PG8_STAGE_A(PG8_SA(0, 0), a2, vo2, 0);
            PG8_BAR; PG8_WAIT_L(0); PG8_MMA(1, 0, At, B0); PG8_BAR; PG8_SCHED;
            PG8_STAGE(PG8_SB(0, 1), b2 + hB, voffB);
            PG8_WAIT_V(6); PG8_BAR; PG8_MMA(1, 1, At, B1); PG8_BAR;
            PG8_LDB(B0, 1, 0); PG8_SCHED; PG8_LDA(At, 1, 0); PG8_STAGE_A(PG8_SA(0, 1), a2, vo2, 1);
            PG8_WAIT_L(8); PG8_BAR; PG8_WAIT_L(0); PG8_MMA(0, 0, At, B0); PG8_BAR; PG8_SCHED;
            PG8_LDB(B1, 1, 1); PG8_STAGE(PG8_SB(1, 0), b3, voffB);
            PG8_BAR; PG8_WAIT_L(0); PG8_MMA(0, 1, At, B1); PG8_BAR;
            PG8_LDA(At, 1, 1); PG8_STAGE_A(PG8_SA(1, 0), a3, vo2, 0);
            PG8_BAR; PG8_WAIT_L(0); PG8_MMA(1, 0, At, B0); PG8_BAR; PG8_SCHED;
            PG8_STAGE(PG8_SB(1, 1), b3 + hB, voffB);
            PG8_WAIT_V(6); PG8_BAR; PG8_MMA(1, 1, At, B1); PG8_BAR;
            }
            if constexpr (Epi::HOOK) { if (t + 2 == 8 || t + 2 == 16) { int t3_ = threadIdx.x; asm volatile("" : "+v"(t3_)); E.mid(acc, cur, (t + 2) / 8 - 1, wr, wc, t3_ & 15, (t3_ >> 4) & 3); } }
        }
        if constexpr (ALIGN_EPI) { if (wr == 0) PG8_BAR; }
        { int t2_ = threadIdx.x; asm volatile("" : "+v"(t2_)); const int fr_ = t2_ & 15, fq_ = (t2_ >> 4) & 3;
          E(acc, cur, wr, wc, fr_, fq_); }
        if (!has_next) break;
#pragma unroll
        for (int a = 0; a < 2; ++a)
#pragma unroll
            for (int b = 0; b < 2; ++b)
#pragma unroll
                for (int m = 0; m < 4; ++m)
#pragma unroll
                    for (int n = 0; n < 2; ++n) acc[a][b][m][n] = (f32x4){0.f, 0.f, 0.f, 0.f};
        cur = nxt; cA = nA; cB = nB; ++ui;
        if constexpr (GATHER) { _Pragma("unroll") for (int h_ = 0; h_ < 2; ++h_) _Pragma("unroll") for (int i_ = 0; i_ < 2; ++i_) voffA[h_][i_] = voffN[h_][i_]; }
        if constexpr (ALIGN_EPI) { if (wr == 1) PG8_BAR; }
    }
    PG8_WAIT_V(0);
    if constexpr (!ALIGN_EPI) { if (wr == 0) PG8_BAR; }
    PG8_BAR;
#undef PG8_SA
#undef PG8_SB
#undef PG8_STAGE
#undef PG8_STAGE_A
#undef PG8_GOFF
#undef PG8_LDA
#undef PG8_LDB
#undef PG8_MMA
#undef PG8_WAIT_V
#undef PG8_WAIT_L
#undef PG8_BAR
#undef PG8_SCHED
}
}
namespace attn_body {
using bf16x8=__attribute__((ext_vector_type(8)))short;
using s16x4=__attribute__((ext_vector_type(4)))short;
using f32x16=__attribute__((ext_vector_type(16)))float;
using u32x4=__attribute__((ext_vector_type(4)))unsigned;
typedef unsigned short bf16;
constexpr int D=64,NW=8,QBLK=32,QB=QBLK*NW,KVBLK=64;
__device__ __forceinline__ int crow(int r,int hi){return (r&3)+8*(r>>2)+4*hi;}
#define SBAR() __builtin_amdgcn_sched_barrier(0)
constexpr int NSLOT=3, SLOTB=8192;
constexpr int LDS_K=0, LDS_V=NSLOT*SLOTB, LDS_WS=2*NSLOT*SLOTB, LDS_OST=LDS_WS+NW*64*4, LDS_BYTES=LDS_OST+NW*4096;
__device__ __forceinline__ void glds16(const void*gsrc,unsigned lds_dst){unsigned keep;
  asm volatile("s_mov_b32 %0, m0\n\ts_mov_b32 m0, %2\n\ts_nop 0\n\tglobal_load_lds_dwordx4 %1, off\n\ts_mov_b32 m0, %0":"=&s"(keep):"v"(gsrc),"s"(lds_dst):"memory");}
__device__ __forceinline__ float max3f(float a,float b,float c){float r;asm("v_max3_f32 %0, %1, %2, %3":"=v"(r):"v"(a),"v"(b),"v"(c));return r;}
__device__ __forceinline__ float max2f(float a,float b){float r;asm("v_max_f32_e32 %0, %1, %2":"=v"(r):"v"(a),"v"(b));return r;}
__device__ __forceinline__ float fadd_s(float a,float b){float r;asm("v_add_f32_e32 %0, %1, %2":"=v"(r):"v"(a),"v"(b));return r;}
__device__ __forceinline__ float fsub_s(float a,float b){float r;asm("v_sub_f32_e32 %0, %1, %2":"=v"(r):"v"(a),"v"(b));return r;}
typedef float f32x2_t __attribute__((ext_vector_type(2))); typedef __bf16 bf16x2_t __attribute__((ext_vector_type(2)));
__device__ __forceinline__ unsigned cvtpk_s(float lo,float hi){f32x2_t v={lo,hi};bf16x2_t b=__builtin_convertvector(v,bf16x2_t);return __builtin_bit_cast(unsigned,b);}
#define WAIT_BAR(N) asm volatile("s_waitcnt vmcnt(" #N ") lgkmcnt(0)\n\ts_barrier":::"memory")

__device__ __forceinline__ void qkt(f32x16&p0,f32x16&p1,const char*Kslot,const bf16x8*qr,const f32x16&negm,int r32,int hi){
  const char*kb=Kslot+hi*1024+r32*16;
  #pragma unroll
  for(int d0=0;d0<4;++d0){
    const bf16x8 b0=*reinterpret_cast<const bf16x8*>(kb+d0*2048);
    const bf16x8 b1=*reinterpret_cast<const bf16x8*>(kb+d0*2048+512);
    if(d0==0){p0=__builtin_amdgcn_mfma_f32_32x32x16_bf16(b0,qr[0],negm,0,0,0);p1=__builtin_amdgcn_mfma_f32_32x32x16_bf16(b1,qr[0],negm,0,0,0);}
    else{p0=__builtin_amdgcn_mfma_f32_32x32x16_bf16(b0,qr[d0],p0,0,0,0);p1=__builtin_amdgcn_mfma_f32_32x32x16_bf16(b1,qr[d0],p1,0,0,0);}}
}
typedef __attribute__((address_space(3))) const char* lds_cptr;
typedef short v4i16_t __attribute__((ext_vector_type(4)));
__device__ __forceinline__ void kload8(bf16x8*kf,lds_cptr kp){
  kf[0]=*(const __attribute__((address_space(3))) bf16x8*)(kp);      kf[1]=*(const __attribute__((address_space(3))) bf16x8*)(kp+512);
  kf[2]=*(const __attribute__((address_space(3))) bf16x8*)(kp+2048); kf[3]=*(const __attribute__((address_space(3))) bf16x8*)(kp+2560);
  kf[4]=*(const __attribute__((address_space(3))) bf16x8*)(kp+4096); kf[5]=*(const __attribute__((address_space(3))) bf16x8*)(kp+4608);
  kf[6]=*(const __attribute__((address_space(3))) bf16x8*)(kp+6144); kf[7]=*(const __attribute__((address_space(3))) bf16x8*)(kp+6656);
}
__device__ __forceinline__ void kload2(bf16x8*kf,lds_cptr kp,int j){ kf[2*j]=*(const __attribute__((address_space(3))) bf16x8*)(kp+j*2048); kf[2*j+1]=*(const __attribute__((address_space(3))) bf16x8*)(kp+j*2048+512); }
__device__ __forceinline__ s16x4 vtr(lds_cptr p){ return __builtin_bit_cast(s16x4,__builtin_amdgcn_ds_read_tr16_b64_v4i16((__attribute__((address_space(3))) v4i16_t*)p)); }
__device__ __forceinline__ float rowmax(const f32x16&p0,const f32x16&p1){
  float a=max3f(p0[0],p0[1],p1[0]),b=max3f(p0[2],p0[3],p1[1]);a=max3f(a,p1[2],p1[3]);
  #pragma unroll
  for(int r=4;r<16;r+=4){a=max3f(a,p0[r],p0[r+1]);b=max3f(b,p0[r+2],p0[r+3]);a=max3f(a,p1[r],p1[r+1]);b=max3f(b,p1[r+2],p1[r+3]);}
  const float m=max2f(a,b);
  auto rr=__builtin_amdgcn_permlane32_swap(__float_as_uint(m),__float_as_uint(m),false,false);
  return max2f(__uint_as_float(rr[0]),__uint_as_float(rr[1]));
}
__device__ __forceinline__ float rowmax16(const f32x16&p){
  float a=__builtin_fmaxf(__builtin_fmaxf(p[0],p[1]),p[2]),b=__builtin_fmaxf(__builtin_fmaxf(p[3],p[4]),p[5]);
  a=__builtin_fmaxf(__builtin_fmaxf(a,p[6]),p[7]); b=__builtin_fmaxf(__builtin_fmaxf(b,p[8]),p[9]); a=__builtin_fmaxf(__builtin_fmaxf(a,p[10]),p[11]); b=__builtin_fmaxf(__builtin_fmaxf(b,p[12]),p[13]);
  a=__builtin_fmaxf(__builtin_fmaxf(a,p[14]),p[15]);
  const float m=__builtin_fmaxf(a,b);
  auto rr=__builtin_amdgcn_permlane32_swap(__float_as_uint(m),__float_as_uint(m),false,false);
  return __builtin_fmaxf(__uint_as_float(rr[0]),__uint_as_float(rr[1]));
}
__device__ __forceinline__ void pv(f32x16*o,int vb,bf16x8 pa0,bf16x8 pa1,bf16x8 pa2,bf16x8 pa3){
  #pragma unroll
  for(int d0=0;d0<2;++d0){s16x4 lo[4],hi[4];
    #pragma unroll
    for(int ks=0;ks<4;++ks){
      asm volatile("ds_read_b64_tr_b16 %0,%1 offset:%c2":"=&v"(lo[ks]):"v"(vb),"i"(d0*4096+ks*1024):"memory");
      asm volatile("ds_read_b64_tr_b16 %0,%1 offset:%c2":"=&v"(hi[ks]):"v"(vb),"i"(d0*4096+ks*1024+512):"memory");}
    asm volatile("s_waitcnt lgkmcnt(0)":::"memory");SBAR();
    #define PK(k) (bf16x8){lo[k][0],lo[k][1],lo[k][2],lo[k][3],hi[k][0],hi[k][1],hi[k][2],hi[k][3]}
    o[d0]=__builtin_amdgcn_mfma_f32_32x32x16_bf16(pa0,PK(0),o[d0],0,0,0);
    o[d0]=__builtin_amdgcn_mfma_f32_32x32x16_bf16(pa1,PK(1),o[d0],0,0,0);
    o[d0]=__builtin_amdgcn_mfma_f32_32x32x16_bf16(pa2,PK(2),o[d0],0,0,0);
    o[d0]=__builtin_amdgcn_mfma_f32_32x32x16_bf16(pa3,PK(3),o[d0],0,0,0);
    #undef PK
  }
}

template<int MODE,int THRL> __device__ __forceinline__ void attn_unit(const bf16*Qw,long qpitch,const bf16*__restrict__ Kh,const bf16*__restrict__ Vh,long kvpitch,
    int NT,int nA,long rowB,bf16*Ow,long opitch,char*shm,lds_cptr btab_c,int qrow0,int jb0){
  int tid=threadIdx.x; asm volatile("":"+v"(tid)); const int lane=tid&63,r32=lane&31,hi=lane>>5; const int wid=__builtin_amdgcn_readfirstlane(tid>>6);
  const unsigned lds0=(unsigned)(uintptr_t)shm;
  float*wsf=(float*)(shm+LDS_WS)+wid*64;
  const bf16*ksrc=Kh+(long)lane*kvpitch+wid*8;
  const bf16*vsrc=Vh+(long)(16*(wid&3)+(lane>>2))*kvpitch+(wid>>2)*32+(lane&3)*8;
  const unsigned kdst=lds0+LDS_K+wid*1024, vdst=lds0+LDS_V+wid*1024;
  #define TR(t) (((t)<nA)?(long)(t)*KVBLK:rowB+(long)((t)-nA)*KVBLK)
  #define DMA_K(t,slot) glds16(ksrc+TR(t)*kvpitch,(unsigned)__builtin_amdgcn_readfirstlane(kdst+(slot)))
  #define DMA_V(t,slot) glds16(vsrc+TR(t)*kvpitch,(unsigned)__builtin_amdgcn_readfirstlane(vdst+(slot)))
  const int vb0=(int)(lds0+LDS_V)+((lane>>4)&1)*32+(lane&3)*8+(4*hi+((lane&15)>>2))*64;
  const char*Kbase=shm+LDS_K; bf16x8 kf[8];
  const lds_cptr shm3=(lds_cptr)shm; const lds_cptr kp0=shm3+LDS_K+hi*1024+r32*16; const lds_cptr vp0=shm3+LDS_V+((lane>>4)&1)*32+(lane&3)*8+(4*hi+((lane&15)>>2))*64;
  const int qrow_=qrow0+(wid>>1), qc_=32*(wid&1)+r32;
  const int cs_=min(max(qc_-8,0),48), rs_=min(max(qrow_-4,0),56);
  const int koff_=4*hi-cs_, boff_=15-qc_+4*hi;
  const float NEGV=-INFINITY;
  #define NAMASK(C0,C1,t) do{ if(MODE==1 && (t)>=4){ const int jrow_=jb0+(t)-4; \
      if(jrow_<rs_||jrow_>rs_+7){ _Pragma("unroll") for(int r=0;r<16;++r){C0[r]=NEGV;C1[r]=NEGV;} } \
      else { const __attribute__((address_space(3))) float* tb_=(const __attribute__((address_space(3))) float*)btab_c+((jrow_-qrow_+7)*32+boff_); \
        _Pragma("unroll") for(int r=0;r<16;++r){ const int kc_=(r&3)+8*(r>>2); const float b0_=tb_[kc_], b1_=tb_[kc_+32]; \
          C0[r]=((unsigned)(kc_+koff_)<16u)?(C0[r]+b0_):NEGV; C1[r]=((unsigned)(kc_+32+koff_)<16u)?(C1[r]+b1_):NEGV; } } } }while(0)
  DMA_K(0,0);DMA_V(0,0);DMA_K(1,SLOTB);
  bf16x8 qr[4];
  { const bf16*Qr=Qw+(long)(wid*QBLK+r32)*qpitch;
  #pragma unroll
  for(int d0=0;d0<4;++d0)qr[d0]=*reinterpret_cast<const bf16x8*>(&Qr[d0*16+hi*8]); }
  float mhat=0.f,l_reg=0.f;f32x16 o[2];o[0]=f32x16{};o[1]=f32x16{};f32x16 negm=f32x16{};asm volatile("":"+v"(negm));
  bool resc=false;
  #define START(P0,P1) do{ const float rm=rowmax(P0,P1); resc=false; \
    { const float dl=rm; mhat=fadd_s(mhat,dl); \
      _Pragma("unroll") for(int r=0;r<16;++r){P0[r]=fsub_s(P0[r],dl);P1[r]=fsub_s(P1[r],dl);} \
      _Pragma("unroll") for(int r=0;r<16;++r)negm[r]=-mhat; asm volatile("":"+v"(negm)); } \
    _Pragma("unroll") for(int r=0;r<16;++r)P0[r]=__builtin_amdgcn_exp2f(P0[r]); }while(0)
  #define RESC() do{ if(resc){ asm volatile("s_waitcnt lgkmcnt(0)":::"memory"); \
      _Pragma("unroll") for(int d_=0;d_<2;++d_) _Pragma("unroll") for(int r=0;r<16;++r)o[d_][r]*=wsf[crow(r,hi)]; } }while(0)
  f32x16 pA0,pA1,pB0,pB1;
  int sl_prev=0,sl_cur=0,sl_next=SLOTB;
  #define ROT() do{sl_prev=sl_cur;sl_cur=sl_next;sl_next=(sl_next==(NSLOT-1)*SLOTB)?0:sl_next+SLOTB;}while(0)
  DMA_K(2,2*SLOTB);
  if(wid>=4) __builtin_amdgcn_s_setprio(1);
  WAIT_BAR(3);
  qkt(pA0,pA1,Kbase,qr,negm,r32,hi);asm volatile("s_nop 15\n\ts_nop 7":"+v"(pA0),"+v"(pA1));
  START(pA0,pA1);
  _Pragma("unroll") for(int r=0;r<16;++r)pA1[r]=__builtin_amdgcn_exp2f(pA1[r]);
  WAIT_BAR(0);
  DMA_K(3,0);DMA_V(1,SLOTB);
  ROT();
  kload8(kf,kp0+sl_cur);
  WAIT_BAR(2);
  s16x4 vlo[8],vhi[8]; u32x4 pw0,pw1,pw2,pw3;
  #define PKW(P,B) cvtpk_s(P[B],P[B+1])
  #define PAF(k) __builtin_bit_cast(bf16x8,pw##k)
  #define VFR(i) (bf16x8){vlo[i][0],vlo[i][1],vlo[i][2],vlo[i][3],vhi[i][0],vhi[i][1],vhi[i][2],vhi[i][3]}
  #define PIN(x) asm volatile("":"+v"(x))
  #define MX3(a,b,c) __builtin_fmaxf(__builtin_fmaxf((a),(b)),(c))
  #define GAPA(MF,A0,A1,A2,A3,W0,W1,PW) do{ MF; sacc+=A0; sacc+=A1; sacc+=A2; sacc+=A3; PIN(sacc); W0; W1; PIN(PW); SBAR(); }while(0)
  #define EX(v) __builtin_amdgcn_exp2f(v)
  #define GAPB(MF,X,B) do{ MF; X[B]=EX(X[B]); X[B+1]=EX(X[B+1]); X[B+2]=EX(X[B+2]); X[B+3]=EX(X[B+3]); PIN(X); SBAR(); }while(0)
  #define VRD(i) do{ vlo[i]=vtr(vp_+(((i)>>2)*4096+((i)&3)*1024)); vhi[i]=vtr(vp_+(((i)>>2)*4096+((i)&3)*1024+512)); }while(0)
  #define KRD(G,j) do{ if(G){ kload2(kf,kp0+sl_next,j); SBAR(); } }while(0)
  #define STEP(C0,C1,P0,P1,t,GK,GV,GL) do{ SBAR(); \
    const lds_cptr vp_=vp0+sl_prev; \
    VRD(0); SBAR(); float sacc=(P0[0]+P0[1]); \
    GAPA(C0=__builtin_amdgcn_mfma_f32_32x32x16_bf16(kf[0],qr[0],negm,0,0,0), P0[2],P0[3],P0[4],P0[5],     pw0[0]=PKW(P0,0), pw0[1]=PKW(P0,2), pw0); \
    VRD(4); SBAR(); GAPA(C1=__builtin_amdgcn_mfma_f32_32x32x16_bf16(kf[1],qr[0],negm,0,0,0), P0[6],P0[7],P0[8],P0[9],     pw0[2]=PKW(P0,4), pw0[3]=PKW(P0,6), pw0); \
    VRD(1); SBAR(); GAPA(C0=__builtin_amdgcn_mfma_f32_32x32x16_bf16(kf[2],qr[1],C0,0,0,0),   P0[10],P0[11],P0[12],P0[13], pw1[0]=PKW(P0,8), pw1[1]=PKW(P0,10), pw1); \
    VRD(5); SBAR(); GAPA(C1=__builtin_amdgcn_mfma_f32_32x32x16_bf16(kf[3],qr[1],C1,0,0,0),   P0[14],P0[15],P1[0],P1[1],   pw1[2]=PKW(P0,12),pw1[3]=PKW(P0,14), pw1); \
    VRD(2); SBAR(); GAPA(C0=__builtin_amdgcn_mfma_f32_32x32x16_bf16(kf[4],qr[2],C0,0,0,0),   P1[2],P1[3],P1[4],P1[5],     pw2[0]=PKW(P1,0), pw2[1]=PKW(P1,2), pw2); \
    VRD(6); SBAR(); GAPA(C1=__builtin_amdgcn_mfma_f32_32x32x16_bf16(kf[5],qr[2],C1,0,0,0),   P1[6],P1[7],P1[8],P1[9],     pw2[2]=PKW(P1,4), pw2[3]=PKW(P1,6), pw2); \
    VRD(3); SBAR(); GAPA(C0=__builtin_amdgcn_mfma_f32_32x32x16_bf16(kf[6],qr[3],C0,0,0,0),   P1[10],P1[11],P1[12],P1[13], pw3[0]=PKW(P1,8), pw3[1]=PKW(P1,10), pw3); \
    VRD(7); SBAR(); GAPA(C1=__builtin_amdgcn_mfma_f32_32x32x16_bf16(kf[7],qr[3],C1,0,0,0),   P1[14],P1[15],0.f,0.f,       pw3[2]=PKW(P1,12),pw3[3]=PKW(P1,14), pw3); \
    l_reg+=sacc; \
    if(GK){DMA_K((t)+3,sl_cur);} if(GV){DMA_V((t)+1,sl_next);} \
    NAMASK(C0,C1,t); \
    if constexpr (THRL < 1000) { \
    { float a=MX3(C0[0],C0[1],C1[0]),b=MX3(C0[2],C0[3],C1[1]); a=MX3(a,C1[2],C1[3]); \
      _Pragma("unroll") for(int r=4;r<16;r+=4){a=MX3(a,C0[r],C0[r+1]);b=MX3(b,C0[r+2],C0[r+3]);a=MX3(a,C1[r],C1[r+1]);b=MX3(b,C1[r+2],C1[r+3]);} \
      float rm=__builtin_fmaxf(a,b); { auto rr=__builtin_amdgcn_permlane32_swap(__float_as_uint(rm),__float_as_uint(rm),false,false); rm=__builtin_fmaxf(__uint_as_float(rr[0]),__uint_as_float(rr[1])); } \
      resc=false; \
      if(__builtin_expect(__any(rm>(float)THRL),0)){ const float dl=__builtin_fmaxf(rm,0.f); mhat+=dl; \
        _Pragma("unroll") for(int r=0;r<16;++r){C0[r]-=dl;C1[r]-=dl;} \
        _Pragma("unroll") for(int r=0;r<16;++r)negm[r]=-mhat; asm volatile("":"+v"(negm)); \
        const float f=__builtin_amdgcn_exp2f(-dl); l_reg*=f; if(hi==0)wsf[r32]=f; resc=true; } } \
    } \
    SBAR(); \
    GAPB(o[0]=__builtin_amdgcn_mfma_f32_32x32x16_bf16(PAF(0),VFR(0),o[0],0,0,0), C0,0); \
    GAPB(o[1]=__builtin_amdgcn_mfma_f32_32x32x16_bf16(PAF(0),VFR(4),o[1],0,0,0), C0,4); \
    KRD(GL,0); GAPB(o[0]=__builtin_amdgcn_mfma_f32_32x32x16_bf16(PAF(1),VFR(1),o[0],0,0,0), C0,8); \
    KRD(GL,1); GAPB(o[1]=__builtin_amdgcn_mfma_f32_32x32x16_bf16(PAF(1),VFR(5),o[1],0,0,0), C0,12); \
    KRD(GL,2); GAPB(o[0]=__builtin_amdgcn_mfma_f32_32x32x16_bf16(PAF(2),VFR(2),o[0],0,0,0), C1,0); \
    KRD(GL,3); GAPB(o[1]=__builtin_amdgcn_mfma_f32_32x32x16_bf16(PAF(2),VFR(6),o[1],0,0,0), C1,4); \
    GAPB(o[0]=__builtin_amdgcn_mfma_f32_32x32x16_bf16(PAF(3),VFR(3),o[0],0,0,0), C1,8); \
    GAPB(o[1]=__builtin_amdgcn_mfma_f32_32x32x16_bf16(PAF(3),VFR(7),o[1],0,0,0), C1,12); \
    }while(0)
  int t=1;
  for(;t+5<NT;t+=2){
    STEP(pB0,pB1,pA0,pA1,t,true,true,true);     WAIT_BAR(2); RESC(); ROT();
    STEP(pA0,pA1,pB0,pB1,t+1,true,true,true);   WAIT_BAR(2); RESC(); ROT();
  }
  #define ENDW(tt) do{ if((tt)+3<NT){WAIT_BAR(2);} else if((tt)+2<NT){WAIT_BAR(1);} else {WAIT_BAR(0);} }while(0)
  for(;t+1<NT;t+=2){
    STEP(pB0,pB1,pA0,pA1,t,(t+3<NT),(t+1<NT),(t+1<NT));       ENDW(t);   RESC(); ROT();
    STEP(pA0,pA1,pB0,pB1,t+1,(t+4<NT),(t+2<NT),(t+2<NT));     ENDW(t+1); RESC(); ROT();
  }
  STEP(pB0,pB1,pA0,pA1,NT-1,false,false,false); RESC();
  { float sacc=pB0[0]+pB0[1]; _Pragma("unroll") for(int r=2;r<16;++r)sacc+=pB0[r]; _Pragma("unroll") for(int r=0;r<16;++r)sacc+=pB1[r]; l_reg+=sacc;
    pw0=(u32x4){PKW(pB0,0),PKW(pB0,2),PKW(pB0,4),PKW(pB0,6)};pw1=(u32x4){PKW(pB0,8),PKW(pB0,10),PKW(pB0,12),PKW(pB0,14)};pw2=(u32x4){PKW(pB1,0),PKW(pB1,2),PKW(pB1,4),PKW(pB1,6)};pw3=(u32x4){PKW(pB1,8),PKW(pB1,10),PKW(pB1,12),PKW(pB1,14)};
    SBAR(); pv(o,vb0+sl_cur,PAF(0),PAF(1),PAF(2),PAF(3)); }
  #undef PKW
  #undef PAF
  #undef VFR
  #undef PIN
  #undef MX3
  #undef GAPA
  #undef GAPB
  #undef EX
  #undef VRD
  #undef KRD
  #undef STEP
  #undef ENDW
  {auto rr=__builtin_amdgcn_permlane32_swap(__float_as_uint(l_reg),__float_as_uint(l_reg),false,false);l_reg=__uint_as_float(rr[0])+__uint_as_float(rr[1]);}
  if(hi==0)wsf[32+r32]=l_reg;asm volatile("s_waitcnt lgkmcnt(0)":::"memory");
  float rli[16];
  #pragma unroll
  for(int r=0;r<16;++r)rli[r]=__builtin_amdgcn_rcpf(wsf[32+crow(r,hi)]);
  bf16*Owv=Ow+(long)(wid*QBLK)*opitch;
  { bf16*stg=(bf16*)(shm+LDS_OST)+wid*2048;
    #pragma unroll
    for(int r=0;r<16;++r){const int orow=crow(r,hi);
      #pragma unroll
      for(int d0=0;d0<2;++d0)stg[orow*64+d0*32+r32]=(bf16)f2bf(o[d0][r]*rli[r]);}
    asm volatile("s_waitcnt lgkmcnt(0)":::"memory");
    #pragma unroll
    for(int i=0;i<4;++i){const int row=i*8+(lane>>3),ch=lane&7; const u32x4 v=*(const u32x4*)(stg+row*64+ch*8); *(u32x4*)(Owv+(long)row*opitch+ch*8)=v;} }
  __builtin_amdgcn_s_setprio(0);
  asm volatile("s_waitcnt lgkmcnt(0)\n\ts_barrier":::"memory");
  #undef DMA_K
  #undef DMA_V
  #undef TR
  #undef NAMASK
  #undef START
  #undef RESC
  #undef ROT
}
constexpr int ATTN_LDS_BYTES=LDS_BYTES;

template<int NBLK_DUMMY=0> __device__ __forceinline__ void na_unit(const bf16* __restrict__ Pb  , int h, int rg, bf16* Ob  , char* shm, lds_cptr tab  ){
  int tid=threadIdx.x; asm volatile("":"+v"(tid)); const int lane=tid&63,r32=lane&31,hi=lane>>5; const int wid=__builtin_amdgcn_readfirstlane(tid>>6);
  const int y0=4*rg+2*(wid>>2), x0=16*(wid&3);
  const int jb=min(max(y0-4,0),55), cb=min(max(x0-8,0),32);
  const int qrow=y0+(r32>>4), qcol=x0+(r32&15), qtok=qrow*64+qcol;
  const int rsq=min(max(qrow-4,0),56), csq=min(max(qcol-8,0),48);
  const bf16* Qp=Pb+(long)qtok*PW+C_BQ+h*64+hi*8;
  bf16x8 qr[4];
  #pragma unroll
  for(int ks=0;ks<4;++ks)qr[ks]=*reinterpret_cast<const bf16x8*>(Qp+ks*16);
  const bf16* Ksrc=Pb+C_BK+h*64+(long)(lane>>3)*PW+(((lane&7)^(lane>>3))*8);
  const bf16* Vsrc=Pb+C_BV+h*64+(long)(lane>>3)*PW+(((lane&7)^(lane>>3))*8);
  const unsigned wb0=(unsigned)(uintptr_t)shm+wid*16384;
  typedef const __attribute__((address_space(3))) bf16x8* lds_b8;
  const lds_cptr wl=(lds_cptr)shm+wid*16384;
  int kofs[4];
  #pragma unroll
  for(int ks=0;ks<4;++ks) kofs[ks]=r32*128+(((2*ks+hi)^(r32&7))*16);
  const int q4=(lane&15)>>2, p4=lane&3, h16=(lane>>4)&1, sw=4*hi+q4;
  const int vofs0=sw*128+(((2*h16+(p4>>1))^sw)*16)+(p4&1)*8, vofs1=sw*128+(((4+2*h16+(p4>>1))^sw)*16)+(p4&1)*8;
  typedef const __attribute__((address_space(3))) float* lds_fptr;
  lds_fptr ta[16];
  #pragma unroll
  for(int r=0;r<16;++r){ const int kc=cb+(r&3)+8*(r>>2)+4*hi; const int idx=((unsigned)(kc-csq)<16u)?(kc-qcol+15):31; ta[r]=(lds_fptr)tab+(jb-qrow+7)*32+idx; }
  const float rm0=((unsigned)(jb-rsq)<8u)?1.f:0.f, rm8=((unsigned)(jb+8-rsq)<8u)?1.f:0.f;
  #define NA_TOK(i) ((i)<8 ? NLAT+32*(i) : (jb+(i)-8)*64+cb)
  #define NA_LOADK(i) do{ const long t0_=(long)NA_TOK(i); \
      _Pragma("unroll") for(int j_=0;j_<4;++j_) glds16(Ksrc+(t0_+8*j_)*PW,(unsigned)__builtin_amdgcn_readfirstlane(wb0+((i)&1)*4096+j_*1024)); }while(0)
  #define NA_LOADV(i) do{ const long t0_=(long)NA_TOK(i); \
      _Pragma("unroll") for(int j_=0;j_<4;++j_) glds16(Vsrc+(t0_+8*j_)*PW,(unsigned)__builtin_amdgcn_readfirstlane(wb0+8192+((i)&1)*4096+j_*1024)); }while(0)
  #define NA_QK(i,c_) do{ const lds_cptr kp_=wl+((i)&1)*4096; bf16x8 kf_[4]; _Pragma("unroll") for(int ks=0;ks<4;++ks) kf_[ks]=*(lds_b8)(kp_+kofs[ks]); \
    c_=__builtin_amdgcn_mfma_f32_32x32x16_bf16(kf_[0],qr[0],negm,0,0,0); c_=__builtin_amdgcn_mfma_f32_32x32x16_bf16(kf_[1],qr[1],c_,0,0,0); \
    c_=__builtin_amdgcn_mfma_f32_32x32x16_bf16(kf_[2],qr[2],c_,0,0,0); c_=__builtin_amdgcn_mfma_f32_32x32x16_bf16(kf_[3],qr[3],c_,0,0,0); }while(0)
  f32x16 o0=f32x16{},o1=f32x16{},negm=f32x16{}; float l_reg=0.f;
  asm volatile("s_waitcnt vmcnt(0)":::"memory");
  NA_LOADK(0); NA_LOADV(0); NA_LOADK(1); NA_LOADV(1);
  f32x16 cA,cB;
  asm volatile("s_waitcnt vmcnt(12)":::"memory");
  NA_QK(0,cA);
  { const float m_=rowmax16(cA); _Pragma("unroll") for(int r=0;r<16;++r){ cA[r]-=m_; negm[r]=-m_; } }
  #define NA_STEP(i,cc_,cn_) do{ \
    if((i)+2<17){ NA_LOADK((i)+2); asm volatile("s_waitcnt vmcnt(8)":::"memory"); } else if((i)+1<17){ asm volatile("s_waitcnt vmcnt(4)":::"memory"); } else { asm volatile("s_waitcnt vmcnt(0)":::"memory"); } \
    if((i)+1<17){ NA_QK((i)+1,cn_); } \
    const lds_cptr vp_=wl+8192+((i)&1)*4096; \
    s16x4 vl_[4],vh_[4]; \
    _Pragma("unroll") for(int kg=0;kg<2;++kg){ vl_[kg]=vtr(vp_+vofs0+kg*2048); vh_[kg]=vtr(vp_+vofs0+kg*2048+1024); vl_[2+kg]=vtr(vp_+vofs1+kg*2048); vh_[2+kg]=vtr(vp_+vofs1+kg*2048+1024); } \
    if((i)>=8){ _Pragma("unroll") for(int r=0;r<16;++r) cc_[r]+=ta[r][((i)-8)*32]; } \
    _Pragma("unroll") for(int r=0;r<16;++r) cc_[r]=__builtin_amdgcn_exp2f(cc_[r]); \
    if((i)==8){ _Pragma("unroll") for(int r=0;r<16;++r) cc_[r]*=rm0; } \
    if((i)==16){ _Pragma("unroll") for(int r=0;r<16;++r) cc_[r]*=rm8; } \
    { float s_=(cc_[0]+cc_[1])+(cc_[2]+cc_[3]); _Pragma("unroll") for(int r=4;r<16;r+=4) s_+=(cc_[r]+cc_[r+1])+(cc_[r+2]+cc_[r+3]); l_reg+=s_; } \
    const u32x4 pa_=(u32x4){cvtpk_s(cc_[0],cc_[1]),cvtpk_s(cc_[2],cc_[3]),cvtpk_s(cc_[4],cc_[5]),cvtpk_s(cc_[6],cc_[7])}, pb_=(u32x4){cvtpk_s(cc_[8],cc_[9]),cvtpk_s(cc_[10],cc_[11]),cvtpk_s(cc_[12],cc_[13]),cvtpk_s(cc_[14],cc_[15])}; \
    asm volatile("s_waitcnt lgkmcnt(0)":::"memory"); \
    if((i)+2<17){ NA_LOADV((i)+2); } \
    o0=__builtin_amdgcn_mfma_f32_32x32x16_bf16(__builtin_bit_cast(bf16x8,pa_),(bf16x8){vl_[0][0],vl_[0][1],vl_[0][2],vl_[0][3],vh_[0][0],vh_[0][1],vh_[0][2],vh_[0][3]},o0,0,0,0); \
    o1=__builtin_amdgcn_mfma_f32_32x32x16_bf16(__builtin_bit_cast(bf16x8,pa_),(bf16x8){vl_[2][0],vl_[2][1],vl_[2][2],vl_[2][3],vh_[2][0],vh_[2][1],vh_[2][2],vh_[2][3]},o1,0,0,0); \
    o0=__builtin_amdgcn_mfma_f32_32x32x16_bf16(__builtin_bit_cast(bf16x8,pb_),(bf16x8){vl_[1][0],vl_[1][1],vl_[1][2],vl_[1][3],vh_[1][0],vh_[1][1],vh_[1][2],vh_[1][3]},o0,0,0,0); \
    o1=__builtin_amdgcn_mfma_f32_32x32x16_bf16(__builtin_bit_cast(bf16x8,pb_),(bf16x8){vl_[3][0],vl_[3][1],vl_[3][2],vl_[3][3],vh_[3][0],vh_[3][1],vh_[3][2],vh_[3][3]},o1,0,0,0); \
  }while(0)
  NA_STEP(0,cA,cB); NA_STEP(1,cB,cA); NA_STEP(2,cA,cB); NA_STEP(3,cB,cA); NA_STEP(4,cA,cB); NA_STEP(5,cB,cA); NA_STEP(6,cA,cB); NA_STEP(7,cB,cA); NA_STEP(8,cA,cB);
  NA_STEP(9,cB,cA); NA_STEP(10,cA,cB); NA_STEP(11,cB,cA); NA_STEP(12,cA,cB); NA_STEP(13,cB,cA); NA_STEP(14,cA,cB); NA_STEP(15,cB,cA); NA_STEP(16,cA,cB);
  #undef NA_STEP
  #undef NA_QK
  #undef NA_LOADK
  #undef NA_LOADV
  #undef NA_TOK
  {auto rr=__builtin_amdgcn_permlane32_swap(__float_as_uint(l_reg),__float_as_uint(l_reg),false,false);l_reg=__uint_as_float(rr[0])+__uint_as_float(rr[1]);}
  float*wsf=(float*)(shm+wid*16384+4096);
  if(hi==0)wsf[r32]=l_reg; asm volatile("s_waitcnt lgkmcnt(0)":::"memory");
  float rli[16];
  #pragma unroll
  for(int r=0;r<16;++r)rli[r]=__builtin_amdgcn_rcpf(wsf[crow(r,hi)]);
  { bf16*stg=(bf16*)(shm+wid*16384);
    #pragma unroll
    for(int r=0;r<16;++r){const int orow=crow(r,hi); stg[orow*64+r32]=(bf16)f2bf(o0[r]*rli[r]); stg[orow*64+32+r32]=(bf16)f2bf(o1[r]*rli[r]);}
    asm volatile("s_waitcnt lgkmcnt(0)":::"memory");
    #pragma unroll
    for(int i=0;i<4;++i){const int row=i*8+(lane>>3),ch=lane&7; const u32x4 v=*(const u32x4*)(stg+row*64+ch*8);
      const int tok=(y0+(row>>4))*64+x0+(row&15); *(u32x4*)(Ob+(long)tok*OW+512+h*64+ch*8)=v;}
    asm volatile("s_waitcnt lgkmcnt(0)":::"memory"); }
}
#undef SBAR
#undef WAIT_BAR
}
constexpr size_t MiB = 1u << 20;
constexpr size_t WS_CTL = 0, CTL_ZERO_BYTES = 2 * MiB;
constexpr size_t WS_MOD = 1 * MiB;
constexpr size_t WS_ROPE = 2 * MiB;
constexpr size_t WS_TOK = 3 * MiB;
constexpr size_t WS_XC = 5 * MiB;
constexpr size_t WS_WR = 4 * MiB + 512 * 1024;
constexpr size_t WS_WIN = 21 * MiB, WIN_L = 15 * MiB;
constexpr size_t WS_WBR = 51 * MiB, WBR_L = 3 * MiB;
constexpr size_t WS_WOUT = 57 * MiB, WOUT_L = 2 * MiB;
constexpr size_t WS_WGU = 61 * MiB, WGU_L = 32 * MiB;
constexpr size_t WS_WDN = 125 * MiB, WDN_L = 16 * MiB;
constexpr size_t WS_H = 157 * MiB;
constexpr size_t WS_P = 225 * MiB;
constexpr size_t WS_GATES = 514 * MiB;
constexpr size_t WS_OUTS = 517 * MiB;
constexpr size_t WS_HDIR = 619 * MiB;
constexpr size_t WS_Y = WS_HDIR;
constexpr size_t WS_MERGED = 687 * MiB;
constexpr size_t WS_SG = 755 * MiB;
constexpr size_t WS_LIST = 960 * MiB;
constexpr int LIST_CAP = 2 * TG;
constexpr size_t WS_END = 969 * MiB;
constexpr int XS_ROWS = 77824;
constexpr size_t WS_XS = WS_P;
constexpr size_t WS_ACT = WS_P + 152 * MiB;
constexpr size_t WS_YS = WS_P + 190 * MiB;
static_assert(WS_YS + (size_t)XS_ROWS * 2048 <= WS_HDIR + 68 * MiB, "overlay map");
constexpr int CW_BAR = 4096;
constexpr int CW_Q = 8192;
constexpr int CW_ECNT = 16384;

constexpr int RING_OFF = 0, RING_BYTES = 131072;
constexpr int LDSX_OFF = RING_BYTES;
constexpr int LDSCTL_OFF = 144 * 1024 - 512;
constexpr int LDS_BYTES = 147456;

#define RLX_AGENT __ATOMIC_RELAXED, __HIP_MEMORY_SCOPE_AGENT
#define LDS_WAIT() asm volatile("s_waitcnt lgkmcnt(0)" ::: "memory")
#define VM_WAIT() asm volatile("s_waitcnt vmcnt(0)" ::: "memory")

#define XB_TMO      128
#define XB_XCNT(j)  (256  + 64 * (j))
#define XB_XSUB(j)  (1280 + 64 * (j))
#define XB_XGEN(j)  (2304 + 64 * (j))
#define XB_TOP      3328
#define XB_TOPGEN   3392
#define XCD_BAR_WORDS 3456
#define XB_SPIN_CAP (1u << 24)

__device__ __forceinline__ unsigned xb_ld(unsigned* p)              { return __hip_atomic_load(p, __ATOMIC_RELAXED, __HIP_MEMORY_SCOPE_AGENT); }
__device__ __forceinline__ unsigned xb_add(unsigned* p, unsigned v) { return __hip_atomic_fetch_add(p, v, __ATOMIC_RELAXED, __HIP_MEMORY_SCOPE_AGENT); }
__device__ __forceinline__ unsigned xb_xcc_id() { return (unsigned)__builtin_amdgcn_s_getreg((3 << 11) | 20) & 0xFu; }
#define XB_SPIN(cond, bar) do { unsigned _sp = 0; while (cond) { __builtin_amdgcn_s_sleep(1); \
    if ((++_sp & 255u) == 0u) { if (xb_ld(&(bar)[XB_TMO])) break; if (_sp > XB_SPIN_CAP) { atomicAdd(&(bar)[XB_TMO], 1u); break; } } } } while (0)

struct XcdBarrier { unsigned* bar; unsigned x; volatile LAS unsigned* st; };

__device__ __forceinline__ XcdBarrier xcd_barrier_post(unsigned* bar, volatile LAS unsigned* st) {
    XcdBarrier b; b.bar = bar; b.x = xb_xcc_id(); b.st = st;
    if (threadIdx.x == 0) (void)xb_add(&bar[XB_XCNT(b.x)], 1u);
    return b;
}
__device__ __forceinline__ void xcd_barrier_complete(unsigned* bar, unsigned x, unsigned& nloc, unsigned& nx) {
    const unsigned G = gridDim.x * gridDim.y * gridDim.z;
    unsigned sum, cnt, mine, sp = 0u;
    for (;;) {
        sum = 0u; cnt = 0u; mine = 0u;
#pragma unroll
        for (unsigned j = 0; j < 16; ++j) { const unsigned c = xb_ld(&bar[XB_XCNT(j)]); sum += c; cnt += (c > 0u) ? 1u : 0u; mine = (j == x) ? c : mine; }
        if (sum == G) break;
        __builtin_amdgcn_s_sleep(1);
        if ((++sp & 255u) == 0u) { if (xb_ld(&bar[XB_TMO])) break; if (sp > XB_SPIN_CAP) { atomicAdd(&bar[XB_TMO], 1u); break; } }
    }
    nloc = mine > 0u ? mine : 1u; nx = cnt > 0u ? cnt : 1u;
}
__device__ __forceinline__ void xcd_barrier(const XcdBarrier& b) {
    asm volatile("s_waitcnt vmcnt(0)" ::: "memory");
    __syncthreads();
    if (threadIdx.x == 0) {
        unsigned* bar = b.bar;
        __builtin_amdgcn_s_waitcnt(0);
        unsigned nloc = b.st[0], nx = b.st[1];
        if (nloc == 0u) { xcd_barrier_complete(bar, b.x, nloc, nx); b.st[0] = nloc; b.st[1] = nx; }
        const unsigned old = xb_add(&bar[XB_XSUB(b.x)], 1u);
        const unsigned gen = old / nloc;
        if (old + 1u == (gen + 1u) * nloc) {
            __builtin_amdgcn_fence(__ATOMIC_RELEASE, "agent");
            asm volatile("s_waitcnt vmcnt(0)" ::: "memory");
            const unsigned og = xb_add(&bar[XB_TOP], 1u);
            const unsigned tg = og / nx;
            if (og + 1u == (tg + 1u) * nx) xb_add(&bar[XB_TOPGEN], 1u);
            else XB_SPIN(xb_ld(&bar[XB_TOPGEN]) == tg, bar);
            __builtin_amdgcn_fence(__ATOMIC_ACQUIRE, "agent");
            xb_add(&bar[XB_XGEN(b.x)], 1u);
            asm volatile("s_waitcnt vmcnt(0)" ::: "memory");
        } else {
            XB_SPIN(xb_ld(&bar[XB_XGEN(b.x)]) == gen, bar);
            __builtin_amdgcn_fence(__ATOMIC_ACQUIRE, "agent");
            asm volatile("s_waitcnt vmcnt(0)" ::: "memory");
        }
    }
    __syncthreads();
}

struct Frame {
    LAS unsigned char* lds;
    volatile LAS unsigned* MISC;
    unsigned* ctl;
    unsigned char* ws;
    int tid, lane, wave, G, gw, NGW;
    float* out;
};
struct Args { const float* in[21]; float* out; unsigned char* ws; int ph_lo, ph_hi; };
enum { I_X = 0, I_C, I_CTX, I_CCTX, I_WMOD, I_BMOD, I_GNORM, I_WIN, I_BMERGE, I_GQK, I_RPB, I_BMLSTM, I_GML, I_WBRANCH, I_WOUT, I_WGROUP, I_BGROUP, I_WROUTER, I_BROUTER, I_WGU, I_WDN };
__device__ __forceinline__ bool refresh(Frame& F) { int t = threadIdx.x; asm volatile("" : "+v"(t)); F.tid = t; F.lane = t & 63; int w = F.wave; asm volatile("" : "+s"(w)); F.wave = w; F.gw = (int)blockIdx.x * 8 + w; return true; }
__device__ __forceinline__ int dequeue(Frame& F, unsigned* counter, int slot) {
    __syncthreads();
    if (F.tid == 0) F.MISC[slot] = __hip_atomic_fetch_add(counter, 1u, RLX_AGENT);
    __syncthreads();
    return (int)F.MISC[slot];
}
__device__ __forceinline__ unsigned dq_issue(Frame& F, unsigned* counter) { unsigned v = 0u; if (F.tid == 0) v = __hip_atomic_fetch_add(counter, 1u, RLX_AGENT); return v; }
__device__ __forceinline__ int dq_take(Frame& F, unsigned v, int slot) {
    __syncthreads();
    if (F.tid == 0) F.MISC[slot] = v;
    __syncthreads();
    return (int)F.MISC[slot];
}
template <class RowPtr>
__device__ __forceinline__ void transpose_item(const float* W, int ldw, int ncols, int k0, int n0, LAS float* scr, int lane, const RowPtr& rp) {
    float tv[32];
#pragma unroll
    for (int i = 0; i < 32; ++i) { const int kk = 2 * i + (lane >> 5), n = n0 + (lane & 31); tv[i] = (n < ncols) ? W[(size_t)(k0 + kk) * ldw + n] : 0.f; }
#pragma unroll
    for (int i = 0; i < 32; ++i) { const int kk = 2 * i + (lane >> 5); scr[kk * 33 + (lane & 31)] = tv[i]; }
    LDS_WAIT(); asm volatile("" ::: "memory");
    const int c = lane & 7;
#pragma unroll
    for (int j = 0; j < 4; ++j) { const int nl = (lane >> 3) + 8 * j, n = n0 + nl; const LAS float* s = scr + (8 * c) * 33 + nl;
        v4u o; o.x = pk2(s[0 * 33], s[1 * 33]); o.y = pk2(s[2 * 33], s[3 * 33]); o.z = pk2(s[4 * 33], s[5 * 33]); o.w = pk2(s[6 * 33], s[7 * 33]);
        if (n < ncols) *(v4u*)(rp(n) + k0 + 8 * c) = o; }
    LDS_WAIT(); asm volatile("" ::: "memory");
}
constexpr int IT_WIN = 16 * 233, IT_WBR = 3 * 8 * 32, IT_WOUT = 16 * 32, IT_WGU = 32 * 16 * 16, IT_WDN = 32 * 4 * 32, IT_LAYER = IT_WIN + IT_WBR + IT_WOUT + IT_WGU + IT_WDN;

__device__ __forceinline__ void p0_prologue(Frame& F, const Args& A) {
    LAS float* sv = (LAS float*)(F.lds + RING_OFF);
    LAS float* part = (LAS float*)(F.lds + RING_OFF + 17 * 1024 * 4);
    float* MOD = (float*)(F.ws + WS_MOD);
    if ((int)blockIdx.x < DEPTH * 24) {
        for (int idx = F.tid; idx < 17 * 1024; idx += 512) { const int rr = idx >> 10, kk = idx & 1023; const float cv = (rr < 16) ? A.in[I_C][rr * 1024 + kk] : A.in[I_CCTX][kk]; sv[idx] = cv / (1.0f + expf(-cv)); }
        __syncthreads();
        for (int it = blockIdx.x; it < DEPTH * 24; it += F.G) {
            const int l = it / 24, jb = it % 24;
            const int j = jb * 256 + (F.tid & 255), kh = F.tid >> 8;
            float acc[17];
#pragma unroll
            for (int rr = 0; rr < 17; ++rr) acc[rr] = 0.f;
            const float* wp = A.in[I_WMOD] + ((size_t)l * 1024 + kh * 512) * 6144 + j;
            for (int k0 = 0; k0 < 512; k0 += 32) { float wv[32];
#pragma unroll
                for (int u = 0; u < 32; ++u) wv[u] = wp[(size_t)(k0 + u) * 6144];
#pragma unroll
                for (int u = 0; u < 32; ++u) {
#pragma unroll
                    for (int rr = 0; rr < 17; ++rr) acc[rr] += sv[rr * 1024 + kh * 512 + k0 + u] * wv[u]; } }
            if (kh == 1) {
#pragma unroll
                for (int rr = 0; rr < 17; ++rr) part[(F.tid & 255) * 17 + rr] = acc[rr]; }
            __syncthreads();
            if (kh == 0) { const float bm = A.in[I_BMOD][l * 6144 + j];
#pragma unroll
                for (int rr = 0; rr < 17; ++rr) MOD[((size_t)l * 17 + rr) * 6144 + j] = (acc[rr] + part[(F.tid & 255) * 17 + rr]) + bm; }
            __syncthreads();
        }
    }
    __syncthreads();
    LAS float* scr = (LAS float*)(F.lds + RING_OFF + F.wave * 16384);
    bf16* const wsb = (bf16*)F.ws;
    unsigned* itq = F.ctl + CW_Q + 64 * 60;
    for (;;) {
        int it_ = 0; if (F.lane == 0) it_ = (int)__hip_atomic_fetch_add(itq, 16u, RLX_AGENT);
        const int itb = __builtin_amdgcn_readfirstlane(it_); if (itb >= DEPTH * IT_LAYER) break;
        for (int it = itb; it < itb + 16 && it < DEPTH * IT_LAYER; ++it) {
        const int l = it / IT_LAYER; int r = it % IT_LAYER;
        if (r < IT_WIN) { const int kb = r / 233, nb = r % 233; bf16* win = (bf16*)(F.ws + WS_WIN + l * WIN_L);
            transpose_item(A.in[I_WIN] + (size_t)l * DM * INW, INW, INW, kb * 64, nb * 32, scr, F.lane, [=](int n) { int r = n < 4368 ? n : n + 240; if (n < 640 || (n >= 768 && n < 1792)) { const int d = n & 63, nn = d >> 5, rr = d & 31; r = (n & ~63) + 32 * (rr >> 4) + 8 * ((rr >> 2) & 3) + 4 * nn + (rr & 3); } return win + (size_t)r * 1024; }); continue; }
        r -= IT_WIN;
        if (r < IT_WBR) { const int br = r / 256, q = r % 256, kb = q / 32, nb = q % 32; bf16* d = (bf16*)(F.ws + WS_WBR + l * WBR_L) + (size_t)br * 512;
            transpose_item(A.in[I_WBRANCH] + ((size_t)l * 3 + br) * 512 * 1024, 1024, 1024, kb * 64, nb * 32, scr, F.lane, [=](int n) { return d + (size_t)n * 1536; }); continue; }
        r -= IT_WBR;
        if (r < IT_WOUT) { const int kb = r / 32, nb = r % 32; bf16* d = (bf16*)(F.ws + WS_WOUT + l * WOUT_L);
            transpose_item(A.in[I_WOUT] + (size_t)l * 1024 * 1024, 1024, 1024, kb * 64, nb * 32, scr, F.lane, [=](int n) { return d + (size_t)n * 1024; }); continue; }
        r -= IT_WOUT;
        if (r < IT_WGU) { const int e = r / 256, q = r % 256, kb = q / 16, nb = q % 16; bf16* d = (bf16*)(F.ws + WS_WGU + l * WGU_L) + (size_t)e * 512 * 1024;
            transpose_item(A.in[I_WGU] + ((size_t)l * NEXP + e) * 1024 * 512, 512, 512, kb * 64, nb * 32, scr, F.lane,
                [=](int n) { const int m = n & 255, row = (m >> 7) * 256 + ((n >> 8) << 7) + (m & 127); return d + (size_t)row * 1024; }); continue; }
        r -= IT_WGU;
        { const int e = r / 128, q = r % 128, kb = q / 32, nb = q % 32; bf16* d = (bf16*)(F.ws + WS_WDN + l * WDN_L) + (size_t)e * 1024 * 256;
            transpose_item(A.in[I_WDN] + ((size_t)l * NEXP + e) * 256 * 1024, 1024, 1024, kb * 64, nb * 32, scr, F.lane, [=](int n) { return d + (size_t)n * 256; }); }
        }
    }
    for (int i = blockIdx.x * 512 + F.tid; i < DEPTH * 240 * 128; i += F.G * 512) { const int l = i / (240 * 128), q = i % (240 * 128);
        *(v4u*)(F.ws + WS_WIN + l * WIN_L + (size_t)4368 * 2048 + (size_t)q * 16) = (v4u){0u, 0u, 0u, 0u}; }
    for (int i = blockIdx.x * 512 + F.tid; i < DEPTH * 48 * 1024; i += F.G * 512) { const int l = i / (48 * 1024), n = (i >> 10) % 48, k = i & 1023;
        const float wv = (n < 4) ? A.in[I_WGROUP][((size_t)l * 1024 + k) * 4 + n] : (n < 36) ? A.in[I_WROUTER][((size_t)l * 1024 + k) * 32 + (n - 4)] : 0.f;
        const unsigned hi = f2bf(wv), lo = f2bf(wv - __builtin_bit_cast(float, hi << 16));
        bf16* wr = (bf16*)(F.ws + WS_WR) + (size_t)l * 2 * 48 * 1024; wr[n * 1024 + k] = (bf16)hi; wr[48 * 1024 + n * 1024 + k] = (bf16)lo; }
    for (int i = blockIdx.x * 512 + F.tid; i < NLAT * 32; i += F.G * 512) { const int t = i >> 5, k = i & 31, f = k & 15; const float pos = (float)((k < 16) ? (t >> 6) : (t & 63));
        const float inv = exp2f(-(float)f * (13.287712379549449f / 16.0f)); const float ang = pos * inv;
        ((f32x2*)(F.ws + WS_ROPE))[i] = (f32x2){cosf(ang), sinf(ang)}; }
}

__device__ __forceinline__ void phase_norm1(Frame& F, const Args& A, int l, int g) {
    const float* xlat = (l == 0) ? A.in[I_X] : F.out; const float* xctx = (l == 0) ? A.in[I_CTX] : (const float*)(F.ws + WS_XC);
    const float* MOD = (const float*)(F.ws + WS_MOD); bf16* H = (bf16*)(F.ws + WS_H);
    const float* gn = A.in[I_GNORM] + (size_t)(l * 2 + 0) * 1024;
    for (int lr0 = F.gw; lr0 < TG; lr0 += 2 * F.NGW) {
        f32x4 v[2][4]; const float* md[2]; bool ok[2];
#pragma unroll
        for (int k = 0; k < 2; ++k) { const int lr = lr0 + k * F.NGW; ok[k] = lr < TG; if (ok[k]) {
            const int bl = lr / TPS, t = lr % TPS, b = g * GBS + bl;
            const float* src = (t < NLAT) ? xlat + ((size_t)b * NLAT + t) * DM : xctx + ((size_t)b * NCTX + (t - NLAT)) * DM;
            md[k] = MOD + ((size_t)l * 17 + ((t < NLAT) ? b : 16)) * 6144;
            const f32x4* xr = (const f32x4*)src + F.lane;
#pragma unroll
            for (int j = 0; j < 4; ++j) v[k][j] = xr[64 * j]; } }
#pragma unroll
        for (int k = 0; k < 2; ++k) if (ok[k]) { const int lr = lr0 + k * F.NGW; float s = 0.f;
#pragma unroll
            for (int j = 0; j < 4; ++j) s += (v[k][j].x * v[k][j].x + v[k][j].y * v[k][j].y) + (v[k][j].z * v[k][j].z + v[k][j].w * v[k][j].w);
            const float rstd = rsq_(wave_sum(s) * (1.0f / DM) + EPS);
            v2u* o8 = (v2u*)(H + (size_t)lr * DM) + F.lane;
#pragma unroll
            for (int j = 0; j < 4; ++j) { const f32x4 gg = ((const f32x4*)gn)[F.lane + 64 * j], sh = ((const f32x4*)md[k])[F.lane + 64 * j], sc = ((const f32x4*)(md[k] + 1024))[F.lane + 64 * j];
                const f32x4 y = (v[k][j] * rstd * gg) * (1.0f + sc) + sh; o8[64 * j] = (v2u){pk2(y.x, y.y), pk2(y.z, y.w)}; } }
    }
}

struct DenseOrder {
    int nM, nN, nwg, G, c; bool skipctx; const char* A; const char* Bt; size_t a_tile, b_tile;
    __device__ __forceinline__ bool next(int i, pg8::Unit& u) const {
        const long L = (long)i * G + c; if (L >= nwg) return false;
        int wgid = (int)L; { const int q = nwg / pg8::NXCD, r = nwg % pg8::NXCD, xcd = wgid % pg8::NXCD, off = wgid / pg8::NXCD; wgid = (xcd < r ? xcd * (q + 1) : r * (q + 1) + (xcd - r) * q) + off; }
        const int nig = pg8::WGM * nN, gid = wgid / nig, fm = gid * pg8::WGM, gsz = (nM - fm) < pg8::WGM ? (nM - fm) : pg8::WGM;
        const int pmq = fm + ((wgid % nig) % gsz), pn = (wgid % nig) / gsz;
        const int pm = skipctx ? (pmq >> 4) * 17 + (pmq & 15) : pmq;
        u.pm = pm; u.pn = pn; u.aux = 0; u.gl = nullptr; u.gn = 0; u.a = A + (size_t)pm * a_tile; u.b = Bt + (size_t)pn * b_tile; return true;
    }
};
struct BranchOrder {
    int nM, G, c; bool skipctx; const char* A; const char* Bt;
    __device__ __forceinline__ bool next(int i, pg8::Unit& u) const {
        const int tl = (i / 3) * G + c, br = i % 3; if (tl >= nM * 4) return false;
        const int pmq = tl >> 2, pn = tl & 3, pm = skipctx ? (pmq >> 4) * 17 + (pmq & 15) : pmq;
        u.pm = pm; u.pn = pn; u.aux = br; u.gl = nullptr; u.gn = 0; u.a = A + (size_t)pm * 256 * OW * 2 + (size_t)br * 512 * 2; u.b = Bt + (size_t)br * 1024 * 512 * 2 + (size_t)pn * 256 * 512 * 2; return true;
    }
};
struct MoeOrder {
    int ntiles, ncol, G, c; const LAS int* tile_e; const LAS int* eoff; const unsigned* ecnt; const int* list; const char* A; size_t a_tile; const char* Bt; size_t e_stride, b_tile;
    __device__ __forceinline__ bool next(int i, pg8::Unit& u) const {
        const int L = i * G + c, rt = L / ncol, pn = L % ncol; if (rt >= ntiles) return false;
        const int e = __builtin_amdgcn_readfirstlane(tile_e[rt]);
        u.pm = rt; u.pn = pn; u.aux = e; u.a = A + (size_t)rt * a_tile; u.b = Bt + (size_t)e * e_stride + (size_t)pn * b_tile;
        if (list) { const int rank0 = rt * 256 - __builtin_amdgcn_readfirstlane(eoff[e]); u.gl = list + (size_t)e * LIST_CAP + rank0; u.gn = __builtin_amdgcn_readfirstlane(eoff[400 + e]) - rank0; } else { u.gl = nullptr; u.gn = 0; }
        return true;
    }
};

struct EpiInproj {
    static constexpr bool PERM = true, HOOK = false;
    bf16* P; float* GT; const float* bml; bf16* SG; const float* bmerge; const float* gq; const f32x2* rope; LAS float* ssq;
    __device__ __forceinline__ void operator()(const f32x4 (&acc)[2][2][4][2], const pg8::Unit& u, int wr, int wc, int fr, int fq) const {
        const int row0 = u.pm * 256 + wr * 64 + fr;
        if (u.pn < 7) {
            int typ[2];
#pragma unroll
            for (int bj = 0; bj < 2; ++bj) { const int col = u.pn * 256 + bj * 128; typ[bj] = col < 512 ? 0 : col < 640 ? 1 : col < 768 ? -1 : col < 1280 ? 2 : 3; }
            const int ti_ = u.pm % 17; const bool lat_ = ti_ < 16 && u.pn < 3; const int tb_ = ti_ * 256 + wr * 64 + fr;
            f32x4 csA[4][2];
#define ROPE_LOAD(dst, ai_) do { _Pragma("unroll") for (int m = 0; m < 4; ++m) { if (lat_) { const f32x4* rp = (const f32x4*)(rope + (size_t)(tb_ + (ai_) * 128 + m * 16) * 32 + 16 * (wc & 1) + 4 * fq); dst[m][0] = rp[0]; dst[m][1] = rp[1]; } \
                else { dst[m][0] = (f32x4){1.f, 0.f, 1.f, 0.f}; dst[m][1] = (f32x4){1.f, 0.f, 1.f, 0.f}; } } } while (0)
            ROPE_LOAD(csA, 0);
#pragma unroll
            for (int ai = 0; ai < 2; ++ai)
#pragma unroll
                for (int m = 0; m < 4; ++m)
#pragma unroll
                    for (int bj = 0; bj < 2; ++bj) { const f32x4 v0 = acc[ai][bj][m][0], v1 = acc[ai][bj][m][1];
                        float ss = (v0[0] * v0[0] + v0[1] * v0[1]) + (v0[2] * v0[2] + v0[3] * v0[3]) + (v1[0] * v1[0] + v1[1] * v1[1]) + (v1[2] * v1[2] + v1[3] * v1[3]);
                        { auto r16 = __builtin_amdgcn_permlane16_swap(__float_as_uint(ss), __float_as_uint(ss), false, false); ss = __uint_as_float(r16[0]) + __uint_as_float(r16[1]);
                          auto r32 = __builtin_amdgcn_permlane32_swap(__float_as_uint(ss), __float_as_uint(ss), false, false); ss = __uint_as_float(r32[0]) + __uint_as_float(r32[1]); }
                        if (fq == 0) ssq[((ai * 128 + wr * 64 + m * 16 + fr) * 2 + bj) * 4 + wc] = ss; }
            asm volatile("s_waitcnt lgkmcnt(0)\n\ts_barrier" ::: "memory");
            const int ws = wc & 1;
            f32x4 g0[2], g1[2];
#pragma unroll
            for (int bj = 0; bj < 2; ++bj) { const int ty = typ[bj] < 0 ? 0 : typ[bj]; g0[bj] = *(const f32x4*)(gq + ty * 64 + 16 * ws + 4 * fq); g1[bj] = *(const f32x4*)(gq + ty * 64 + 32 + 16 * ws + 4 * fq); }
#pragma unroll
            for (int ai = 0; ai < 2; ++ai) {
                if (ai == 1) ROPE_LOAD(csA, 1);
#pragma unroll
                for (int m = 0; m < 4; ++m) { const int rowl = ai * 128 + wr * 64 + m * 16 + fr; bf16* rowp = P + (size_t)(row0 + ai * 128 + m * 16) * PW + u.pn * 256 + wc * 32 + 8 * fq;
                    const f32x4 cs0 = csA[m][0], cs1 = csA[m][1];
#pragma unroll
                    for (int bj = 0; bj < 2; ++bj) { f32x4 v0 = acc[ai][bj][m][0], v1 = acc[ai][bj][m][1];
                        if (typ[bj] >= 0) { const float tot = ssq[(rowl * 2 + bj) * 4 + wc] + ssq[(rowl * 2 + bj) * 4 + (wc ^ 1)]; const float rstd = rsq_(tot * (1.0f / 64.0f) + EPS);
                            v0 = v0 * rstd * g0[bj]; v1 = v1 * rstd * g1[bj];
                            if (typ[bj] < 2) { const f32x4 a = v0, b = v1;
                                v0[0] = a[0] * cs0[0] - b[0] * cs0[1]; v1[0] = b[0] * cs0[0] + a[0] * cs0[1]; v0[1] = a[1] * cs0[2] - b[1] * cs0[3]; v1[1] = b[1] * cs0[2] + a[1] * cs0[3];
                                v0[2] = a[2] * cs1[0] - b[2] * cs1[1]; v1[2] = b[2] * cs1[0] + a[2] * cs1[1]; v0[3] = a[3] * cs1[2] - b[3] * cs1[3]; v1[3] = b[3] * cs1[2] + a[3] * cs1[3]; }
                            if ((typ[bj] & 1) == 0) { v0 = v0 * QSCALE; v1 = v1 * QSCALE; } }
                        v4u w; w.x = pg8::cvt_pk_bf16(v0[0], v0[1]); w.y = pg8::cvt_pk_bf16(v0[2], v0[3]); w.z = pg8::cvt_pk_bf16(v1[0], v1[1]); w.w = pg8::cvt_pk_bf16(v1[2], v1[3]);
                        *(v4u*)(rowp + bj * 128) = w; } }
            }
#undef ROPE_LOAD
        } else if (u.pn < 17) {
#pragma unroll
            for (int ai = 0; ai < 2; ++ai)
#pragma unroll
                for (int m = 0; m < 4; ++m) { bf16* rowp = P + (size_t)(row0 + ai * 128 + m * 16) * PW + u.pn * 256 + wc * 32 + 8 * fq;
#pragma unroll
                    for (int bj = 0; bj < 2; ++bj) { const f32x4 v0 = acc[ai][bj][m][0], v1 = acc[ai][bj][m][1];
                        v4u w; w.x = pg8::cvt_pk_bf16(v0[0], v0[1]); w.y = pg8::cvt_pk_bf16(v0[2], v0[3]); w.z = pg8::cvt_pk_bf16(v1[0], v1[1]); w.w = pg8::cvt_pk_bf16(v1[2], v1[3]);
                        *(v4u*)(rowp + bj * 128) = w; } }
        } else if (u.pn == 17) {
            if (wc == 0 && fq < 2) {
                const f32x4 b0 = *(const f32x4*)(bml + 8 * fq), b1 = *(const f32x4*)(bml + 8 * fq + 4);
#pragma unroll
                for (int ai = 0; ai < 2; ++ai)
#pragma unroll
                    for (int m = 0; m < 4; ++m) { float* rowp = GT + (size_t)(row0 + ai * 128 + m * 16) * 16 + 8 * fq;
                        *(f32x4*)(rowp) = acc[ai][0][m][0] + b0; *(f32x4*)(rowp + 4) = acc[ai][0][m][1] + b1; }
            }
        } else {
            const int col0 = (u.pn - 18) * 256 + wc * 32 + 8 * fq;
            f32x4 bv[2][2];
#pragma unroll
            for (int bj = 0; bj < 2; ++bj)
#pragma unroll
                for (int n = 0; n < 2; ++n) bv[bj][n] = *(const f32x4*)(bmerge + col0 + bj * 128 + 4 * n);
            v4u* sgf = (v4u*)SG + ((((size_t)u.pm * 12 + (u.pn - 18)) * 8 + (wr * 4 + wc)) * 16) * 64 + (fq * 16 + fr);
#pragma unroll
            for (int ai = 0; ai < 2; ++ai)
#pragma unroll
                for (int m = 0; m < 4; ++m)
#pragma unroll
                    for (int bj = 0; bj < 2; ++bj) { f32x4 v0 = acc[ai][bj][m][0] + bv[bj][0], v1 = acc[ai][bj][m][1] + bv[bj][1];
#pragma unroll
                        for (int i = 0; i < 4; ++i) { v0[i] = sigmoidf_(v0[i]); v1[i] = sigmoidf_(v1[i]); }
                        v4u w; w.x = pg8::cvt_pk_bf16(v0[0], v0[1]); w.y = pg8::cvt_pk_bf16(v0[2], v0[3]); w.z = pg8::cvt_pk_bf16(v1[0], v1[1]); w.w = pg8::cvt_pk_bf16(v1[2], v1[3]);
                        sgf[(ai * 8 + m * 2 + bj) * 64] = w; }
        }
    }
};
struct EpiBranch {
    static constexpr bool PERM = true, HOOK = true;
    const bf16* SG; bf16* MG;
    __device__ __forceinline__ void mid(f32x4 (&acc)[2][2][4][2], const pg8::Unit& u, int seg, int wr, int wc, int fr, int fq) const {
        const v4u* sgf = (const v4u*)SG + ((((size_t)u.pm * 12 + u.pn) * 8 + (wr * 4 + wc)) * 16) * 64 + (fq * 16 + fr);
#pragma unroll
        for (int ai = 0; ai < 2; ++ai) {
            v4u sa[4][2], sb[4][2];
#pragma unroll
            for (int m = 0; m < 4; ++m) {
#pragma unroll
                for (int bj = 0; bj < 2; ++bj) { const v4u* p = sgf + (size_t)(seg * 4) * 8192 + (ai * 8 + m * 2 + bj) * 64; sa[m][bj] = p[0]; sb[m][bj] = p[4 * 8192]; } }
#pragma unroll
            for (int m = 0; m < 4; ++m)
#pragma unroll
                for (int bj = 0; bj < 2; ++bj) { const v4u a = sa[m][bj], b = sb[m][bj]; f32x4& a0 = acc[ai][bj][m][0]; f32x4& a1 = acc[ai][bj][m][1];
                    a0[0] *= bf_lo(a.x) * __builtin_amdgcn_rcpf(bf_lo(b.x)); a0[1] *= bf_hi(a.x) * __builtin_amdgcn_rcpf(bf_hi(b.x)); a0[2] *= bf_lo(a.y) * __builtin_amdgcn_rcpf(bf_lo(b.y)); a0[3] *= bf_hi(a.y) * __builtin_amdgcn_rcpf(bf_hi(b.y));
                    a1[0] *= bf_lo(a.z) * __builtin_amdgcn_rcpf(bf_lo(b.z)); a1[1] *= bf_hi(a.z) * __builtin_amdgcn_rcpf(bf_hi(b.z)); a1[2] *= bf_lo(a.w) * __builtin_amdgcn_rcpf(bf_lo(b.w)); a1[3] *= bf_hi(a.w) * __builtin_amdgcn_rcpf(bf_hi(b.w)); }
        }
    }
    __device__ __forceinline__ void operator()(const f32x4 (&acc)[2][2][4][2], const pg8::Unit& u, int wr, int wc, int fr, int fq) const {
        const int row0 = u.pm * 256 + wr * 64 + fr, col0 = u.pn * 256 + wc * 32 + 8 * fq;
        const v4u* sgf = (const v4u*)SG + ((((size_t)u.pm * 12 + u.pn) * 8 + (wr * 4 + wc)) * 16) * 64 + (fq * 16 + fr);
#pragma unroll
        for (int ai = 0; ai < 2; ++ai) {
            v4u sg[4][2];
#pragma unroll
            for (int m = 0; m < 4; ++m) {
#pragma unroll
                for (int bj = 0; bj < 2; ++bj) sg[m][bj] = sgf[(size_t)8 * 8192 + (ai * 8 + m * 2 + bj) * 64]; }
#pragma unroll
            for (int m = 0; m < 4; ++m) { const size_t row = (size_t)(row0 + ai * 128 + m * 16);
#pragma unroll
                for (int bj = 0; bj < 2; ++bj) { const v4u s = sg[m][bj]; const f32x4 a0 = acc[ai][bj][m][0], a1 = acc[ai][bj][m][1];
                    v4u w; w.x = pg8::cvt_pk_bf16(a0[0] * bf_lo(s.x), a0[1] * bf_hi(s.x)); w.y = pg8::cvt_pk_bf16(a0[2] * bf_lo(s.y), a0[3] * bf_hi(s.y));
                    w.z = pg8::cvt_pk_bf16(a1[0] * bf_lo(s.z), a1[1] * bf_hi(s.z)); w.w = pg8::cvt_pk_bf16(a1[2] * bf_lo(s.w), a1[3] * bf_hi(s.w));
                    *(v4u*)(MG + row * 1024 + col0 + bj * 128) = w; } }
        }
    }
};
struct EpiWout {
    static constexpr bool PERM = true, HOOK = false;
    bf16* Y;
    __device__ __forceinline__ void operator()(const f32x4 (&acc)[2][2][4][2], const pg8::Unit& u, int wr, int wc, int fr, int fq) const {
        const int row0 = u.pm * 256 + wr * 64 + fr, col0 = u.pn * 256 + wc * 32 + 8 * fq;
#pragma unroll
        for (int ai = 0; ai < 2; ++ai)
#pragma unroll
            for (int m = 0; m < 4; ++m) { bf16* rowp = Y + (size_t)(row0 + ai * 128 + m * 16) * DM + col0;
#pragma unroll
                for (int bj = 0; bj < 2; ++bj) { const f32x4 v0 = acc[ai][bj][m][0], v1 = acc[ai][bj][m][1];
                    v4u w; w.x = pg8::cvt_pk_bf16(v0[0], v0[1]); w.y = pg8::cvt_pk_bf16(v0[2], v0[3]); w.z = pg8::cvt_pk_bf16(v1[0], v1[1]); w.w = pg8::cvt_pk_bf16(v1[2], v1[3]);
                    *(v4u*)(rowp + bj * 128) = w; } }
    }
};
struct EpiMoe1 {
    static constexpr bool PERM = true, HOOK = false;
    bf16* ACT;
    __device__ __forceinline__ void operator()(const f32x4 (&acc)[2][2][4][2], const pg8::Unit& u, int wr, int wc, int fr, int fq) const {
        const int row0 = u.pm * 256 + wr * 64 + fr, col0 = u.pn * 128 + wc * 32 + 8 * fq;
#pragma unroll
        for (int ai = 0; ai < 2; ++ai)
#pragma unroll
            for (int m = 0; m < 4; ++m) { bf16* rowp = ACT + (size_t)(row0 + ai * 128 + m * 16) * DEXP + col0; float r[8];
#pragma unroll
                for (int n = 0; n < 2; ++n)
#pragma unroll
                    for (int i = 0; i < 4; ++i) { const float gt = acc[ai][0][m][n][i], up = acc[ai][1][m][n][i]; r[4 * n + i] = gt * sigmoidf_(gt) * up; }
                v4u w; w.x = pg8::cvt_pk_bf16(r[0], r[1]); w.y = pg8::cvt_pk_bf16(r[2], r[3]); w.z = pg8::cvt_pk_bf16(r[4], r[5]); w.w = pg8::cvt_pk_bf16(r[6], r[7]);
                *(v4u*)rowp = w; }
    }
};
struct EpiMoe2 {
    static constexpr bool PERM = true, HOOK = false;
    bf16* YS;
    __device__ __forceinline__ void operator()(const f32x4 (&acc)[2][2][4][2], const pg8::Unit& u, int wr, int wc, int fr, int fq) const {
        const int row0 = u.pm * 256 + wr * 64 + fr, col0 = u.pn * 256 + wc * 32 + 8 * fq;
#pragma unroll
        for (int ai = 0; ai < 2; ++ai)
#pragma unroll
            for (int m = 0; m < 4; ++m) { bf16* rowp = YS + (size_t)(row0 + ai * 128 + m * 16) * DM + col0;
#pragma unroll
                for (int bj = 0; bj < 2; ++bj) { const f32x4 v0 = acc[ai][bj][m][0], v1 = acc[ai][bj][m][1];
                    v4u w; w.x = pg8::cvt_pk_bf16(v0[0], v0[1]); w.y = pg8::cvt_pk_bf16(v0[2], v0[3]); w.z = pg8::cvt_pk_bf16(v1[0], v1[1]); w.w = pg8::cvt_pk_bf16(v1[2], v1[3]);
                    *(v4u*)(rowp + bj * 128) = w; } }
    }
};

__device__ __forceinline__ void qk_head8(v4u& w, const float* gain, const f32x2* rope  , int lane, float post) {
    float x[8] = {bf_lo(w.x), bf_hi(w.x), bf_lo(w.y), bf_hi(w.y), bf_lo(w.z), bf_hi(w.z), bf_lo(w.w), bf_hi(w.w)};
    float ss = 0.f;
#pragma unroll
    for (int e = 0; e < 8; ++e) ss += x[e] * x[e];
    ss += __shfl_xor(ss, 1); ss += __shfl_xor(ss, 2); ss += __shfl_xor(ss, 4);
    const float rstd = rsq_(ss * (1.0f / 64.0f) + EPS);
    const int j = lane & 7;
#pragma unroll
    for (int e = 0; e < 8; ++e) x[e] = x[e] * rstd * gain[j * 8 + e];
    if (rope) {
#pragma unroll
        for (int e = 0; e < 8; ++e) { const float part = __shfl_xor(x[e], 4); const f32x2 cs = rope[(j & 3) * 8 + e];
            x[e] = (j < 4) ? (x[e] * cs.x - part * cs.y) : (x[e] * cs.x + part * cs.y); }
    }
#pragma unroll
    for (int e = 0; e < 8; ++e) x[e] *= post;
    w.x = pk2(x[0], x[1]); w.y = pk2(x[2], x[3]); w.z = pk2(x[4], x[5]); w.w = pk2(x[6], x[7]);
}
__device__ __forceinline__ void phase_qknorm(Frame& F, const Args& A, int l, bool commit = true, bool dummy = false) {
    bf16* P = (bf16*)(F.ws + WS_P); bf16* DP = dummy ? (bf16*)(F.ws + WS_OUTS) : P; const int dpw = dummy ? 2048 : PW; const float* gq = A.in[I_GQK] + (size_t)l * 4 * 64; const f32x2* ROPE = (const f32x2*)(F.ws + WS_ROPE);
    for (int lr0 = F.gw; lr0 < TG; lr0 += 2 * F.NGW) {
        v4u w[2][4]; bool ok[2];
#pragma unroll
        for (int k = 0; k < 2; ++k) { const int lr = lr0 + k * F.NGW; ok[k] = lr < TG; if (ok[k]) { bf16* prow = P + (size_t)lr * PW;
            w[k][0] = *((v4u*)(prow + C_AQ) + F.lane); w[k][1] = *((v4u*)(prow + C_AK) + (F.lane & 15)); w[k][2] = *((v4u*)(prow + C_BQ) + F.lane); w[k][3] = *((v4u*)(prow + C_BK) + F.lane); } }
#pragma unroll
        for (int k = 0; k < 2; ++k) if (ok[k]) { const int lr = lr0 + k * F.NGW, t = lr % TPS; bf16* prow = DP + (size_t)lr * dpw; const f32x2* rp = (t < NLAT) ? ROPE + (size_t)t * 32 : nullptr;
            qk_head8(w[k][0], gq, rp, F.lane, QSCALE); qk_head8(w[k][1], gq + 64, rp, F.lane, 1.0f); qk_head8(w[k][2], gq + 128, nullptr, F.lane, QSCALE); qk_head8(w[k][3], gq + 192, nullptr, F.lane, 1.0f);
            if (commit) { *((v4u*)(prow + C_AQ) + F.lane) = w[k][0]; if (F.lane < 16) *((v4u*)(prow + C_AK) + F.lane) = w[k][1]; *((v4u*)(prow + C_BQ) + F.lane) = w[k][2]; *((v4u*)(prow + C_BK) + F.lane) = w[k][3]; } }
    }
}

__device__ __forceinline__ void phase_mlstm_finish(Frame& F, const Args& A, int l) {
    const bf16* HD = (const bf16*)(F.ws + WS_HDIR); const bf16* P = (const bf16*)(F.ws + WS_P); bf16* OUTS = (bf16*)(F.ws + WS_OUTS); const float* gm = A.in[I_GML] + (size_t)l * 512 + F.lane * 8;
    const f32x4 g0 = *(const f32x4*)gm, g1 = *(const f32x4*)(gm + 4);
    const float gg[8] = {g0.x, g0.y, g0.z, g0.w, g1.x, g1.y, g1.z, g1.w};
    for (int lr0 = F.gw; lr0 < TG; lr0 += 2 * F.NGW) {
        v4u ra[2], rb[2], ro[2]; bool ok[2];
#pragma unroll
        for (int k = 0; k < 2; ++k) { const int lr = lr0 + k * F.NGW; ok[k] = lr < TG && !(l == DEPTH - 1 && (lr % TPS) >= NLAT); if (ok[k]) {
            ra[k] = *((const v4u*)(HD + (size_t)lr * 512) + F.lane); rb[k] = *((const v4u*)(HD + ((size_t)TG + lr) * 512) + F.lane); ro[k] = *((const v4u*)(P + (size_t)lr * PW + C_CO) + F.lane); } }
#pragma unroll
        for (int k = 0; k < 2; ++k) if (ok[k]) { const int lr = lr0 + k * F.NGW; const v4u a = ra[k], b = rb[k], og = ro[k];
            float h[8] = {bf_lo(a.x) + bf_lo(b.x), bf_hi(a.x) + bf_hi(b.x), bf_lo(a.y) + bf_lo(b.y), bf_hi(a.y) + bf_hi(b.y), bf_lo(a.z) + bf_lo(b.z), bf_hi(a.z) + bf_hi(b.z), bf_lo(a.w) + bf_lo(b.w), bf_hi(a.w) + bf_hi(b.w)};
            const float o[8] = {bf_lo(og.x), bf_hi(og.x), bf_lo(og.y), bf_hi(og.y), bf_lo(og.z), bf_hi(og.z), bf_lo(og.w), bf_hi(og.w)};
            float ss = 0.f;
#pragma unroll
            for (int e = 0; e < 8; ++e) ss += h[e] * h[e];
            ss = row16_sum(ss);
            const float rstd = rsq_(ss * (1.0f / 128.0f) + EPS);
#pragma unroll
            for (int e = 0; e < 8; ++e) h[e] = h[e] * rstd * gg[e] * sigmoidf_(o[e]);
            *((v4u*)(OUTS + (size_t)lr * OW + 1024) + F.lane) = (v4u){pk2(h[0], h[1]), pk2(h[2], h[3]), pk2(h[4], h[5]), pk2(h[6], h[7])}; }
    }
}

__device__ __forceinline__ void phase_norm2_route(Frame& F, const Args& A, int l, int g, bool commit = true) {
    const float* xlat = (l == 0) ? A.in[I_X] : F.out; const float* xctx = (l == 0) ? A.in[I_CTX] : (const float*)(F.ws + WS_XC); const bf16* Y = (const bf16*)(F.ws + WS_Y);
    const float* MOD = (const float*)(F.ws + WS_MOD); bf16* H = (bf16*)(F.ws + WS_H); unsigned* TOK = (unsigned*)(F.ws + WS_TOK);
    const float* gn = A.in[I_GNORM] + (size_t)(l * 2 + 1) * 1024;
    const bf16* WR = (const bf16*)(F.ws + WS_WR) + (size_t)l * 2 * 48 * 1024;
    unsigned* ecnt = F.ctl + CW_ECNT + 64 * (l * 2 + g); int* LIST = (int*)(F.ws + WS_LIST);
    constexpr int TP2 = 2064;
    LAS unsigned char* THI = F.lds; LAS unsigned char* TLO = F.lds + 16 * TP2;
    LAS float* part = (LAS float*)(F.lds + 66048);
    LAS float* LG = (LAS float*)(F.lds + 90624);
    LAS unsigned* rec = (LAS unsigned*)(F.lds + 93696);
    LAS unsigned* blkcnt = (LAS unsigned*)(F.lds + 98304); LAS unsigned* blkbase = blkcnt + 32;
    const int w = F.wave, fr = F.lane & 15, fq = F.lane >> 4;
    bf16x8 bh[4][3], bo[4][3];
#pragma unroll
    for (int ks = 0; ks < 4; ++ks)
#pragma unroll
        for (int nt = 0; nt < 3; ++nt) { const bf16* p = WR + (size_t)(16 * nt + fr) * 1024 + 128 * w + 32 * ks + 8 * fq; bh[ks][nt] = *(const bf16x8*)p; bo[ks][nt] = *(const bf16x8*)(p + 48 * 1024); }
    if (F.tid < 32) blkcnt[F.tid] = 0u;
    __syncthreads();
    f32x4 xv[2][4]; v2u yv[2][4];
#define RT_LOAD(gi_) do { const int lr0_ = (gi_) * 16; if ((gi_) < TG / 16 && !(l == DEPTH - 1 && (lr0_ % TPS) >= NLAT)) { _Pragma("unroll") for (int rr = 0; rr < 2; ++rr) { \
        const int lr_ = lr0_ + 2 * w + rr, bl_ = lr_ / TPS, t_ = lr_ % TPS, b_ = g * GBS + bl_; \
        const float* src_ = (t_ < NLAT) ? xlat + ((size_t)b_ * NLAT + t_) * DM : xctx + ((size_t)b_ * NCTX + (t_ - NLAT)) * DM; \
        _Pragma("unroll") for (int j = 0; j < 4; ++j) { xv[rr][j] = ((const f32x4*)src_)[F.lane + 64 * j]; yv[rr][j] = ((const v2u*)(Y + (size_t)lr_ * DM))[F.lane + 64 * j]; } } } } while (0)
    RT_LOAD((int)blockIdx.x);
    int it = 0;
    for (int gi = blockIdx.x; gi < TG / 16; gi += F.G, ++it) {
        const int lr0 = gi * 16; const bool valid = !(l == DEPTH - 1 && (lr0 % TPS) >= NLAT);
        if (valid) {
#pragma unroll
            for (int rr = 0; rr < 2; ++rr) {
                const int r = 2 * w + rr, lr = lr0 + r, bl = lr / TPS, t = lr % TPS, b = g * GBS + bl;
                const float* md = MOD + ((size_t)l * 17 + ((t < NLAT) ? b : 16)) * 6144;
                f32x4 v[4]; float s = 0.f;
#pragma unroll
                for (int j = 0; j < 4; ++j) { const v2u yy = yv[rr][j]; const f32x4 g1 = ((const f32x4*)(md + 2048))[F.lane + 64 * j]; v[j] = xv[rr][j];
                    v[j].x += g1.x * bf_lo(yy.x); v[j].y += g1.y * bf_hi(yy.x); v[j].z += g1.z * bf_lo(yy.y); v[j].w += g1.w * bf_hi(yy.y);
                    s += (v[j].x * v[j].x + v[j].y * v[j].y) + (v[j].z * v[j].z + v[j].w * v[j].w); }
                const float rstd = rsq_(wave_sum(s) * (1.0f / DM) + EPS);
                v2u* o8 = (v2u*)(H + (size_t)lr * DM) + F.lane;
#pragma unroll
                for (int j = 0; j < 4; ++j) { const f32x4 gg = ((const f32x4*)gn)[F.lane + 64 * j], sh = ((const f32x4*)(md + 3072))[F.lane + 64 * j], sc = ((const f32x4*)(md + 4096))[F.lane + 64 * j];
                    const f32x4 y = (v[j] * rstd * gg) * (1.0f + sc) + sh;
                    const unsigned h0 = pk2(y.x, y.y), h1 = pk2(y.z, y.w);
                    const unsigned l0 = pk2(y.x - bf_lo(h0), y.y - bf_hi(h0)), l1 = pk2(y.z - bf_lo(h1), y.w - bf_hi(h1));
                    o8[64 * j] = (v2u){h0, h1};
                    *(LAS v2u*)(THI + r * TP2 + (64 * j + F.lane) * 8) = (v2u){h0, h1}; *(LAS v2u*)(TLO + r * TP2 + (64 * j + F.lane) * 8) = (v2u){l0, l1}; }
            }
        }
        RT_LOAD(gi + F.G);
        LDS_BARRIER();
        if (valid) {
            f32x4 acc[3];
#pragma unroll
            for (int nt = 0; nt < 3; ++nt) acc[nt] = (f32x4){0.f, 0.f, 0.f, 0.f};
#pragma unroll
            for (int ks = 0; ks < 4; ++ks) { const bf16x8 ah = *(const LAS bf16x8*)(THI + fr * TP2 + (128 * w + 32 * ks + 8 * fq) * 2), al = *(const LAS bf16x8*)(TLO + fr * TP2 + (128 * w + 32 * ks + 8 * fq) * 2);
#pragma unroll
                for (int nt = 0; nt < 3; ++nt) { acc[nt] = __builtin_amdgcn_mfma_f32_16x16x32_bf16(ah, bh[ks][nt], acc[nt], 0, 0, 0); acc[nt] = __builtin_amdgcn_mfma_f32_16x16x32_bf16(ah, bo[ks][nt], acc[nt], 0, 0, 0);
                    acc[nt] = __builtin_amdgcn_mfma_f32_16x16x32_bf16(al, bh[ks][nt], acc[nt], 0, 0, 0); } }
#pragma unroll
            for (int nt = 0; nt < 3; ++nt)
#pragma unroll
                for (int i = 0; i < 4; ++i) part[(w * 16 + 4 * fq + i) * 48 + 16 * nt + fr] = acc[nt][i];
        }
        LDS_BARRIER();
        if (valid) for (int idx = F.tid; idx < 768; idx += 512) { const int row = idx / 48, n = idx % 48; float s = 0.f;
#pragma unroll
            for (int w8 = 0; w8 < 8; ++w8) s += part[(w8 * 16 + row) * 48 + n];
            LG[idx] = s + ((n < 4) ? A.in[I_BGROUP][l * 4 + n] : (n < 36) ? A.in[I_BROUTER][l * 32 + n - 4] : 0.f); }
        LDS_BARRIER();
        if (F.tid < 16) {
            const int li = it * 16 + F.tid;
            if (!valid) rec[li * 8] = 0xffffffffu;
            else {
                const LAS float* lg = LG + F.tid * 48;
                int gs = 0; float gm = lg[0];
#pragma unroll
                for (int o = 1; o < 4; ++o) if (lg[o] > gm) { gm = lg[o]; gs = o; }
                float gden = 0.f;
#pragma unroll
                for (int o = 0; o < 4; ++o) gden += expf(lg[o] - gm);
                const float pgs = 1.0f / gden;
                const LAS float* ls = lg + 4 + gs * 8;
                int i0 = 0; float m0 = ls[0];
#pragma unroll
                for (int k = 1; k < 8; ++k) if (ls[k] > m0) { m0 = ls[k]; i0 = k; }
                int i1 = -1; float m1 = -INFINITY;
#pragma unroll
                for (int k = 0; k < 8; ++k) if (k != i0 && ls[k] > m1) { m1 = ls[k]; i1 = k; }
                const float ed = expf(m1 - m0); const float w0 = pgs / (1.0f + ed), w1 = pgs * ed / (1.0f + ed);
                const unsigned e0 = gs * 8 + i0, e1 = gs * 8 + i1;
                const unsigned r0 = atomicAdd((unsigned*)(blkcnt + e0), 1u), r1 = atomicAdd((unsigned*)(blkcnt + e1), 1u);
                rec[li * 8 + 0] = e0; rec[li * 8 + 1] = r0; rec[li * 8 + 2] = e1; rec[li * 8 + 3] = r1; rec[li * 8 + 4] = __float_as_uint(w0); rec[li * 8 + 5] = __float_as_uint(w1);
            }
        }
    }
#undef RT_LOAD
    __syncthreads();
    if (F.tid < 32) { const unsigned n = blkcnt[F.tid]; blkbase[F.tid] = (n && commit) ? __hip_atomic_fetch_add(ecnt + F.tid, n, RLX_AGENT) : 0u; }
    __syncthreads();
    for (int li = F.tid; li < it * 16; li += 512) { const int lr = ((int)blockIdx.x + (li >> 4) * F.G) * 16 + (li & 15);
        const unsigned e0 = rec[li * 8 + 0]; if (e0 == 0xffffffffu) continue;
        const unsigned e1 = rec[li * 8 + 2];
        v4u a; a.x = e0; a.y = blkbase[e0] + rec[li * 8 + 1]; a.z = e1; a.w = blkbase[e1] + rec[li * 8 + 3];
        v4u bb; bb.x = rec[li * 8 + 4]; bb.y = rec[li * 8 + 5]; bb.z = 0u; bb.w = 0u;
        if (commit) { *(v4u*)(TOK + (size_t)lr * 8) = a; *(v4u*)(TOK + (size_t)lr * 8 + 4) = bb; LIST[(size_t)e0 * LIST_CAP + a.y] = lr; LIST[(size_t)e1 * LIST_CAP + a.w] = lr; } }
    __syncthreads();
}

__device__ __forceinline__ void moe_tables(Frame& F, const Args& A, int l, int g, LAS int* eoff, LAS int* tile_e) {
    const unsigned* ecnt = F.ctl + CW_ECNT + 64 * (l * 2 + g);
    __syncthreads();
    if (F.tid < 33) { int off = 0; for (int e = 0; e < F.tid; ++e) off += (int)((__hip_atomic_load(ecnt + e, RLX_AGENT) + 255u) & ~255u); eoff[F.tid] = off; }
    if (F.tid >= 64 && F.tid < 96) eoff[400 + F.tid - 64] = (int)__hip_atomic_load(ecnt + (F.tid - 64), RLX_AGENT);
    __syncthreads();
    for (int rt = F.tid; rt < XS_ROWS / 256; rt += 512) { int e = 31; for (int k = 31; k >= 0; --k) if (rt * 256 < eoff[k + 1]) e = k; tile_e[rt] = e; }
    __syncthreads();
}
__device__ __forceinline__ void phase_moe_combine(Frame& F, const Args& A, int l, int g, bool commit = true, bool next_norm = false) {
    const float* xlat_s = (l == 0) ? A.in[I_X] : F.out; const float* xctx_s = (l == 0) ? A.in[I_CTX] : (const float*)(F.ws + WS_XC);
    float* xlat = F.out; float* xctx = (float*)(F.ws + WS_XC); const float* MOD = (const float*)(F.ws + WS_MOD);
    const bf16* YS = (const bf16*)(F.ws + WS_YS); const bf16* Y = (const bf16*)(F.ws + WS_Y); const unsigned* TOK = (const unsigned*)(F.ws + WS_TOK);
    bf16* H = (bf16*)(F.ws + WS_H); const float* gn1 = A.in[I_GNORM] + (size_t)((l + 1 < DEPTH ? l + 1 : l) * 2 + 0) * 1024;
    LAS int* eoff = (LAS int*)(F.lds + LDSX_OFF); LAS int* tile_e = eoff + 64; moe_tables(F, A, l, g, eoff, tile_e);
    for (int lr0 = F.gw; lr0 < TG; lr0 += 2 * F.NGW) {
        v4u bb[2]; v4u ta[2]; bool ok[2]; size_t ro[2]; bool lat[2]; const float* md[2];
#pragma unroll
        for (int k = 0; k < 2; ++k) { const int lr = lr0 + k * F.NGW; const int bl = lr / TPS, t = lr % TPS, b = g * GBS + bl; ok[k] = lr < TG && !(l == DEPTH - 1 && t >= NLAT); lat[k] = t < NLAT;
            ro[k] = lat[k] ? ((size_t)b * NLAT + t) * DM : ((size_t)b * NCTX + (t - NLAT)) * DM; md[k] = MOD + ((size_t)l * 17 + (lat[k] ? b : 16)) * 6144;
            if (ok[k]) { ta[k] = *(const v4u*)(TOK + (size_t)lr * 8); bb[k] = *(const v4u*)(TOK + (size_t)lr * 8 + 4); } }
        v2u ya[2][4], yc[2][4], yy[2][4]; f32x4 xv[2][4];
#pragma unroll
        for (int k = 0; k < 2; ++k) if (ok[k]) { const int lr = lr0 + k * F.NGW;
            const unsigned p0 = (unsigned)eoff[ta[k].x] + ta[k].y, p1 = (unsigned)eoff[ta[k].z] + ta[k].w;
            const v2u* y0 = (const v2u*)(YS + (size_t)p0 * DM) + F.lane; const v2u* y1 = (const v2u*)(YS + (size_t)p1 * DM) + F.lane; const v2u* yp = (const v2u*)(Y + (size_t)lr * DM) + F.lane;
            const f32x4* xr = (const f32x4*)((lat[k] ? xlat_s : xctx_s) + ro[k]) + F.lane;
#pragma unroll
            for (int j = 0; j < 4; ++j) { ya[k][j] = y0[64 * j]; yc[k][j] = y1[64 * j]; yy[k][j] = yp[64 * j]; xv[k][j] = xr[64 * j]; } }
#pragma unroll
        for (int k = 0; k < 2; ++k) if (ok[k]) { const float w0 = __uint_as_float(bb[k].x), w1 = __uint_as_float(bb[k].y); f32x4* xo = (f32x4*)((lat[k] ? xlat : xctx) + ro[k]) + F.lane;
#pragma unroll
            for (int j = 0; j < 4; ++j) { const v2u a = ya[k][j], c = yc[k][j], y = yy[k][j]; const f32x4 g1 = ((const f32x4*)(md[k] + 2048))[F.lane + 64 * j], g2 = ((const f32x4*)(md[k] + 5120))[F.lane + 64 * j]; f32x4 x = xv[k][j];
                x.x += g1.x * bf_lo(y.x) + g2.x * (w0 * bf_lo(a.x) + w1 * bf_lo(c.x)); x.y += g1.y * bf_hi(y.x) + g2.y * (w0 * bf_hi(a.x) + w1 * bf_hi(c.x));
                x.z += g1.z * bf_lo(y.y) + g2.z * (w0 * bf_lo(a.y) + w1 * bf_lo(c.y)); x.w += g1.w * bf_hi(y.y) + g2.w * (w0 * bf_hi(a.y) + w1 * bf_hi(c.y)); if (commit) xo[64 * j] = x; xv[k][j] = x; }
            if (next_norm) {
                const int lr = lr0 + k * F.NGW; float s = 0.f;
#pragma unroll
                for (int j = 0; j < 4; ++j) s += (xv[k][j].x * xv[k][j].x + xv[k][j].y * xv[k][j].y) + (xv[k][j].z * xv[k][j].z + xv[k][j].w * xv[k][j].w);
                const float rstd = rsq_(wave_sum(s) * (1.0f / DM) + EPS); const float* mdn = md[k] + 17 * 6144;
                v2u* o8 = (v2u*)(H + (size_t)lr * DM) + F.lane;
#pragma unroll
                for (int j = 0; j < 4; ++j) { const f32x4 gg = ((const f32x4*)gn1)[F.lane + 64 * j], sh = ((const f32x4*)mdn)[F.lane + 64 * j], sc = ((const f32x4*)(mdn + 1024))[F.lane + 64 * j];
                    const f32x4 yv = (xv[k][j] * rstd * gg) * (1.0f + sc) + sh; o8[64 * j] = (v2u){pk2(yv.x, yv.y), pk2(yv.z, yv.w)}; } } }
    }
}
namespace ml {
constexpr int QS_OFF = 0, QP = 272;
constexpr int KS_OFF = 17408;
constexpr int KG_OFF = 34816, KGP = 320;
constexpr int VS_OFF = 55296, VSP = 320;
constexpr int SS_OFF = 75776, TP = 144;
constexpr int CT_OFF = 84992;
constexpr int HS_OFF = 119808, HP = 272;
constexpr int NV_OFF = 137216;
constexpr int GA_OFF = 137728, GA_SZ = 1536;
constexpr int DQ_OFF = GA_OFF + 2 * GA_SZ;
constexpr int NVB_OFF = DQ_OFF + 256;
constexpr int GTS_OFF = NVB_OFF + 256;
static_assert(GTS_OFF + 4096 <= LDSCTL_OFF, "mLSTM LDS map");
constexpr int NCHUNK = TPS / 64;
constexpr float KSCALE = 0.08838834764831845f;
__device__ __forceinline__ int crow(int r, int hi) { return (r & 3) + 8 * (r >> 2) + 4 * hi; }
__device__ __forceinline__ f32x16 mfma32(bf16x8 a, bf16x8 b, f32x16 c) { return __builtin_amdgcn_mfma_f32_32x32x16_bf16(a, b, c, 0, 0, 0); }
__device__ __forceinline__ int tokrow(int p, int dir) { return dir == 0 ? (p < NCTX ? NLAT + p : p - NCTX) : (p < NCTX ? NLAT + NCTX - 1 - p : TPS - 1 - p); }
typedef short s16x4_ __attribute__((ext_vector_type(4)));
__device__ __forceinline__ bf16x8 trfrag(const LAS unsigned char* p, int koff, int pitch) {
    const s16x4_ lo = __builtin_bit_cast(s16x4_, __builtin_amdgcn_ds_read_tr16_b64_v4i16((LAS s16x4_*)(p + koff)));
    const s16x4_ hi = __builtin_bit_cast(s16x4_, __builtin_amdgcn_ds_read_tr16_b64_v4i16((LAS s16x4_*)(p + koff + 8 * pitch)));
    return (bf16x8){lo[0], lo[1], lo[2], lo[3], hi[0], hi[1], hi[2], hi[3]};
}
__device__ __forceinline__ bf16x8 rowfrag_perm(const LAS unsigned char* p, int ks) {
    const s16x4_ lo = *(const LAS s16x4_*)(p + 32 * ks), hi = *(const LAS s16x4_*)(p + 32 * ks + 16);
    return (bf16x8){lo[0], lo[1], lo[2], lo[3], hi[0], hi[1], hi[2], hi[3]};
}
}
struct MlRegs { v4u q0, q1, k0, k1, v0, v1; f32x4 g4; };
struct MlCtx { LAS unsigned char* L; const bf16* P; const float* GT; bf16* HD; int h, dir, tid, lane, w, r32, hi; };
__device__ __forceinline__ void ml_load(const MlCtx& c, MlRegs& r, int j) {
    using namespace ml;
    const int jj = j;
    const int s0 = c.tid >> 4, ch = c.tid & 15;
    const bf16* p0 = c.P + (size_t)tokrow(jj * 64 + s0, c.dir) * PW + c.h * 128 + ch * 8;
    const bf16* p1 = c.P + (size_t)tokrow(jj * 64 + s0 + 32, c.dir) * PW + c.h * 128 + ch * 8;
    r.q0 = *(const v4u*)(p0 + C_CQ); r.q1 = *(const v4u*)(p1 + C_CQ); r.k0 = *(const v4u*)(p0 + C_CK); r.k1 = *(const v4u*)(p1 + C_CK);
    r.v0 = *(const v4u*)(p0 + C_CV); r.v1 = *(const v4u*)(p1 + C_CV);
    const int rlo = c.dir == 0 ? tokrow(jj * 64, 0) : tokrow(jj * 64 + 63, 1);
    r.g4 = *(const f32x4*)(c.GT + (size_t)rlo * 16 + (c.tid & 255) * 4);
}
__device__ __forceinline__ void ml_scan(const MlCtx& c, int gb, float& m_carry) {
    using namespace ml;
    LAS float* ga = (LAS float*)(c.L + GA_OFF + gb * GA_SZ); const int lane = c.lane;
    const LAS float* gt = (const LAS float*)(c.L + GTS_OFF) + (c.dir == 0 ? lane : 63 - lane) * 16 + c.dir * 8 + c.h;
    const float rig = gt[0], rfp = gt[4];
    const float lf = fminf(rfp, 0.f) - __logf(1.0f + __expf(-fabsf(rfp)));
    const float b = wave_scan_add(lf);
    const float u = rig - b; const float pm = wave_scan_max(u);
    const float Mt = fmaxf(m_carry, pm); const float bend = lane63(b), M63 = lane63(Mt);
    ga[lane] = u; ga[64 + lane] = Mt; ga[128 + lane] = __expf(m_carry - Mt); ga[192 + lane] = __expf(-(b + Mt)); ga[256 + lane] = __expf(u - M63) * KSCALE;
    if (lane == 0) ga[320] = __expf(m_carry - M63);
    m_carry = bend + M63;
}
__device__ __forceinline__ void ml_stage_gates(const MlCtx& c, const MlRegs& r) { if (c.tid < 256) *(LAS f32x4*)(c.L + ml::GTS_OFF + c.tid * 16) = r.g4; }
__device__ __forceinline__ void ml_stage_qk(const MlCtx& c, const MlRegs& r) {
    using namespace ml;
    LAS unsigned char* L = c.L; const int s0 = c.tid >> 4, ch = c.tid & 15;
    *(LAS v4u*)(L + QS_OFF + s0 * QP + ch * 16) = r.q0; *(LAS v4u*)(L + QS_OFF + (s0 + 32) * QP + ch * 16) = r.q1;
    *(LAS v4u*)(L + KS_OFF + s0 * QP + ch * 16) = r.k0; *(LAS v4u*)(L + KS_OFF + (s0 + 32) * QP + ch * 16) = r.k1;
}
__device__ __forceinline__ void ml_stage_kgvs(const MlCtx& c, const MlRegs& r, int gb) {
    using namespace ml;
    LAS unsigned char* L = c.L; const int s0 = c.tid >> 4, ch = c.tid & 15;
    const LAS float* gsp = (const LAS float*)(L + GA_OFF + gb * GA_SZ) + 256;
    const float gs0 = gsp[s0], gs1 = gsp[s0 + 32];
    v4u g0, g1;
    g0.x = pk2(bf_lo(r.k0.x) * gs0, bf_hi(r.k0.x) * gs0); g0.y = pk2(bf_lo(r.k0.y) * gs0, bf_hi(r.k0.y) * gs0); g0.z = pk2(bf_lo(r.k0.z) * gs0, bf_hi(r.k0.z) * gs0); g0.w = pk2(bf_lo(r.k0.w) * gs0, bf_hi(r.k0.w) * gs0);
    g1.x = pk2(bf_lo(r.k1.x) * gs1, bf_hi(r.k1.x) * gs1); g1.y = pk2(bf_lo(r.k1.y) * gs1, bf_hi(r.k1.y) * gs1); g1.z = pk2(bf_lo(r.k1.z) * gs1, bf_hi(r.k1.z) * gs1); g1.w = pk2(bf_lo(r.k1.w) * gs1, bf_hi(r.k1.w) * gs1);
    *(LAS v4u*)(L + KG_OFF + s0 * KGP + ch * 16) = g0; *(LAS v4u*)(L + KG_OFF + (s0 + 32) * KGP + ch * 16) = g1;
    *(LAS v4u*)(L + VS_OFF + s0 * VSP + ch * 16) = r.v0; *(LAS v4u*)(L + VS_OFF + (s0 + 32) * VSP + ch * 16) = r.v1;
}
__device__ __forceinline__ void ml_step(const MlCtx& c, int j, MlRegs& rl, const MlRegs& rs, f32x16& cacc0, f32x16& cacc1, float& m_carry) {
    using namespace ml;
    int tid = c.tid; asm volatile("" : "+v"(tid));
    LAS unsigned char* L = c.L; const int lane = tid & 63, w = c.w, r32 = lane & 31, hi = lane >> 5;
    const int gb = j & 1; const int hstep = c.dir ? -1 : 1;
    LAS float* ga = (LAS float*)(L + GA_OFF + gb * GA_SZ);
    unsigned one2 = 0x3F803F80u; asm volatile("" : "+v"(one2));
    const bf16x8 ones = __builtin_bit_cast(bf16x8, (v4u){one2, one2, one2, one2});
    ml_stage_kgvs(c, rl, gb);
    ml_load(c, rl, (j + 2 < NCHUNK) ? j + 2 : NCHUNK - 1);
    f32x16 hacc0, hacc1;
    ml_stage_gates(c, rs);
    if (j > 0) { const int hp0 = tokrow((j - 1) * 64, c.dir); const int t = tid >> 4, ch = tid & 15;
        const v4u hv0 = *(const LAS v4u*)(L + HS_OFF + t * HP + ch * 16), hv1 = *(const LAS v4u*)(L + HS_OFF + (t + 32) * HP + ch * 16);
        *(v4u*)(c.HD + (size_t)(hp0 + hstep * t) * 512 + ch * 8) = hv0; *(v4u*)(c.HD + (size_t)(hp0 + hstep * (t + 32)) * 512 + ch * 8) = hv1; }
    if (w < 4) {
        const int tb = w >> 1, dbp = w & 1;
#pragma unroll
        for (int r = 0; r < 16; ++r) { hacc0[r] = 0.f; hacc1[r] = 0.f; }
        bf16x8 fa[8], fb[8];
#pragma unroll
        for (int ks = 0; ks < 8; ++ks) { fa[ks] = *(const LAS bf16x8*)(L + QS_OFF + (32 * tb + r32) * QP + (16 * ks + 8 * hi) * 2); fb[ks] = *(const LAS bf16x8*)(L + CT_OFF + (64 * dbp + r32) * QP + (16 * ks + 8 * hi) * 2); }
        __builtin_amdgcn_sched_barrier(0);
#pragma unroll
        for (int ks = 0; ks < 8; ++ks) hacc0 = mfma32(fa[ks], fb[ks], hacc0);
#pragma unroll
        for (int ks = 0; ks < 8; ++ks) fb[ks] = *(const LAS bf16x8*)(L + CT_OFF + (64 * dbp + 32 + r32) * QP + (16 * ks + 8 * hi) * 2);
        __builtin_amdgcn_sched_barrier(0);
#pragma unroll
        for (int ks = 0; ks < 8; ++ks) hacc1 = mfma32(fa[ks], fb[ks], hacc1);
    } else if (w < 7) {
        const int tb = (w == 4) ? 0 : 1, sb = (w == 6) ? 1 : 0;
        f32x16 sacc;
#pragma unroll
        for (int r = 0; r < 16; ++r) sacc[r] = 0.f;
        bf16x8 fa[8], fb[8];
#pragma unroll
        for (int ks = 0; ks < 8; ++ks) { fa[ks] = *(const LAS bf16x8*)(L + QS_OFF + (32 * tb + r32) * QP + (16 * ks + 8 * hi) * 2); fb[ks] = *(const LAS bf16x8*)(L + KS_OFF + (32 * sb + r32) * QP + (16 * ks + 8 * hi) * 2); }
        const int s = 32 * sb + r32; const float us = ga[s];
        f32x4 mtv[4];
#pragma unroll
        for (int gq = 0; gq < 4; ++gq) mtv[gq] = *(const LAS f32x4*)(ga + 64 + 32 * tb + 8 * gq + 4 * hi);
        __builtin_amdgcn_sched_barrier(0);
#pragma unroll
        for (int ks = 0; ks < 8; ++ks) sacc = mfma32(fa[ks], fb[ks], sacc);
#pragma unroll
        for (int gq = 0; gq < 4; ++gq) { const f32x4 mt = mtv[gq];
#pragma unroll
            for (int i = 0; i < 4; ++i) { const int t = 32 * tb + 8 * gq + 4 * hi + i; const float val = (s <= t) ? sacc[4 * gq + i] * KSCALE * __expf(us - mt[i]) : 0.f;
                *(LAS bf16*)(L + SS_OFF + t * TP + s * 2) = (bf16)f2bf(val); } }
    } else {
        {
            const int fr = lane & 15, fq = lane >> 4;
            typedef float f32x4_ __attribute__((ext_vector_type(4)));
            bf16x8 nb[4];
#pragma unroll
            for (int ks = 0; ks < 4; ++ks) nb[ks] = *(const LAS bf16x8*)(L + NVB_OFF + (32 * ks + 8 * fq) * 2);
            bf16x8 qa[4][4];
#pragma unroll
            for (int rb = 0; rb < 4; ++rb)
#pragma unroll
                for (int ks = 0; ks < 4; ++ks) qa[rb][ks] = *(const LAS bf16x8*)(L + QS_OFF + (16 * rb + fr) * QP + (32 * ks + 8 * fq) * 2);
            __builtin_amdgcn_sched_barrier(0);
#pragma unroll
            for (int rb = 0; rb < 4; ++rb) { f32x4_ d = {0.f, 0.f, 0.f, 0.f};
#pragma unroll
                for (int ks = 0; ks < 4; ++ks) d = __builtin_amdgcn_mfma_f32_16x16x32_bf16(qa[rb][ks], nb[ks], d, 0, 0, 0);
                if (fr == 0) *(LAS f32x4_*)(L + DQ_OFF + (16 * rb + 4 * fq) * 4) = d; }
        }
        { const int row = lane >> 1, half = lane & 1; unsigned z = 0u; asm volatile("" : "+v"(z)); *(LAS v4u*)(L + SS_OFF + row * TP + 64 + half * 32) = (v4u){z, z, z, z}; *(LAS v4u*)(L + SS_OFF + row * TP + 64 + half * 32 + 16) = (v4u){z, z, z, z}; }
    }
    LDS_BARRIER();
    const int q4 = (lane & 15) >> 2, p4 = lane & 3, h16 = (lane >> 4) & 1;
    const int dbp = w & 1;
    const LAS unsigned char* vtr_ = L + VS_OFF + (4 * hi + q4) * VSP + (16 * h16 + 4 * p4) * 2 + 128 * dbp;
    if (w < 4) {
        const int tb = w >> 1;
        f32x4 wv[4];
#pragma unroll
        for (int gq = 0; gq < 4; ++gq) { wv[gq] = *(const LAS f32x4*)(ga + 128 + 32 * tb + 8 * gq + 4 * hi);
#pragma unroll
            for (int i = 0; i < 4; ++i) { hacc0[4 * gq + i] *= wv[gq][i]; hacc1[4 * gq + i] *= wv[gq][i]; } }
        f32x16 racc;
#pragma unroll
        for (int r = 0; r < 16; ++r) racc[r] = 0.f;
        const LAS unsigned char* sp = L + SS_OFF + (32 * tb + r32) * TP + 8 * hi;
        bf16x8 fa[4], fb0[4], fb1[4];
#pragma unroll
        for (int ks = 0; ks < 4; ++ks) { fa[ks] = rowfrag_perm(sp, ks); fb0[ks] = trfrag(vtr_, 16 * ks * VSP, VSP); fb1[ks] = trfrag(vtr_, 16 * ks * VSP + 64, VSP); }
        __builtin_amdgcn_sched_barrier(0);
#pragma unroll
        for (int ks = 0; ks < 4; ++ks) { hacc0 = mfma32(fa[ks], fb0[ks], hacc0); hacc1 = mfma32(fa[ks], fb1[ks], hacc1); racc = mfma32(fa[ks], ones, racc); }
#pragma unroll
        for (int gq = 0; gq < 4; ++gq) { const f32x4 dqv = *(const LAS f32x4*)(L + DQ_OFF + (32 * tb + 8 * gq + 4 * hi) * 4), emv = *(const LAS f32x4*)(ga + 192 + 32 * tb + 8 * gq + 4 * hi);
#pragma unroll
            for (int i = 0; i < 4; ++i) { const int t = 32 * tb + 8 * gq + 4 * hi + i; const float den = wv[gq][i] * dqv[i] + racc[4 * gq + i];
                const float inv = __builtin_amdgcn_rcpf(fmaxf(fabsf(den), emv[i]));
                *(LAS bf16*)(L + HS_OFF + t * HP + (64 * dbp + r32) * 2) = (bf16)f2bf(hacc0[4 * gq + i] * inv);
                *(LAS bf16*)(L + HS_OFF + t * HP + (64 * dbp + 32 + r32) * 2) = (bf16)f2bf(hacc1[4 * gq + i] * inv); } }
    }
    {
        const int kb = w >> 1; const float gi = ga[320];
        const LAS unsigned char* ktr_ = L + KG_OFF + (4 * hi + q4) * KGP + (16 * h16 + 4 * p4) * 2;
#pragma unroll
        for (int r = 0; r < 16; ++r) { cacc0[r] *= gi; cacc1[r] *= gi; }
        bf16x8 ca[4], cb0[4], cb1[4];
#pragma unroll
        for (int ks = 0; ks < 4; ++ks) { ca[ks] = trfrag(ktr_, 16 * ks * KGP + 64 * kb, KGP); cb0[ks] = trfrag(vtr_, 16 * ks * VSP, VSP); cb1[ks] = trfrag(vtr_, 16 * ks * VSP + 64, VSP); }
        __builtin_amdgcn_sched_barrier(0);
#pragma unroll
        for (int ks = 0; ks < 4; ++ks) { cacc0 = mfma32(ca[ks], cb0[ks], cacc0); cacc1 = mfma32(ca[ks], cb1[ks], cacc1); }
#pragma unroll
        for (int gq = 0; gq < 4; ++gq) {
            *(LAS v2u*)(L + CT_OFF + (64 * dbp + r32) * QP + (32 * kb + 8 * gq + 4 * hi) * 2) = (v2u){pk2(cacc0[4 * gq], cacc0[4 * gq + 1]), pk2(cacc0[4 * gq + 2], cacc0[4 * gq + 3])};
            *(LAS v2u*)(L + CT_OFF + (64 * dbp + 32 + r32) * QP + (32 * kb + 8 * gq + 4 * hi) * 2) = (v2u){pk2(cacc1[4 * gq], cacc1[4 * gq + 1]), pk2(cacc1[4 * gq + 2], cacc1[4 * gq + 3])}; }
        if (w == 6) {
#pragma unroll
            for (int kb2 = 0; kb2 < 4; ++kb2) { f32x16 nacc; bf16x8 nf[4];
#pragma unroll
                for (int ks = 0; ks < 4; ++ks) nf[ks] = trfrag(ktr_, 16 * ks * KGP + 64 * kb2, KGP);
#pragma unroll
                for (int r = 0; r < 16; ++r) nacc[r] = 0.f;
                __builtin_amdgcn_sched_barrier(0);
#pragma unroll
                for (int ks = 0; ks < 4; ++ks) nacc = mfma32(ones, nf[ks], nacc);
                if (hi == 0) { LAS float* nv = (LAS float*)(L + NV_OFF); const int dk = 32 * kb2 + r32; const float nn = gi * nv[dk] + nacc[0]; nv[dk] = nn; *(LAS bf16*)(L + NVB_OFF + dk * 2) = (bf16)f2bf(nn); } }
        }
        if (w == 7 && j + 1 < NCHUNK) ml_scan(c, gb ^ 1, m_carry);
    }
    if (j + 1 < NCHUNK) ml_stage_qk(c, rs);
    LDS_BARRIER();
}
__device__ __forceinline__ void mlstm_chain(Frame& F, const Args& A, int l, int bl, int h, int dir) {
    using namespace ml;
    MlCtx c; c.L = F.lds; c.tid = F.tid; c.lane = F.lane; c.w = F.wave; c.r32 = F.lane & 31; c.hi = F.lane >> 5; c.h = h; c.dir = dir;
    c.P = (const bf16*)(F.ws + WS_P) + (size_t)bl * TPS * PW;
    c.GT = (const float*)(F.ws + WS_GATES) + (size_t)bl * TPS * 16;
    c.HD = (bf16*)(F.ws + WS_HDIR) + ((size_t)dir * TG + (size_t)bl * TPS) * 512 + h * 128;
    f32x16 cacc0, cacc1;
#pragma unroll
    for (int r = 0; r < 16; ++r) { cacc0[r] = 0.f; cacc1[r] = 0.f; }
    __syncthreads();
    { unsigned z = 0u; asm volatile("" : "+v"(z));
      for (int i = c.tid; i < (128 * QP) / 16; i += 512) *(LAS v4u*)(c.L + CT_OFF + i * 16) = (v4u){z, z, z, z}; }
    if (c.tid < 128) { ((LAS float*)(c.L + NV_OFF))[c.tid] = 0.f; *(LAS bf16*)(c.L + NVB_OFF + c.tid * 2) = (bf16)0; }
    float m_carry = 0.f;
    MlRegs ra, rb;
    ml_load(c, ra, 0); ml_load(c, rb, 1);
    ml_stage_gates(c, ra);
    __syncthreads();
    if (c.w == 7) ml_scan(c, 0, m_carry);
    __syncthreads();
    ml_stage_qk(c, ra);
    __syncthreads();
    for (int j = 0; j < NCHUNK; j += 2) {
        ml_step(c, j, ra, rb, cacc0, cacc1, m_carry);
        ml_step(c, j + 1, rb, ra, cacc0, cacc1, m_carry);
    }
    { const int hp0 = tokrow((NCHUNK - 1) * 64, dir), hstep = dir ? -1 : 1; const int t = c.tid >> 4, ch = c.tid & 15;
      const v4u hv0 = *(const LAS v4u*)(c.L + HS_OFF + t * HP + ch * 16), hv1 = *(const LAS v4u*)(c.L + HS_OFF + (t + 32) * HP + ch * 16);
      *(v4u*)(c.HD + (size_t)(hp0 + hstep * t) * 512 + ch * 8) = hv0; *(v4u*)(c.HD + (size_t)(hp0 + hstep * (t + 32)) * 512 + ch * 8) = hv1; }
    __syncthreads();
}
#define MLPROBE ((DBL_MASK >> 20) & 1)
constexpr int NA_TAB_OFF = 131072, NA_TAB_STRIDE = 2560;
__device__ __forceinline__ void phase_mixers(Frame& F, const Args& A, int l, int g, int r1 = 1, int r2 = 1, int r3 = 1) {
    unsigned* q0 = F.ctl + CW_Q + 64 * ((l * 2 + g) * 4);
    const bf16* P = (const bf16*)(F.ws + WS_P); bf16* OUTS = (bf16*)(F.ws + WS_OUTS);
    char* shm = (char*)(F.lds + RING_OFF);
    const bool ctxq = (l < DEPTH - 1);
    for (int rep = 0; rep < r1; ++rep) { unsigned* q = q0 + rep * 4096; for (;;) { const int i = dequeue(F, q, 16); if (i >= GBS * 8) break; mlstm_chain(F, A, l, i >> 3, (i >> 1) & 3, i & 1); } }
    const int nU = 1024 + (ctxq ? 128 : 0);
    for (int rep = 0; rep < r2; ++rep) { unsigned* q = q0 + rep * 4096; for (int i = dequeue(F, q + 64, 17); i < nU; ) {
        const unsigned nxq = dq_issue(F, q + 64);
        const bf16 *Qw, *Kh, *Vh; bf16* Ow; int NT, nA;
        if (i < 1024) { const int g4 = i & 3, qb = (i >> 2) & 15, kvh = (i >> 6) & 1, bl = i >> 7, h = kvh * 4 + g4; const size_t r0 = (size_t)bl * TPS;
            Qw = P + (r0 + qb * 256) * PW + C_AQ + h * 64; Kh = P + r0 * PW + C_AK + kvh * 64; Vh = P + r0 * PW + C_AV + kvh * 64; Ow = OUTS + (r0 + qb * 256) * OW + h * 64; NT = TPS / 64; nA = TPS / 64; }
        else if (i < 1088) { const int jj = i - 1024, h = jj & 7, bl = jj >> 3, kvh = h >> 2; const size_t r0 = (size_t)bl * TPS + NLAT;
            Qw = P + r0 * PW + C_AQ + h * 64; Kh = P + r0 * PW + C_AK + kvh * 64; Vh = P + r0 * PW + C_AV + kvh * 64; Ow = OUTS + r0 * OW + h * 64; NT = 4; nA = 4; }
        else { const int jj = i - 1088, h = jj & 7, bl = jj >> 3; const size_t r0 = (size_t)bl * TPS + NLAT;
            Qw = P + r0 * PW + C_BQ + h * 64; Kh = P + r0 * PW + C_BK + h * 64; Vh = P + r0 * PW + C_BV + h * 64; Ow = OUTS + r0 * OW + 512 + h * 64; NT = 4; nA = 4; }
        attn_body::attn_unit<0, 1000>(Qw, PW, Kh, Vh, PW, NT, nA, 0, Ow, OW, shm, (attn_body::lds_cptr)(F.lds + NA_TAB_OFF + 256), 0, 0);
        i = dq_take(F, nxq, 17);
    } }
    int tab_h = -1;
    for (int rep = 0; rep < r3; ++rep) { unsigned* q = q0 + rep * 4096; for (int i = dequeue(F, q + 128, 18); i < 1024; ) {
        const unsigned nxq = dq_issue(F, q + 128);
        const int rg = i & 15, h = (i >> 4) & 7, bl = i >> 7; const size_t r0 = (size_t)bl * TPS;
        if (h != tab_h) { tab_h = h;
            for (int idx = F.tid; idx < NA_TAB_STRIDE / 4; idx += 512) { const int r = idx - 64, dr = r >> 5, dc = r & 31;
                float v = 0.f; if (r >= 0 && r < 480) v = (dc < 31) ? A.in[I_RPB][((size_t)l * 8 + h) * 15 * 31 + dr * 31 + dc] * LOG2E : -INFINITY;
                ((LAS float*)(F.lds + NA_TAB_OFF))[idx] = v; }
            __syncthreads(); }
        attn_body::na_unit<0>(P + r0 * PW, h, rg, OUTS + r0 * OW, shm, (attn_body::lds_cptr)(F.lds + NA_TAB_OFF + 256));
        i = dq_take(F, nxq, 18);
    } }
}

#ifndef MK_PER_PHASE
#define MK_PER_PHASE 0
#endif
#ifndef PHASE_MASK
#define PHASE_MASK 0xffff
#endif
#define PHM(k) ((PHASE_MASK >> (k)) & 1)
#ifndef DBL_MASK
#define DBL_MASK 0
#endif
#define DBL(k) ((DBL_MASK >> (k)) & 1)
constexpr int NPHASE = 1 + NGRP * (DEPTH * 9 + 1);
__global__ void __launch_bounds__(512, 2) fwd_kernel(Args A) {
    extern __shared__ __attribute__((aligned(16))) unsigned char lds[];
    Frame F;
    F.lds = (LAS unsigned char*)lds;
    F.MISC = (volatile LAS unsigned*)(F.lds + LDSCTL_OFF);
    F.tid = threadIdx.x; F.lane = F.tid & 63; F.wave = __builtin_amdgcn_readfirstlane(F.tid >> 6);
    F.G = gridDim.x; F.gw = blockIdx.x * 8 + F.wave; F.NGW = F.G * 8;
    F.ws = A.ws; F.ctl = (unsigned*)(A.ws + WS_CTL); F.out = A.out;
    A.in[I_X] = A.in[0]; A.in[I_C] = A.in[1]; A.in[I_CTX] = A.in[2]; A.in[I_CCTX] = A.in[3]; A.in[I_WMOD] = A.in[4]; A.in[I_BMOD] = A.in[5]; A.in[I_GNORM] = A.in[6]; A.in[I_WIN] = A.in[7];
    A.in[I_BMERGE] = A.in[8]; A.in[I_GQK] = A.in[9]; A.in[I_RPB] = A.in[10]; A.in[I_BMLSTM] = A.in[11]; A.in[I_GML] = A.in[12]; A.in[I_WBRANCH] = A.in[13]; A.in[I_WOUT] = A.in[14];
    A.in[I_WGROUP] = A.in[15]; A.in[I_BGROUP] = A.in[16]; A.in[I_WROUTER] = A.in[17]; A.in[I_BROUTER] = A.in[18]; A.in[I_WGU] = A.in[19]; A.in[I_WDN] = A.in[20];
    for (int u = F.tid; u < 128; u += 512) ((LAS unsigned*)(F.lds + LDSCTL_OFF))[u] = 0u;
    __syncthreads();
    XcdBarrier bar; bar.bar = F.ctl + CW_BAR; bar.x = 0; bar.st = nullptr;
    if (!MK_PER_PHASE) bar = xcd_barrier_post(F.ctl + CW_BAR, F.MISC + 8);
    const int lo = A.ph_lo, hi = A.ph_hi; int ph = 0;
#define SEAM() do { if (!MK_PER_PHASE) { if (ph + 1 < hi) { xcd_barrier(bar); if (DBL(19)) xcd_barrier(bar); } } } while (0)
#define ON() (ph >= lo && ph < hi && refresh(F))
    if (PHM(0) && ON()) { p0_prologue(F, A); if (DBL(0)) { __syncthreads(); p0_prologue(F, A); } SEAM(); } ++ph;
    for (int g = 0; g < NGRP; ++g) {
        for (int l = 0; l < DEPTH; ++l) {
            const bool skipctx = (l == DEPTH - 1); const int nMrows = skipctx ? GBS * 16 : RTG;
            if (l == 0) { if (PHM(1) && ON()) { phase_norm1(F, A, l, g); if (DBL(1)) phase_norm1(F, A, l, g); SEAM(); } ++ph; }
            if (PHM(2) && ON()) {
                DenseOrder S{RTG, 30, RTG * 30, F.G, (int)blockIdx.x, false, (const char*)(F.ws + WS_H), (const char*)(F.ws + WS_WIN + l * WIN_L), (size_t)256 * 1024 * 2, (size_t)256 * 1024 * 2};
                EpiInproj E{(bf16*)(F.ws + WS_P), (float*)(F.ws + WS_GATES), A.in[I_BMLSTM] + l * 16, (bf16*)(F.ws + WS_SG), A.in[I_BMERGE] + l * 3072, A.in[I_GQK] + (size_t)l * 256, (const f32x2*)(F.ws + WS_ROPE), (LAS float*)(F.lds + LDSX_OFF)};
                for (int rep_ = 0; rep_ < 1 + DBL(2); ++rep_) { pg8::gemm_phase<EpiInproj, DenseOrder, true, true>(F.lds + RING_OFF, pg8::Gemm{1024, 1024, 1024}, S, E); }
                SEAM(); } ++ph;
            if (PHM(4) && ON()) { phase_mixers(F, A, l, g, 1 + DBL(16), 1 + DBL(17), 1 + DBL(18)); SEAM(); } ++ph;
            if (PHM(5) && ON()) { phase_mlstm_finish(F, A, l); if (DBL(5)) phase_mlstm_finish(F, A, l); SEAM(); } ++ph;
            if (PHM(7) && ON()) {
                DenseOrder S{nMrows, 4, nMrows * 4, F.G, (int)blockIdx.x, skipctx, (const char*)(F.ws + WS_OUTS), (const char*)(F.ws + WS_WBR + l * WBR_L), (size_t)256 * OW * 2, (size_t)256 * 1536 * 2};
                EpiBranch E{(const bf16*)(F.ws + WS_SG), (bf16*)(F.ws + WS_MERGED)};
                for (int rep_ = 0; rep_ < 1 + DBL(7); ++rep_) { pg8::gemm_phase<EpiBranch, DenseOrder, true, true>(F.lds + RING_OFF, pg8::Gemm{OW, 1536, 1536}, S, E); }
                SEAM(); } ++ph;
            if (PHM(8) && ON()) {
                DenseOrder S{nMrows, 4, nMrows * 4, F.G, (int)blockIdx.x, skipctx, (const char*)(F.ws + WS_MERGED), (const char*)(F.ws + WS_WOUT + l * WOUT_L), (size_t)256 * 1024 * 2, (size_t)256 * 1024 * 2};
                EpiWout E{(bf16*)(F.ws + WS_Y)};
                for (int rep_ = 0; rep_ < 1 + DBL(8); ++rep_) { pg8::gemm_phase<EpiWout, DenseOrder, true, true>(F.lds + RING_OFF, pg8::Gemm{1024, 1024, 1024}, S, E); }
                SEAM(); } ++ph;
            if (PHM(9) && ON()) { phase_norm2_route(F, A, l, g); if (DBL(9)) phase_norm2_route(F, A, l, g, F.G == 12345); SEAM(); } ++ph;
            if (PHM(11) && ON()) {
                LAS int* eoff = (LAS int*)(F.lds + LDSX_OFF); LAS int* tile_e = eoff + 64; moe_tables(F, A, l, g, eoff, tile_e);
                MoeOrder S{eoff[32] / 256, 2, F.G, (int)blockIdx.x, tile_e, eoff, F.ctl + CW_ECNT + 64 * (l * 2 + g), (const int*)(F.ws + WS_LIST), (const char*)(F.ws + WS_H), (size_t)0, (const char*)(F.ws + WS_WGU + l * WGU_L), (size_t)512 * 1024 * 2, (size_t)256 * 1024 * 2};
                EpiMoe1 E{(bf16*)(F.ws + WS_ACT)};
                for (int rep_ = 0; rep_ < 1 + DBL(11); ++rep_) { pg8::gemm_phase<EpiMoe1, MoeOrder, true, true, true>(F.lds + RING_OFF, pg8::Gemm{1024, 1024, 1024}, S, E); }
                SEAM(); } ++ph;
            if (PHM(12) && ON()) {
                LAS int* eoff = (LAS int*)(F.lds + LDSX_OFF); LAS int* tile_e = eoff + 64; moe_tables(F, A, l, g, eoff, tile_e);
                MoeOrder S{eoff[32] / 256, 4, F.G, (int)blockIdx.x, tile_e, eoff, F.ctl + CW_ECNT + 64 * (l * 2 + g), (const int*)nullptr, (const char*)(F.ws + WS_ACT), (size_t)256 * 256 * 2, (const char*)(F.ws + WS_WDN + l * WDN_L), (size_t)1024 * 256 * 2, (size_t)256 * 256 * 2};
                EpiMoe2 E{(bf16*)(F.ws + WS_YS)};
                for (int rep_ = 0; rep_ < 1 + DBL(12); ++rep_) { pg8::gemm_phase<EpiMoe2, MoeOrder, true, true>(F.lds + RING_OFF, pg8::Gemm{256, 256, 256}, S, E); }
                SEAM(); } ++ph;
            if (PHM(13) && ON()) { phase_moe_combine(F, A, l, g, true, l + 1 < DEPTH); if (DBL(13) && l == 0) phase_moe_combine(F, A, l, g, true, true); SEAM(); } ++ph;
        }
    }
#undef SEAM
#undef ON
}

extern "C" void kernel_launch(void* const* d_in, const int* in_sizes, int n_in, void* d_out, int out_size, void* d_ws, size_t ws_size, hipStream_t stream) {
    static int grid = 0;
    if (grid == 0) {
        if (n_in != 21 || out_size != NB * NLAT * DM || ws_size < WS_END) { fprintf(stderr, "kernel_launch: unexpected shapes (n_in %d, out %d, ws %zu)\n", n_in, out_size, ws_size); grid = -1; return; }
        int dev = 0, cus = 0, per_cu = 0;
        if (hipGetDevice(&dev) != hipSuccess || hipDeviceGetAttribute(&cus, hipDeviceAttributeMultiprocessorCount, dev) != hipSuccess) { grid = -1; return; }
        if (hipFuncSetAttribute((const void*)fwd_kernel, hipFuncAttributeMaxDynamicSharedMemorySize, LDS_BYTES) != hipSuccess) { fprintf(stderr, "kernel_launch: hipFuncSetAttribute failed\n"); grid = -1; return; }
        if (hipOccupancyMaxActiveBlocksPerMultiprocessor(&per_cu, (const void*)fwd_kernel, 512, LDS_BYTES) != hipSuccess || per_cu < 1) fprintf(stderr, "kernel_launch: occupancy query reports %d\n", per_cu);
        (void)hipGetLastError();
        grid = cus;
    }
    if (grid < 0) return;
    (void)in_sizes;
    if (hipMemsetAsync((char*)d_ws + WS_CTL, 0, CTL_ZERO_BYTES, stream) != hipSuccess) return;
    Args a{};
    for (int i = 0; i < 21; ++i) a.in[i] = (const float*)d_in[i];
    a.out = (float*)d_out; a.ws = (unsigned char*)d_ws;
#if MK_PER_PHASE
    for (int p = 0; p < NPHASE; ++p) { a.ph_lo = p; a.ph_hi = p + 1; hipLaunchKernelGGL(fwd_kernel, dim3(grid), dim3(512), LDS_BYTES, stream, a); }
#else
    a.ph_lo = 0; a.ph_hi = NPHASE;
    hipLaunchKernelGGL(fwd_kernel, dim3(grid), dim3(512), LDS_BYTES, stream, a);
#endif
}
```

```cpp
#include <hip/hip_runtime.h>
#include <cstdio>
#include <cstdint>

constexpr int NB = 16, NLAT = 4096, NCTX = 256, TPS = NLAT + NCTX  , DM = 1024, DEPTH = 2;
constexpr int GBS = 8  , NGRP = NB / GBS, TG = GBS * TPS  , RTG = TG / 256  ;
constexpr int PW = 4352;
constexpr int C_AQ = 0, C_AK = 512, C_AV = 640, C_BQ = 768, C_BK = 1280, C_BV = 1792, C_CQ = 2304, C_CK = 2816, C_CV = 3328, C_CO = 3840;
constexpr int INW = 7440, NPADW = 4608;
constexpr int OW = 1536;
constexpr int NEXP = 32, DEXP = 256;
constexpr float EPS = 1e-6f;
constexpr float LOG2E = 1.4426950408889634f;
constexpr float QSCALE = 0.125f * LOG2E;

#define LAS __attribute__((address_space(3)))
typedef unsigned short bf16;
typedef unsigned v4u __attribute__((ext_vector_type(4)));
typedef unsigned v2u __attribute__((ext_vector_type(2)));
typedef float f32x4 __attribute__((ext_vector_type(4)));
typedef float f32x2 __attribute__((ext_vector_type(2)));
typedef short bf16x8 __attribute__((ext_vector_type(8)));
typedef float f32x16 __attribute__((ext_vector_type(16)));

typedef float f32x2_hw __attribute__((ext_vector_type(2))); typedef __bf16 bf16x2_hw __attribute__((ext_vector_type(2)));
__device__ __forceinline__ unsigned pk2(float lo, float hi) { f32x2_hw v = {lo, hi}; bf16x2_hw b = __builtin_convertvector(v, bf16x2_hw); return __builtin_bit_cast(unsigned, b); }
__device__ __forceinline__ unsigned f2bf(float f) { return pk2(f, 0.f) & 0xffffu; }
__device__ __forceinline__ float bf_lo(unsigned w) { return __builtin_bit_cast(float, w << 16); }
__device__ __forceinline__ float bf_hi(unsigned w) { return __builtin_bit_cast(float, w & 0xffff0000u); }
__device__ __forceinline__ float bf2f(bf16 b) { return __builtin_bit_cast(float, ((unsigned)b) << 16); }
template <int CTRL, int ROWMASK> __device__ __forceinline__ float dpp_f(float identity, float x) {
    return __builtin_bit_cast(float, __builtin_amdgcn_update_dpp(__builtin_bit_cast(int, identity), __builtin_bit_cast(int, x), CTRL, ROWMASK, 0xf, false)); }
__device__ __forceinline__ float wave_scan_add(float x) {
    x += dpp_f<0x111, 0xf>(0.f, x); x += dpp_f<0x112, 0xf>(0.f, x); x += dpp_f<0x114, 0xf>(0.f, x); x += dpp_f<0x118, 0xf>(0.f, x);
    x += dpp_f<0x142, 0xa>(0.f, x); x += dpp_f<0x143, 0xc>(0.f, x); return x; }
__device__ __forceinline__ float wave_scan_max(float x) {
    const float ninf = -INFINITY;
    x = fmaxf(x, dpp_f<0x111, 0xf>(ninf, x)); x = fmaxf(x, dpp_f<0x112, 0xf>(ninf, x)); x = fmaxf(x, dpp_f<0x114, 0xf>(ninf, x)); x = fmaxf(x, dpp_f<0x118, 0xf>(ninf, x));
    x = fmaxf(x, dpp_f<0x142, 0xa>(ninf, x)); x = fmaxf(x, dpp_f<0x143, 0xc>(ninf, x)); return x; }
__device__ __forceinline__ float lane63(float x) { return __builtin_bit_cast(float, __builtin_amdgcn_readlane(__builtin_bit_cast(int, x), 63)); }
__device__ __forceinline__ float wave_sum(float v) { return lane63(wave_scan_add(v)); }
__device__ __forceinline__ float row16_sum(float x) {
    x += dpp_f<0xB1, 0xf>(0.f, x); x += dpp_f<0x4E, 0xf>(0.f, x); x += dpp_f<0x141, 0xf>(0.f, x); x += dpp_f<0x140, 0xf>(0.f, x); return x; }
__device__ __forceinline__ float rcp_(float x) { return __builtin_amdgcn_rcpf(x); }
__device__ __forceinline__ float rsq_(float x) { return __builtin_amdgcn_rsqf(x); }
__device__ __forceinline__ float sigmoidf_(float x) { return rcp_(1.0f + __builtin_amdgcn_exp2f(-LOG2E * x)); }
#define SIG(k, x) sigmoidf_(x)
#define LDS_BARRIER() asm volatile("s_waitcnt lgkmcnt(0)\n\ts_barrier" ::: "memory")
#ifndef DBL_MASK
#define DBL_MASK 0
#endif
#define MLCUT ((DBL_MASK >> 21) & 255)
namespace pg8 {
#define PG8_LAS __attribute__((address_space(3)))
typedef unsigned short bf16_t;
typedef short bf16x8 __attribute__((ext_vector_type(8)));
typedef float f32x4 __attribute__((ext_vector_type(4)));
typedef unsigned u32x4 __attribute__((ext_vector_type(4)));
constexpr int BM = 256, BK = 64, HALF = 128, HTB = HALF * BK * 2  , STAGE_BYTES = 8 * HTB, NXCD = 8, WGM = 8;

__host__ __device__ __forceinline__ int lds_byte(int r, int c) { const int st = (r >> 4) * 2 + (c >> 5), rr = r & 15, cc = c & 31, ob = rr * 64 + cc * 2; return st * 1024 + (ob ^ (((ob >> 9) & 1) << 5)); }
__host__ __device__ __forceinline__ void stage_rc(int b, int& R, int& C) { const int st = b / 1024, sb = b % 1024, swz = sb ^ (((sb >> 9) & 1) << 5); R = (st >> 1) * 16 + swz / 64; C = (st & 1) * 32 + (swz % 64) / 2; }
__host__ __device__ __forceinline__ int perm32(int rho) { const int n = rho >> 4, i = rho & 15; return 8 * (i >> 2) + 4 * n + (i & 3); }

struct Unit { const char* a; const char* b; int pm, pn, aux; const int* gl; int gn; };
struct Gemm { int lda, ldb, K; };

__device__ __forceinline__ unsigned cvt_pk_bf16(float lo, float hi) { return pk2(lo, hi); }

template <class Epi, class Sched, bool ALIGN_EPI = false, bool SP2 = false, bool GATHER = false>
__device__ __forceinline__ void gemm_phase(PG8_LAS unsigned char* lds, const Gemm g, const Sched& S, const Epi& E) {
    int tid = threadIdx.x; asm volatile("" : "+v"(tid));
    const int wid = __builtin_amdgcn_readfirstlane(tid >> 6), lane = tid & 63, wr = wid >> 2, wc = wid & 3, fr = lane & 15, fq = lane >> 4;
    int K = g.K; asm volatile("" : "+s"(K)); const int nt = K / BK;
    unsigned voffA[2][2], voffN[2][2], voffB[2];
    int RA[2], CA[2];
#pragma unroll
    for (int i = 0; i < 2; ++i) { int R, C; stage_rc(tid * 16 + i * 8192, R, C); const int Rb = Epi::PERM ? ((R & ~31) + perm32(R & 31)) : R; RA[i] = R; CA[i] = C;
        voffA[0][i] = (unsigned)(R * g.lda + C) * 2u; voffA[1][i] = (unsigned)((R + HALF) * g.lda + C) * 2u; voffN[0][i] = voffA[0][i]; voffN[1][i] = voffA[1][i]; voffB[i] = (unsigned)(Rb * g.ldb + C) * 2u; }
#define PG8_GOFF(dst, u) do { _Pragma("unroll") for (int h_ = 0; h_ < 2; ++h_) _Pragma("unroll") for (int i_ = 0; i_ < 2; ++i_) { const int r_ = h_ * HALF + RA[i_]; const int idx_ = (r_ < (u).gn) ? (u).gl[r_] : 0; \
        dst[h_][i_] = (unsigned)(idx_ * g.lda + CA[i_]) * 2u; } } while (0)
    const size_t kstep = (size_t)(BK * 2);
    int lda_ = g.lda, ldb_ = g.ldb; asm volatile("" : "+s"(lda_), "+s"(ldb_));
    const size_t hB = (size_t)HALF * ldb_ * 2; (void)lda_;
    const unsigned ldsw = (unsigned)wid * 1024u;
    const int aoff = lds_byte(wr * 64 + fr, fq * 8), boff = lds_byte(wc * 32 + fr, fq * 8);
#define PG8_SA(b, h) (((b) * 2 + (h)) * HTB)
#define PG8_SB(b, h) ((4 + (b) * 2 + (h)) * HTB)
#define PG8_STAGE(bufoff, gbase, voff) do { _Pragma("unroll") for (int _i = 0; _i < 2; ++_i) \
        __builtin_amdgcn_global_load_lds((const unsigned*)((const char*)(gbase) + (voff)[_i]), (PG8_LAS unsigned*)(lds + (bufoff) + ldsw + _i * 8192), 16, 0, 0); } while (0)
#define PG8_STAGE_A(bufoff, gbase, vo, h) do { _Pragma("unroll") for (int _i = 0; _i < 2; ++_i) \
        __builtin_amdgcn_global_load_lds((const unsigned*)((const char*)(gbase) + (vo)[h][_i]), (PG8_LAS unsigned*)(lds + (bufoff) + ldsw + _i * 8192), 16, 0, 0); } while (0)
#define PG8_LDA(dst, b, h) do { _Pragma("unroll") for (int m = 0; m < 4; ++m) _Pragma("unroll") for (int k = 0; k < 2; ++k) dst[m][k] = *(const PG8_LAS bf16x8*)(lds + PG8_SA(b, h) + aoff + m * 2048 + k * 1024); } while (0)
#define PG8_LDB(dst, b, h) do { _Pragma("unroll") for (int n = 0; n < 2; ++n) _Pragma("unroll") for (int k = 0; k < 2; ++k) dst[n][k] = *(const PG8_LAS bf16x8*)(lds + PG8_SB(b, h) + boff + n * 2048 + k * 1024); } while (0)
#define PG8_MMA(ai, bj, At, Bt) do { __builtin_amdgcn_s_setprio(1); _Pragma("unroll") for (int m = 0; m < 4; ++m) _Pragma("unroll") for (int n = 0; n < 2; ++n) _Pragma("unroll") for (int k = 0; k < 2; ++k) \
        acc[ai][bj][m][n] = __builtin_amdgcn_mfma_f32_16x16x32_bf16(Bt[n][k], At[m][k], acc[ai][bj][m][n], 0, 0, 0); __builtin_amdgcn_s_setprio(0); } while (0)
#define PG8_WAIT_V(n) asm volatile("s_waitcnt vmcnt(" #n ")" ::: "memory")
#define PG8_WAIT_L(n) asm volatile("s_waitcnt lgkmcnt(" #n ")" ::: "memory")
#define PG8_BAR __builtin_amdgcn_s_barrier()
#define PG8_SCHED __builtin_amdgcn_sched_barrier(0)
    Unit cur, nxt; int ui = 0;
    if (!S.next(0, cur)) return;
    f32x4 acc[2][2][4][2];
#pragma unroll
    for (int a = 0; a < 2; ++a)
#pragma unroll
        for (int b = 0; b < 2; ++b)
#pragma unroll
            for (int m = 0; m < 4; ++m)
#pragma unroll
                for (int n = 0; n < 2; ++n) acc[a][b][m][n] = (f32x4){0.f, 0.f, 0.f, 0.f};
    bf16x8 At[4][2], B0[2][2], B1[2][2];
    const char* cA = cur.a; const char* cB = cur.b;
    if constexpr (GATHER) PG8_GOFF(voffA, cur);
    if constexpr (SP2) {
        PG8_STAGE(PG8_SB(0, 0), cB, voffB); PG8_STAGE(PG8_SB(0, 1), cB + hB, voffB); PG8_STAGE_A(PG8_SA(0, 0), cA, voffA, 0); PG8_STAGE_A(PG8_SA(0, 1), cA, voffA, 1);
        if (wr == 1) PG8_BAR;
        PG8_WAIT_V(2); PG8_BAR;
        PG8_STAGE(PG8_SB(1, 0), cB + kstep, voffB); PG8_STAGE_A(PG8_SA(1, 0), cA + kstep, voffA, 0); PG8_STAGE(PG8_SB(1, 1), cB + hB + kstep, voffB);
        PG8_WAIT_V(6); PG8_BAR;
    } else {
        PG8_STAGE(PG8_SB(0, 0), cB, voffB); PG8_STAGE_A(PG8_SA(0, 0), cA, voffA, 0); PG8_STAGE(PG8_SB(0, 1), cB + hB, voffB); PG8_STAGE_A(PG8_SA(0, 1), cA, voffA, 1);
        if (wr == 1) PG8_BAR;
        PG8_WAIT_V(4); PG8_BAR;
        PG8_STAGE(PG8_SB(1, 0), cB + kstep, voffB); PG8_STAGE_A(PG8_SA(1, 0), cA + kstep, voffA, 0); PG8_STAGE(PG8_SB(1, 1), cB + hB + kstep, voffB);
        PG8_WAIT_V(6); PG8_BAR;
    }
    for (;;) {
        const bool has_next = S.next(ui + 1, nxt);
        const char* nA = has_next ? nxt.a : cA; const char* nB = has_next ? nxt.b : cB;
        if constexpr (GATHER) { if (has_next) PG8_GOFF(voffN, nxt); else { _Pragma("unroll") for (int h_ = 0; h_ < 2; ++h_) _Pragma("unroll") for (int i_ = 0; i_ < 2; ++i_) voffN[h_][i_] = voffA[h_][i_]; } }
        for (int t = 0; t < nt; t += 2) {
            const bool last = (t == nt - 2);
            const char* a1 = cA + (size_t)(t + 1) * kstep;
            const char* a2 = last ? nA : cA + (size_t)(t + 2) * kstep; const char* b2 = last ? nB : cB + (size_t)(t + 2) * kstep;
            const char* a3 = a2 + kstep; const char* b3 = b2 + kstep;
            unsigned vo2[2][2];
            _Pragma("unroll") for (int h_ = 0; h_ < 2; ++h_) _Pragma("unroll") for (int i_ = 0; i_ < 2; ++i_) vo2[h_][i_] = (GATHER && last) ? voffN[h_][i_] : voffA[h_][i_];
            if constexpr (SP2) {
            PG8_LDB(B0, 0, 0); PG8_LDB(B1, 0, 1); PG8_SCHED; PG8_LDA(At, 0, 0); PG8_STAGE_A(PG8_SA(1, 1), a1, voffA, 1);
            PG8_WAIT_V(8); PG8_WAIT_L(0); PG8_BAR; PG8_MMA(0, 0, At, B0); PG8_MMA(0, 1, At, B1); PG8_BAR; PG8_SCHED;
            PG8_LDA(At, 0, 1); PG8_STAGE(PG8_SB(0, 0), b2, voffB); PG8_STAGE(PG8_SB(0, 1), b2 + hB, voffB); PG8_STAGE_A(PG8_SA(0, 0), a2, vo2, 0);
            PG8_WAIT_V(8); PG8_WAIT_L(0); PG8_BAR; PG8_MMA(1, 0, At, B0); PG8_MMA(1, 1, At, B1); PG8_BAR; PG8_SCHED;
            PG8_LDB(B0, 1, 0); PG8_LDB(B1, 1, 1); PG8_SCHED; PG8_LDA(At, 1, 0); PG8_STAGE_A(PG8_SA(0, 1), a2, vo2, 1);
            PG8_WAIT_V(8); PG8_WAIT_L(0); PG8_BAR; PG8_MMA(0, 0, At, B0); PG8_MMA(0, 1, At, B1); PG8_BAR; PG8_SCHED;
            PG8_LDA(At, 1, 1); PG8_STAGE(PG8_SB(1, 0), b3, voffB); PG8_STAGE(PG8_SB(1, 1), b3 + hB, voffB); PG8_STAGE_A(PG8_SA(1, 0), a3, vo2, 0);
            PG8_WAIT_V(8); PG8_WAIT_L(0); PG8_BAR; PG8_MMA(1, 0, At, B0); PG8_MMA(1, 1, At, B1); PG8_BAR; PG8_SCHED;
            } else {
            PG8_LDB(B0, 0, 0); PG8_SCHED; PG8_LDA(At, 0, 0); PG8_STAGE_A(PG8_SA(1, 1), a1, voffA, 1);
            PG8_WAIT_L(8); PG8_BAR; PG8_WAIT_L(0); PG8_MMA(0, 0, At, B0); PG8_BAR; PG8_SCHED;
            PG8_LDB(B1, 0, 1); PG8_STAGE(PG8_SB(0, 0), b2, voffB);
            PG8_BAR; PG8_WAIT_L(0); PG8_MMA(0, 1, At, B1); PG8_BAR;
            PG8_LDA(At, 0, 1); PG8_STAGE_A(PG8_SA(0, 0), a2, vo2, 0);
            PG8_BAR; PG8_WAIT_L(0); PG8_MMA(1, 0, At, B0); PG8_BAR; PG8_SCHED;
            PG8_STAGE(PG8_SB(0, 1), b2 + hB, voffB);
            PG8_WAIT_V(6); PG8_BAR; PG8_MMA(1, 1, At, B1); PG8_BAR;
            PG8_LDB(B0, 1, 0); PG8_SCHED; PG8_LDA(At, 1, 0); PG8_STAGE_A(PG8_SA(0, 1), a2, vo2, 1);
            PG8_WAIT_L(8); PG8_BAR; PG8_WAIT_L(0); PG8_MMA(0, 0, At, B0); PG8_BAR; PG8_SCHED;
            PG8_LDB(B1, 1, 1); PG8_STAGE(PG8_SB(1, 0), b3, voffB);
            PG8_BAR; PG8_WAIT_L(0); PG8_MMA(0, 1, At, B1); PG8_BAR;
            PG8_LDA(At, 1, 1); PG8_STAGE_A(PG8_SA(1, 0), a3, vo2, 0);
            PG8_BAR; PG8_WAIT_L(0); PG8_MMA(1, 0, At, B0); PG8_BAR; PG8_SCHED;
            PG8_STAGE(PG8_SB(1, 1), b3 + hB, voffB);
            PG8_WAIT_V(6); PG8_BAR; PG8_MMA(1, 1, At, B1); PG8_BAR;
            }
            if constexpr (Epi::HOOK) { if (t + 2 == 8 || t + 2 == 16) { int t3_ = threadIdx.x; asm volatile("" : "+v"(t3_)); E.mid(acc, cur, (t + 2) / 8 - 1, wr, wc, t3_ & 15, (t3_ >> 4) & 3); } }
        }
        if constexpr (ALIGN_EPI) { if (wr == 0) PG8_BAR; }
        { int t2_ = threadIdx.x; asm volatile("" : "+v"(t2_)); const int fr_ = t2_ & 15, fq_ = (t2_ >> 4) & 3;
          E(acc, cur, wr, wc, fr_, fq_); }
        if (!has_next) break;
#pragma unroll
        for (int a = 0; a < 2; ++a)
#pragma unroll
            for (int b = 0; b < 2; ++b)
#pragma unroll
                for (int m = 0; m < 4; ++m)
#pragma unroll
                    for (int n = 0; n < 2; ++n) acc[a][b][m][n] = (f32x4){0.f, 0.f, 0.f, 0.f};
        cur = nxt; cA = nA; cB = nB; ++ui;
        if constexpr (GATHER) { _Pragma("unroll") for (int h_ = 0; h_ < 2; ++h_) _Pragma("unroll") for (int i_ = 0; i_ < 2; ++i_) voffA[h_][i_] = voffN[h_][i_]; }
        if constexpr (ALIGN_EPI) { if (wr == 1) PG8_BAR; }
    }
    PG8_WAIT_V(0);
    if constexpr (!ALIGN_EPI) { if (wr == 0) PG8_BAR; }
    PG8_BAR;
#undef PG8_SA
#undef PG8_SB
#undef PG8_STAGE
#undef PG8_STAGE_A
#undef PG8_GOFF
#undef PG8_LDA
#undef PG8_LDB
#undef PG8_MMA
#undef PG8_WAIT_V
#undef PG8_WAIT_L
#undef PG8_BAR
#undef PG8_SCHED
}
}
namespace attn_body {
using bf16x8=__attribute__((ext_vector_type(8)))short;
using s16x4=__attribute__((ext_vector_type(4)))short;
using f32x16=__attribute__((ext_vector_type(16)))float;
using u32x4=__attribute__((ext_vector_type(4)))unsigned;
typedef unsigned short bf16;
constexpr int D=64,NW=8,QBLK=32,QB=QBLK*NW,KVBLK=64;
__device__ __forceinline__ int crow(int r,int hi){return (r&3)+8*(r>>2)+4*hi;}
#define SBAR() __builtin_amdgcn_sched_barrier(0)
constexpr int NSLOT=3, SLOTB=8192;
constexpr int LDS_K=0, LDS_V=NSLOT*SLOTB, LDS_WS=2*NSLOT*SLOTB, LDS_OST=LDS_WS+NW*64*4, LDS_BYTES=LDS_OST+NW*4096;
__device__ __forceinline__ void glds16(const void*gsrc,unsigned lds_dst){unsigned keep;
  asm volatile("s_mov_b32 %0, m0\n\ts_mov_b32 m0, %2\n\ts_nop 0\n\tglobal_load_lds_dwordx4 %1, off\n\ts_mov_b32 m0, %0":"=&s"(keep):"v"(gsrc),"s"(lds_dst):"memory");}
__device__ __forceinline__ float max3f(float a,float b,float c){float r;asm("v_max3_f32 %0, %1, %2, %3":"=v"(r):"v"(a),"v"(b),"v"(c));return r;}
__device__ __forceinline__ float max2f(float a,float b){float r;asm("v_max_f32_e32 %0, %1, %2":"=v"(r):"v"(a),"v"(b));return r;}
__device__ __forceinline__ float fadd_s(float a,float b){float r;asm("v_add_f32_e32 %0, %1, %2":"=v"(r):"v"(a),"v"(b));return r;}
__device__ __forceinline__ float fsub_s(float a,float b){float r;asm("v_sub_f32_e32 %0, %1, %2":"=v"(r):"v"(a),"v"(b));return r;}
typedef float f32x2_t __attribute__((ext_vector_type(2))); typedef __bf16 bf16x2_t __attribute__((ext_vector_type(2)));
__device__ __forceinline__ unsigned cvtpk_s(float lo,float hi){f32x2_t v={lo,hi};bf16x2_t b=__builtin_convertvector(v,bf16x2_t);return __builtin_bit_cast(unsigned,b);}
#define WAIT_BAR(N) asm volatile("s_waitcnt vmcnt(" #N ") lgkmcnt(0)\n\ts_barrier":::"memory")

__device__ __forceinline__ void qkt(f32x16&p0,f32x16&p1,const char*Kslot,const bf16x8*qr,const f32x16&negm,int r32,int hi){
  const char*kb=Kslot+hi*1024+r32*16;
  #pragma unroll
  for(int d0=0;d0<4;++d0){
    const bf16x8 b0=*reinterpret_cast<const bf16x8*>(kb+d0*2048);
    const bf16x8 b1=*reinterpret_cast<const bf16x8*>(kb+d0*2048+512);
    if(d0==0){p0=__builtin_amdgcn_mfma_f32_32x32x16_bf16(b0,qr[0],negm,0,0,0);p1=__builtin_amdgcn_mfma_f32_32x32x16_bf16(b1,qr[0],negm,0,0,0);}
    else{p0=__builtin_amdgcn_mfma_f32_32x32x16_bf16(b0,qr[d0],p0,0,0,0);p1=__builtin_amdgcn_mfma_f32_32x32x16_bf16(b1,qr[d0],p1,0,0,0);}}
}
typedef __attribute__((address_space(3))) const char* lds_cptr;
typedef short v4i16_t __attribute__((ext_vector_type(4)));
__device__ __forceinline__ void kload8(bf16x8*kf,lds_cptr kp){
  kf[0]=*(const __attribute__((address_space(3))) bf16x8*)(kp);      kf[1]=*(const __attribute__((address_space(3))) bf16x8*)(kp+512);
  kf[2]=*(const __attribute__((address_space(3))) bf16x8*)(kp+2048); kf[3]=*(const __attribute__((address_space(3))) bf16x8*)(kp+2560);
  kf[4]=*(const __attribute__((address_space(3))) bf16x8*)(kp+4096); kf[5]=*(const __attribute__((address_space(3))) bf16x8*)(kp+4608);
  kf[6]=*(const __attribute__((address_space(3))) bf16x8*)(kp+6144); kf[7]=*(const __attribute__((address_space(3))) bf16x8*)(kp+6656);
}
__device__ __forceinline__ void kload2(bf16x8*kf,lds_cptr kp,int j){ kf[2*j]=*(const __attribute__((address_space(3))) bf16x8*)(kp+j*2048); kf[2*j+1]=*(const __attribute__((address_space(3))) bf16x8*)(kp+j*2048+512); }
__device__ __forceinline__ s16x4 vtr(lds_cptr p){ return __builtin_bit_cast(s16x4,__builtin_amdgcn_ds_read_tr16_b64_v4i16((__attribute__((address_space(3))) v4i16_t*)p)); }
__device__ __forceinline__ float rowmax(const f32x16&p0,const f32x16&p1){
  float a=max3f(p0[0],p0[1],p1[0]),b=max3f(p0[2],p0[3],p1[1]);a=max3f(a,p1[2],p1[3]);
  #pragma unroll
  for(int r=4;r<16;r+=4){a=max3f(a,p0[r],p0[r+1]);b=max3f(b,p0[r+2],p0[r+3]);a=max3f(a,p1[r],p1[r+1]);b=max3f(b,p1[r+2],p1[r+3]);}
  const float m=max2f(a,b);
  auto rr=__builtin_amdgcn_permlane32_swap(__float_as_uint(m),__float_as_uint(m),false,false);
  return max2f(__uint_as_float(rr[0]),__uint_as_float(rr[1]));
}
__device__ __forceinline__ float rowmax16(const f32x16&p){
  float a=__builtin_fmaxf(__builtin_fmaxf(p[0],p[1]),p[2]),b=__builtin_fmaxf(__builtin_fmaxf(p[3],p[4]),p[5]);
  a=__builtin_fmaxf(__builtin_fmaxf(a,p[6]),p[7]); b=__builtin_fmaxf(__builtin_fmaxf(b,p[8]),p[9]); a=__builtin_fmaxf(__builtin_fmaxf(a,p[10]),p[11]); b=__builtin_fmaxf(__builtin_fmaxf(b,p[12]),p[13]);
  a=__builtin_fmaxf(__builtin_fmaxf(a,p[14]),p[15]);
  const float m=__builtin_fmaxf(a,b);
  auto rr=__builtin_amdgcn_permlane32_swap(__float_as_uint(m),__float_as_uint(m),false,false);
  return __builtin_fmaxf(__uint_as_float(rr[0]),__uint_as_float(rr[1]));
}
__device__ __forceinline__ void pv(f32x16*o,int vb,bf16x8 pa0,bf16x8 pa1,bf16x8 pa2,bf16x8 pa3){
  #pragma unroll
  for(int d0=0;d0<2;++d0){s16x4 lo[4],hi[4];
    #pragma unroll
    for(int ks=0;ks<4;++ks){
      asm volatile("ds_read_b64_tr_b16 %0,%1 offset:%c2":"=&v"(lo[ks]):"v"(vb),"i"(d0*4096+ks*1024):"memory");
      asm volatile("ds_read_b64_tr_b16 %0,%1 offset:%c2":"=&v"(hi[ks]):"v"(vb),"i"(d0*4096+ks*1024+512):"memory");}
    asm volatile("s_waitcnt lgkmcnt(0)":::"memory");SBAR();
    #define PK(k) (bf16x8){lo[k][0],lo[k][1],lo[k][2],lo[k][3],hi[k][0],hi[k][1],hi[k][2],hi[k][3]}
    o[d0]=__builtin_amdgcn_mfma_f32_32x32x16_bf16(pa0,PK(0),o[d0],0,0,0);
    o[d0]=__builtin_amdgcn_mfma_f32_32x32x16_bf16(pa1,PK(1),o[d0],0,0,0);
    o[d0]=__builtin_amdgcn_mfma_f32_32x32x16_bf16(pa2,PK(2),o[d0],0,0,0);
    o[d0]=__builtin_amdgcn_mfma_f32_32x32x16_bf16(pa3,PK(3),o[d0],0,0,0);
    #undef PK
  }
}

template<int MODE,int THRL> __device__ __forceinline__ void attn_unit(const bf16*Qw,long qpitch,const bf16*__restrict__ Kh,const bf16*__restrict__ Vh,long kvpitch,
    int NT,int nA,long rowB,bf16*Ow,long opitch,char*shm,lds_cptr btab_c,int qrow0,int jb0){
  int tid=threadIdx.x; asm volatile("":"+v"(tid)); const int lane=tid&63,r32=lane&31,hi=lane>>5; const int wid=__builtin_amdgcn_readfirstlane(tid>>6);
  const unsigned lds0=(unsigned)(uintptr_t)shm;
  float*wsf=(float*)(shm+LDS_WS)+wid*64;
  const bf16*ksrc=Kh+(long)lane*kvpitch+wid*8;
  const bf16*vsrc=Vh+(long)(16*(wid&3)+(lane>>2))*kvpitch+(wid>>2)*32+(lane&3)*8;
  const unsigned kdst=lds0+LDS_K+wid*1024, vdst=lds0+LDS_V+wid*1024;
  #define TR(t) (((t)<nA)?(long)(t)*KVBLK:rowB+(long)((t)-nA)*KVBLK)
  #define DMA_K(t,slot) glds16(ksrc+TR(t)*kvpitch,(unsigned)__builtin_amdgcn_readfirstlane(kdst+(slot)))
  #define DMA_V(t,slot) glds16(vsrc+TR(t)*kvpitch,(unsigned)__builtin_amdgcn_readfirstlane(vdst+(slot)))
  const int vb0=(int)(lds0+LDS_V)+((lane>>4)&1)*32+(lane&3)*8+(4*hi+((lane&15)>>2))*64;
  const char*Kbase=shm+LDS_K; bf16x8 kf[8];
  const lds_cptr shm3=(lds_cptr)shm; const lds_cptr kp0=shm3+LDS_K+hi*1024+r32*16; const lds_cptr vp0=shm3+LDS_V+((lane>>4)&1)*32+(lane&3)*8+(4*hi+((lane&15)>>2))*64;
  const int qrow_=qrow0+(wid>>1), qc_=32*(wid&1)+r32;
  const int cs_=min(max(qc_-8,0),48), rs_=min(max(qrow_-4,0),56);
  const int koff_=4*hi-cs_, boff_=15-qc_+4*hi;
  const float NEGV=-INFINITY;
  #define NAMASK(C0,C1,t) do{ if(MODE==1 && (t)>=4){ const int jrow_=jb0+(t)-4; \
      if(jrow_<rs_||jrow_>rs_+7){ _Pragma("unroll") for(int r=0;r<16;++r){C0[r]=NEGV;C1[r]=NEGV;} } \
      else { const __attribute__((address_space(3))) float* tb_=(const __attribute__((address_space(3))) float*)btab_c+((jrow_-qrow_+7)*32+boff_); \
        _Pragma("unroll") for(int r=0;r<16;++r){ const int kc_=(r&3)+8*(r>>2); const float b0_=tb_[kc_], b1_=tb_[kc_+32]; \
          C0[r]=((unsigned)(kc_+koff_)<16u)?(C0[r]+b0_):NEGV; C1[r]=((unsigned)(kc_+32+koff_)<16u)?(C1[r]+b1_):NEGV; } } } }while(0)
  DMA_K(0,0);DMA_V(0,0);DMA_K(1,SLOTB);
  bf16x8 qr[4];
  { const bf16*Qr=Qw+(long)(wid*QBLK+r32)*qpitch;
  #pragma unroll
  for(int d0=0;d0<4;++d0)qr[d0]=*reinterpret_cast<const bf16x8*>(&Qr[d0*16+hi*8]); }
  float mhat=0.f,l_reg=0.f;f32x16 o[2];o[0]=f32x16{};o[1]=f32x16{};f32x16 negm=f32x16{};asm volatile("":"+v"(negm));
  bool resc=false;
  #define START(P0,P1) do{ const float rm=rowmax(P0,P1); resc=false; \
    { const float dl=rm; mhat=fadd_s(mhat,dl); \
      _Pragma("unroll") for(int r=0;r<16;++r){P0[r]=fsub_s(P0[r],dl);P1[r]=fsub_s(P1[r],dl);} \
      _Pragma("unroll") for(int r=0;r<16;++r)negm[r]=-mhat; asm volatile("":"+v"(negm)); } \
    _Pragma("unroll") for(int r=0;r<16;++r)P0[r]=__builtin_amdgcn_exp2f(P0[r]); }while(0)
  #define RESC() do{ if(resc){ asm volatile("s_waitcnt lgkmcnt(0)":::"memory"); \
      _Pragma("unroll") for(int d_=0;d_<2;++d_) _Pragma("unroll") for(int r=0;r<16;++r)o[d_][r]*=wsf[crow(r,hi)]; } }while(0)
  f32x16 pA0,pA1,pB0,pB1;
  int sl_prev=0,sl_cur=0,sl_next=SLOTB;
  #define ROT() do{sl_prev=sl_cur;sl_cur=sl_next;sl_next=(sl_next==(NSLOT-1)*SLOTB)?0:sl_next+SLOTB;}while(0)
  DMA_K(2,2*SLOTB);
  WAIT_BAR(3);
  qkt(pA0,pA1,Kbase,qr,negm,r32,hi);asm volatile("s_nop 15\n\ts_nop 7":"+v"(pA0),"+v"(pA1));
  START(pA0,pA1);
  _Pragma("unroll") for(int r=0;r<16;++r)pA1[r]=__builtin_amdgcn_exp2f(pA1[r]);
  WAIT_BAR(0);
  DMA_K(3,0);DMA_V(1,SLOTB);
  ROT();
  kload8(kf,kp0+sl_cur);
  WAIT_BAR(2);
  s16x4 vlo[8],vhi[8]; u32x4 pw0,pw1,pw2,pw3;
  #define PKW(P,B) cvtpk_s(P[B],P[B+1])
  #define PAF(k) __builtin_bit_cast(bf16x8,pw##k)
  #define VFR(i) (bf16x8){vlo[i][0],vlo[i][1],vlo[i][2],vlo[i][3],vhi[i][0],vhi[i][1],vhi[i][2],vhi[i][3]}
  #define PIN(x) asm volatile("":"+v"(x))
  #define MX3(a,b,c) __builtin_fmaxf(__builtin_fmaxf((a),(b)),(c))
  #define GAPA(MF,A0,A1,A2,A3,W0,W1,PW) do{ MF; sacc+=A0; sacc+=A1; sacc+=A2; sacc+=A3; PIN(sacc); W0; W1; PIN(PW); SBAR(); }while(0)
  #define EX(v) __builtin_amdgcn_exp2f(v)
  #define GAPB(MF,X,B) do{ MF; X[B]=EX(X[B]); X[B+1]=EX(X[B+1]); X[B+2]=EX(X[B+2]); X[B+3]=EX(X[B+3]); PIN(X); SBAR(); }while(0)
  #define VRD(i) do{ vlo[i]=vtr(vp_+(((i)>>2)*4096+((i)&3)*1024)); vhi[i]=vtr(vp_+(((i)>>2)*4096+((i)&3)*1024+512)); }while(0)
  #define KRD(G,j) do{ if(G){ kload2(kf,kp0+sl_next,j); SBAR(); } }while(0)
  #define STEP(C0,C1,P0,P1,t,GK,GV,GL) do{ SBAR(); \
    const lds_cptr vp_=vp0+sl_prev; \
    VRD(0); SBAR(); float sacc=(P0[0]+P0[1]); \
    GAPA(C0=__builtin_amdgcn_mfma_f32_32x32x16_bf16(kf[0],qr[0],negm,0,0,0), P0[2],P0[3],P0[4],P0[5],     pw0[0]=PKW(P0,0), pw0[1]=PKW(P0,2), pw0); \
    VRD(4); SBAR(); GAPA(C1=__builtin_amdgcn_mfma_f32_32x32x16_bf16(kf[1],qr[0],negm,0,0,0), P0[6],P0[7],P0[8],P0[9],     pw0[2]=PKW(P0,4), pw0[3]=PKW(P0,6), pw0); \
    VRD(1); SBAR(); GAPA(C0=__builtin_amdgcn_mfma_f32_32x32x16_bf16(kf[2],qr[1],C0,0,0,0),   P0[10],P0[11],P0[12],P0[13], pw1[0]=PKW(P0,8), pw1[1]=PKW(P0,10), pw1); \
    VRD(5); SBAR(); GAPA(C1=__builtin_amdgcn_mfma_f32_32x32x16_bf16(kf[3],qr[1],C1,0,0,0),   P0[14],P0[15],P1[0],P1[1],   pw1[2]=PKW(P0,12),pw1[3]=PKW(P0,14), pw1); \
    VRD(2); SBAR(); GAPA(C0=__builtin_amdgcn_mfma_f32_32x32x16_bf16(kf[4],qr[2],C0,0,0,0),   P1[2],P1[3],P1[4],P1[5],     pw2[0]=PKW(P1,0), pw2[1]=PKW(P1,2), pw2); \
    VRD(6); SBAR(); GAPA(C1=__builtin_amdgcn_mfma_f32_32x32x16_bf16(kf[5],qr[2],C1,0,0,0),   P1[6],P1[7],P1[8],P1[9],     pw2[2]=PKW(P1,4), pw2[3]=PKW(P1,6), pw2); \
    VRD(3); SBAR(); GAPA(C0=__builtin_amdgcn_mfma_f32_32x32x16_bf16(kf[6],qr[3],C0,0,0,0),   P1[10],P1[11],P1[12],P1[13], pw3[0]=PKW(P1,8), pw3[1]=PKW(P1,10), pw3); \
    VRD(7); SBAR(); GAPA(C1=__builtin_amdgcn_mfma_f32_32x32x16_bf16(kf[7],qr[3],C1,0,0,0),   P1[14],P1[15],0.f,0.f,       pw3[2]=PKW(P1,12),pw3[3]=PKW(P1,14), pw3); \
    l_reg+=sacc; \
    if(GK){DMA_K((t)+3,sl_cur);} if(GV){DMA_V((t)+1,sl_next);} \
    NAMASK(C0,C1,t); \
    if constexpr (THRL < 1000) { \
    { float a=MX3(C0[0],C0[1],C1[0]),b=MX3(C0[2],C0[3],C1[1]); a=MX3(a,C1[2],C1[3]); \
      _Pragma("unroll") for(int r=4;r<16;r+=4){a=MX3(a,C0[r],C0[r+1]);b=MX3(b,C0[r+2],C0[r+3]);a=MX3(a,C1[r],C1[r+1]);b=MX3(b,C1[r+2],C1[r+3]);} \
      float rm=__builtin_fmaxf(a,b); { auto rr=__builtin_amdgcn_permlane32_swap(__float_as_uint(rm),__float_as_uint(rm),false,false); rm=__builtin_fmaxf(__uint_as_float(rr[0]),__uint_as_float(rr[1])); } \
      resc=false; \
      if(__builtin_expect(__any(rm>(float)THRL),0)){ const float dl=__builtin_fmaxf(rm,0.f); mhat+=dl; \
        _Pragma("unroll") for(int r=0;r<16;++r){C0[r]-=dl;C1[r]-=dl;} \
        _Pragma("unroll") for(int r=0;r<16;++r)negm[r]=-mhat; asm volatile("":"+v"(negm)); \
        const float f=__builtin_amdgcn_exp2f(-dl); l_reg*=f; if(hi==0)wsf[r32]=f; resc=true; } } \
    } \
    SBAR(); \
    GAPB(o[0]=__builtin_amdgcn_mfma_f32_32x32x16_bf16(PAF(0),VFR(0),o[0],0,0,0), C0,0); \
    GAPB(o[1]=__builtin_amdgcn_mfma_f32_32x32x16_bf16(PAF(0),VFR(4),o[1],0,0,0), C0,4); \
    KRD(GL,0); GAPB(o[0]=__builtin_amdgcn_mfma_f32_32x32x16_bf16(PAF(1),VFR(1),o[0],0,0,0), C0,8); \
    KRD(GL,1); GAPB(o[1]=__builtin_amdgcn_mfma_f32_32x32x16_bf16(PAF(1),VFR(5),o[1],0,0,0), C0,12); \
    KRD(GL,2); GAPB(o[0]=__builtin_amdgcn_mfma_f32_32x32x16_bf16(PAF(2),VFR(2),o[0],0,0,0), C1,0); \
    KRD(GL,3); GAPB(o[1]=__builtin_amdgcn_mfma_f32_32x32x16_bf16(PAF(2),VFR(6),o[1],0,0,0), C1,4); \
    GAPB(o[0]=__builtin_amdgcn_mfma_f32_32x32x16_bf16(PAF(3),VFR(3),o[0],0,0,0), C1,8); \
    GAPB(o[1]=__builtin_amdgcn_mfma_f32_32x32x16_bf16(PAF(3),VFR(7),o[1],0,0,0), C1,12); \
    }while(0)
  int t=1;
  for(;t+5<NT;t+=2){
    STEP(pB0,pB1,pA0,pA1,t,true,true,true);     WAIT_BAR(2); RESC(); ROT();
    STEP(pA0,pA1,pB0,pB1,t+1,true,true,true);   WAIT_BAR(2); RESC(); ROT();
  }
  #define ENDW(tt) do{ if((tt)+3<NT){WAIT_BAR(2);} else if((tt)+2<NT){WAIT_BAR(1);} else {WAIT_BAR(0);} }while(0)
  for(;t+1<NT;t+=2){
    STEP(pB0,pB1,pA0,pA1,t,(t+3<NT),(t+1<NT),(t+1<NT));       ENDW(t);   RESC(); ROT();
    STEP(pA0,pA1,pB0,pB1,t+1,(t+4<NT),(t+2<NT),(t+2<NT));     ENDW(t+1); RESC(); ROT();
  }
  STEP(pB0,pB1,pA0,pA1,NT-1,false,false,false); RESC();
  { float sacc=pB0[0]+pB0[1]; _Pragma("unroll") for(int r=2;r<16;++r)sacc+=pB0[r]; _Pragma("unroll") for(int r=0;r<16;++r)sacc+=pB1[r]; l_reg+=sacc;
    pw0=(u32x4){PKW(pB0,0),PKW(pB0,2),PKW(pB0,4),PKW(pB0,6)};pw1=(u32x4){PKW(pB0,8),PKW(pB0,10),PKW(pB0,12),PKW(pB0,14)};pw2=(u32x4){PKW(pB1,0),PKW(pB1,2),PKW(pB1,4),PKW(pB1,6)};pw3=(u32x4){PKW(pB1,8),PKW(pB1,10),PKW(pB1,12),PKW(pB1,14)};
    SBAR(); pv(o,vb0+sl_cur,PAF(0),PAF(1),PAF(2),PAF(3)); }
  #undef PKW
  #undef PAF
  #undef VFR
  #undef PIN
  #undef MX3
  #undef GAPA
  #undef GAPB
  #undef EX
  #undef VRD
  #undef KRD
  #undef STEP
  #undef ENDW
  {auto rr=__builtin_amdgcn_permlane32_swap(__float_as_uint(l_reg),__float_as_uint(l_reg),false,false);l_reg=__uint_as_float(rr[0])+__uint_as_float(rr[1]);}
  if(hi==0)wsf[32+r32]=l_reg;asm volatile("s_waitcnt lgkmcnt(0)":::"memory");
  float rli[16];
  #pragma unroll
  for(int r=0;r<16;++r)rli[r]=__builtin_amdgcn_rcpf(wsf[32+crow(r,hi)]);
  bf16*Owv=Ow+(long)(wid*QBLK)*opitch;
  { bf16*stg=(bf16*)(shm+LDS_OST)+wid*2048;
    #pragma unroll
    for(int r=0;r<16;++r){const int orow=crow(r,hi);
      #pragma unroll
      for(int d0=0;d0<2;++d0)stg[orow*64+d0*32+r32]=(bf16)f2bf(o[d0][r]*rli[r]);}
    asm volatile("s_waitcnt lgkmcnt(0)":::"memory");
    #pragma unroll
    for(int i=0;i<4;++i){const int row=i*8+(lane>>3),ch=lane&7; const u32x4 v=*(const u32x4*)(stg+row*64+ch*8); *(u32x4*)(Owv+(long)row*opitch+ch*8)=v;} }
  asm volatile("s_waitcnt lgkmcnt(0)\n\ts_barrier":::"memory");
  #undef DMA_K
  #undef DMA_V
  #undef TR
  #undef NAMASK
  #undef START
  #undef RESC
  #undef ROT
}
constexpr int ATTN_LDS_BYTES=LDS_BYTES;

template<int NBLK_DUMMY=0> __device__ __forceinline__ void na_unit(const bf16* __restrict__ Pb  , int h, int rg, bf16* Ob  , char* shm, lds_cptr tab  ){
  int tid=threadIdx.x; asm volatile("":"+v"(tid)); const int lane=tid&63,r32=lane&31,hi=lane>>5; const int wid=__builtin_amdgcn_readfirstlane(tid>>6);
  const int y0=4*rg+2*(wid>>2), x0=16*(wid&3);
  const int jb=min(max(y0-4,0),55), cb=min(max(x0-8,0),32);
  const int qrow=y0+(r32>>4), qcol=x0+(r32&15), qtok=qrow*64+qcol;
  const int rsq=min(max(qrow-4,0),56), csq=min(max(qcol-8,0),48);
  const bf16* Qp=Pb+(long)qtok*PW+C_BQ+h*64+hi*8;
  bf16x8 qr[4];
  #pragma unroll
  for(int ks=0;ks<4;++ks)qr[ks]=*reinterpret_cast<const bf16x8*>(Qp+ks*16);
  const bf16* Ksrc=Pb+C_BK+h*64+(long)(lane>>3)*PW+(((lane&7)^(lane>>3))*8);
  const bf16* Vsrc=Pb+C_BV+h*64+(long)(lane>>3)*PW+(((lane&7)^(lane>>3))*8);
  const unsigned wb0=(unsigned)(uintptr_t)shm+wid*16384;
  typedef const __attribute__((address_space(3))) bf16x8* lds_b8;
  const lds_cptr wl=(lds_cptr)shm+wid*16384;
  int kofs[4];
  #pragma unroll
  for(int ks=0;ks<4;++ks) kofs[ks]=r32*128+(((2*ks+hi)^(r32&7))*16);
  const int q4=(lane&15)>>2, p4=lane&3, h16=(lane>>4)&1, sw=4*hi+q4;
  const int vofs0=sw*128+(((2*h16+(p4>>1))^sw)*16)+(p4&1)*8, vofs1=sw*128+(((4+2*h16+(p4>>1))^sw)*16)+(p4&1)*8;
  typedef const __attribute__((address_space(3))) float* lds_fptr;
  lds_fptr ta[16];
  #pragma unroll
  for(int r=0;r<16;++r){ const int kc=cb+(r&3)+8*(r>>2)+4*hi; const int idx=((unsigned)(kc-csq)<16u)?(kc-qcol+15):31; ta[r]=(lds_fptr)tab+(jb-qrow+7)*32+idx; }
  const float rm0=((unsigned)(jb-rsq)<8u)?1.f:0.f, rm8=((unsigned)(jb+8-rsq)<8u)?1.f:0.f;
  #define NA_TOK(i) ((i)<8 ? NLAT+32*(i) : (jb+(i)-8)*64+cb)
  #define NA_LOADK(i) do{ const long t0_=(long)NA_TOK(i); \
      _Pragma("unroll") for(int j_=0;j_<4;++j_) glds16(Ksrc+(t0_+8*j_)*PW,(unsigned)__builtin_amdgcn_readfirstlane(wb0+((i)&1)*4096+j_*1024)); }while(0)
  #define NA_LOADV(i) do{ const long t0_=(long)NA_TOK(i); \
      _Pragma("unroll") for(int j_=0;j_<4;++j_) glds16(Vsrc+(t0_+8*j_)*PW,(unsigned)__builtin_amdgcn_readfirstlane(wb0+8192+((i)&1)*4096+j_*1024)); }while(0)
  #define NA_QK(i,c_) do{ const lds_cptr kp_=wl+((i)&1)*4096; bf16x8 kf_[4]; _Pragma("unroll") for(int ks=0;ks<4;++ks) kf_[ks]=*(lds_b8)(kp_+kofs[ks]); \
    c_=__builtin_amdgcn_mfma_f32_32x32x16_bf16(kf_[0],qr[0],negm,0,0,0); c_=__builtin_amdgcn_mfma_f32_32x32x16_bf16(kf_[1],qr[1],c_,0,0,0); \
    c_=__builtin_amdgcn_mfma_f32_32x32x16_bf16(kf_[2],qr[2],c_,0,0,0); c_=__builtin_amdgcn_mfma_f32_32x32x16_bf16(kf_[3],qr[3],c_,0,0,0); }while(0)
  f32x16 o0=f32x16{},o1=f32x16{},negm=f32x16{}; float l_reg=0.f;
  asm volatile("s_waitcnt vmcnt(0)":::"memory");
  NA_LOADK(0); NA_LOADV(0); NA_LOADK(1); NA_LOADV(1);
  f32x16 cA,cB;
  asm volatile("s_waitcnt vmcnt(12)":::"memory");
  NA_QK(0,cA);
  { const float m_=rowmax16(cA); _Pragma("unroll") for(int r=0;r<16;++r){ cA[r]-=m_; negm[r]=-m_; } }
  #define NA_STEP(i,cc_,cn_) do{ \
    if((i)+2<17){ NA_LOADK((i)+2); asm volatile("s_waitcnt vmcnt(8)":::"memory"); } else if((i)+1<17){ asm volatile("s_waitcnt vmcnt(4)":::"memory"); } else { asm volatile("s_waitcnt vmcnt(0)":::"memory"); } \
    if((i)+1<17){ NA_QK((i)+1,cn_); } \
    const lds_cptr vp_=wl+8192+((i)&1)*4096; \
    s16x4 vl_[4],vh_[4]; \
    _Pragma("unroll") for(int kg=0;kg<2;++kg){ vl_[kg]=vtr(vp_+vofs0+kg*2048); vh_[kg]=vtr(vp_+vofs0+kg*2048+1024); vl_[2+kg]=vtr(vp_+vofs1+kg*2048); vh_[2+kg]=vtr(vp_+vofs1+kg*2048+1024); } \
    if((i)>=8){ _Pragma("unroll") for(int r=0;r<16;++r) cc_[r]+=ta[r][((i)-8)*32]; } \
    _Pragma("unroll") for(int r=0;r<16;++r) cc_[r]=__builtin_amdgcn_exp2f(cc_[r]); \
    if((i)==8){ _Pragma("unroll") for(int r=0;r<16;++r) cc_[r]*=rm0; } \
    if((i)==16){ _Pragma("unroll") for(int r=0;r<16;++r) cc_[r]*=rm8; } \
    { float s_=(cc_[0]+cc_[1])+(cc_[2]+cc_[3]); _Pragma("unroll") for(int r=4;r<16;r+=4) s_+=(cc_[r]+cc_[r+1])+(cc_[r+2]+cc_[r+3]); l_reg+=s_; } \
    const u32x4 pa_=(u32x4){cvtpk_s(cc_[0],cc_[1]),cvtpk_s(cc_[2],cc_[3]),cvtpk_s(cc_[4],cc_[5]),cvtpk_s(cc_[6],cc_[7])}, pb_=(u32x4){cvtpk_s(cc_[8],cc_[9]),cvtpk_s(cc_[10],cc_[11]),cvtpk_s(cc_[12],cc_[13]),cvtpk_s(cc_[14],cc_[15])}; \
    asm volatile("s_waitcnt lgkmcnt(0)":::"memory"); \
    if((i)+2<17){ NA_LOADV((i)+2); } \
    o0=__builtin_amdgcn_mfma_f32_32x32x16_bf16(__builtin_bit_cast(bf16x8,pa_),(bf16x8){vl_[0][0],vl_[0][1],vl_[0][2],vl_[0][3],vh_[0][0],vh_[0][1],vh_[0][2],vh_[0][3]},o0,0,0,0); \
    o1=__builtin_amdgcn_mfma_f32_32x32x16_bf16(__builtin_bit_cast(bf16x8,pa_),(bf16x8){vl_[2][0],vl_[2][1],vl_[2][2],vl_[2][3],vh_[2][0],vh_[2][1],vh_[2][2],vh_[2][3]},o1,0,0,0); \
    o0=__builtin_amdgcn_mfma_f32_32x32x16_bf16(__builtin_bit_cast(bf16x8,pb_),(bf16x8){vl_[1][0],vl_[1][1],vl_[1][2],vl_[1][3],vh_[1][0],vh_[1][1],vh_[1][2],vh_[1][3]},o0,0,0,0); \
    o1=__builtin_amdgcn_mfma_f32_32x32x16_bf16(__builtin_bit_cast(bf16x8,pb_),(bf16x8){vl_[3][0],vl_[3][1],vl_[3][2],vl_[3][3],vh_[3][0],vh_[3][1],vh_[3][2],vh_[3][3]},o1,0,0,0); \
  }while(0)
  NA_STEP(0,cA,cB); NA_STEP(1,cB,cA); NA_STEP(2,cA,cB); NA_STEP(3,cB,cA); NA_STEP(4,cA,cB); NA_STEP(5,cB,cA); NA_STEP(6,cA,cB); NA_STEP(7,cB,cA); NA_STEP(8,cA,cB);
  NA_STEP(9,cB,cA); NA_STEP(10,cA,cB); NA_STEP(11,cB,cA); NA_STEP(12,cA,cB); NA_STEP(13,cB,cA); NA_STEP(14,cA,cB); NA_STEP(15,cB,cA); NA_STEP(16,cA,cB);
  #undef NA_STEP
  #undef NA_QK
  #undef NA_LOADK
  #undef NA_LOADV
  #undef NA_TOK
  {auto rr=__builtin_amdgcn_permlane32_swap(__float_as_uint(l_reg),__float_as_uint(l_reg),false,false);l_reg=__uint_as_float(rr[0])+__uint_as_float(rr[1]);}
  float*wsf=(float*)(shm+wid*16384+4096);
  if(hi==0)wsf[r32]=l_reg; asm volatile("s_waitcnt lgkmcnt(0)":::"memory");
  float rli[16];
  #pragma unroll
  for(int r=0;r<16;++r)rli[r]=__builtin_amdgcn_rcpf(wsf[crow(r,hi)]);
  { bf16*stg=(bf16*)(shm+wid*16384);
    #pragma unroll
    for(int r=0;r<16;++r){const int orow=crow(r,hi); stg[orow*64+r32]=(bf16)f2bf(o0[r]*rli[r]); stg[orow*64+32+r32]=(bf16)f2bf(o1[r]*rli[r]);}
    asm volatile("s_waitcnt lgkmcnt(0)":::"memory");
    #pragma unroll
    for(int i=0;i<4;++i){const int row=i*8+(lane>>3),ch=lane&7; const u32x4 v=*(const u32x4*)(stg+row*64+ch*8);
      const int tok=(y0+(row>>4))*64+x0+(row&15); *(u32x4*)(Ob+(long)tok*OW+512+h*64+ch*8)=v;}
    asm volatile("s_waitcnt lgkmcnt(0)":::"memory"); }
}
#undef SBAR
#undef WAIT_BAR
}
constexpr size_t MiB = 1u << 20;
constexpr size_t WS_CTL = 0, CTL_ZERO_BYTES = 2 * MiB;
constexpr size_t WS_MOD = 1 * MiB;
constexpr size_t WS_ROPE = 2 * MiB;
constexpr size_t WS_TOK = 3 * MiB;
constexpr size_t WS_XC = 5 * MiB;
constexpr size_t WS_WR = 4 * MiB + 512 * 1024;
constexpr size_t WS_WIN = 21 * MiB, WIN_L = 15 * MiB;
constexpr size_t WS_WBR = 51 * MiB, WBR_L = 3 * MiB;
constexpr size_t WS_WOUT = 57 * MiB, WOUT_L = 2 * MiB;
constexpr size_t WS_WGU = 61 * MiB, WGU_L = 32 * MiB;
constexpr size_t WS_WDN = 125 * MiB, WDN_L = 16 * MiB;
constexpr size_t WS_H = 157 * MiB;
constexpr size_t WS_P = 225 * MiB;
constexpr size_t WS_GATES = 514 * MiB;
constexpr size_t WS_OUTS = 517 * MiB;
constexpr size_t WS_HDIR = 619 * MiB;
constexpr size_t WS_Y = WS_HDIR;
constexpr size_t WS_MERGED = 687 * MiB;
constexpr size_t WS_SG = 755 * MiB;
constexpr size_t WS_LIST = 960 * MiB;
constexpr int LIST_CAP = 2 * TG;
constexpr size_t WS_END = 969 * MiB;
constexpr int XS_ROWS = 77824;
constexpr size_t WS_XS = WS_P;
constexpr size_t WS_ACT = WS_P + 152 * MiB;
constexpr size_t WS_YS = WS_P + 190 * MiB;
static_assert(WS_YS + (size_t)XS_ROWS * 2048 <= WS_HDIR + 68 * MiB, "overlay map");
constexpr int CW_BAR = 4096;
constexpr int CW_Q = 8192;
constexpr int CW_ECNT = 16384;

constexpr int RING_OFF = 0, RING_BYTES = 131072;
constexpr int LDSX_OFF = RING_BYTES;
constexpr int LDSCTL_OFF = 144 * 1024 - 512;
constexpr int LDS_BYTES = 147456;

#define RLX_AGENT __ATOMIC_RELAXED, __HIP_MEMORY_SCOPE_AGENT
#define LDS_WAIT() asm volatile("s_waitcnt lgkmcnt(0)" ::: "memory")
#define VM_WAIT() asm volatile("s_waitcnt vmcnt(0)" ::: "memory")

#define XB_TMO      128
#define XB_XCNT(j)  (256  + 64 * (j))
#define XB_XSUB(j)  (1280 + 64 * (j))
#define XB_XGEN(j)  (2304 + 64 * (j))
#define XB_TOP      3328
#define XB_TOPGEN   3392
#define XCD_BAR_WORDS 3456
#define XB_SPIN_CAP (1u << 24)

__device__ __forceinline__ unsigned xb_ld(unsigned* p)              { return __hip_atomic_load(p, __ATOMIC_RELAXED, __HIP_MEMORY_SCOPE_AGENT); }
__device__ __forceinline__ unsigned xb_add(unsigned* p, unsigned v) { return __hip_atomic_fetch_add(p, v, __ATOMIC_RELAXED, __HIP_MEMORY_SCOPE_AGENT); }
__device__ __forceinline__ unsigned xb_xcc_id() { return (unsigned)__builtin_amdgcn_s_getreg((3 << 11) | 20) & 0xFu; }
#define XB_SPIN(cond, bar) do { unsigned _sp = 0; while (cond) { __builtin_amdgcn_s_sleep(1); \
    if ((++_sp & 255u) == 0u) { if (xb_ld(&(bar)[XB_TMO])) break; if (_sp > XB_SPIN_CAP) { atomicAdd(&(bar)[XB_TMO], 1u); break; } } } } while (0)

struct XcdBarrier { unsigned* bar; unsigned x; volatile LAS unsigned* st; };

__device__ __forceinline__ XcdBarrier xcd_barrier_post(unsigned* bar, volatile LAS unsigned* st) {
    XcdBarrier b; b.bar = bar; b.x = xb_xcc_id(); b.st = st;
    if (threadIdx.x == 0) (void)xb_add(&bar[XB_XCNT(b.x)], 1u);
    return b;
}
__device__ __forceinline__ void xcd_barrier_complete(unsigned* bar, unsigned x, unsigned& nloc, unsigned& nx) {
    const unsigned G = gridDim.x * gridDim.y * gridDim.z;
    unsigned sum, cnt, mine, sp = 0u;
    for (;;) {
        sum = 0u; cnt = 0u; mine = 0u;
#pragma unroll
        for (unsigned j = 0; j < 16; ++j) { const unsigned c = xb_ld(&bar[XB_XCNT(j)]); sum += c; cnt += (c > 0u) ? 1u : 0u; mine = (j == x) ? c : mine; }
        if (sum == G) break;
        __builtin_amdgcn_s_sleep(1);
        if ((++sp & 255u) == 0u) { if (xb_ld(&bar[XB_TMO])) break; if (sp > XB_SPIN_CAP) { atomicAdd(&bar[XB_TMO], 1u); break; } }
    }
    nloc = mine > 0u ? mine : 1u; nx = cnt > 0u ? cnt : 1u;
}
__device__ __forceinline__ void xcd_barrier(const XcdBarrier& b) {
    asm volatile("s_waitcnt vmcnt(0)" ::: "memory");
    __syncthreads();
    if (threadIdx.x == 0) {
        unsigned* bar = b.bar;
        __builtin_amdgcn_s_waitcnt(0);
        unsigned nloc = b.st[0], nx = b.st[1];
        if (nloc == 0u) { xcd_barrier_complete(bar, b.x, nloc, nx); b.st[0] = nloc; b.st[1] = nx; }
        const unsigned old = xb_add(&bar[XB_XSUB(b.x)], 1u);
        const unsigned gen = old / nloc;
        if (old + 1u == (gen + 1u) * nloc) {
            __builtin_amdgcn_fence(__ATOMIC_RELEASE, "agent");
            asm volatile("s_waitcnt vmcnt(0)" ::: "memory");
            const unsigned og = xb_add(&bar[XB_TOP], 1u);
            const unsigned tg = og / nx;
            if (og + 1u == (tg + 1u) * nx) xb_add(&bar[XB_TOPGEN], 1u);
            else XB_SPIN(xb_ld(&bar[XB_TOPGEN]) == tg, bar);
            __builtin_amdgcn_fence(__ATOMIC_ACQUIRE, "agent");
            xb_add(&bar[XB_XGEN(b.x)], 1u);
            asm volatile("s_waitcnt vmcnt(0)" ::: "memory");
        } else {
            XB_SPIN(xb_ld(&bar[XB_XGEN(b.x)]) == gen, bar);
            __builtin_amdgcn_fence(__ATOMIC_ACQUIRE, "agent");
            asm volatile("s_waitcnt vmcnt(0)" ::: "memory");
        }
    }
    __syncthreads();
}

struct Frame {
    LAS unsigned char* lds;
    volatile LAS unsigned* MISC;
    unsigned* ctl;
    unsigned char* ws;
    int tid, lane, wave, G, gw, NGW;
    float* out;
};
struct Args { const float* in[21]; float* out; unsigned char* ws; int ph_lo, ph_hi; };
enum { I_X = 0, I_C, I_CTX, I_CCTX, I_WMOD, I_BMOD, I_GNORM, I_WIN, I_BMERGE, I_GQK, I_RPB, I_BMLSTM, I_GML, I_WBRANCH, I_WOUT, I_WGROUP, I_BGROUP, I_WROUTER, I_BROUTER, I_WGU, I_WDN };
__device__ __forceinline__ bool refresh(Frame& F) { int t = threadIdx.x; asm volatile("" : "+v"(t)); F.tid = t; F.lane = t & 63; int w = F.wave; asm volatile("" : "+s"(w)); F.wave = w; F.gw = (int)blockIdx.x * 8 + w; return true; }
__device__ __forceinline__ int dequeue(Frame& F, unsigned* counter, int slot) {
    __syncthreads();
    if (F.tid == 0) F.MISC[slot] = __hip_atomic_fetch_add(counter, 1u, RLX_AGENT);
    __syncthreads();
    return (int)F.MISC[slot];
}
__device__ __forceinline__ unsigned dq_issue(Frame& F, unsigned* counter) { unsigned v = 0u; if (F.tid == 0) v = __hip_atomic_fetch_add(counter, 1u, RLX_AGENT); return v; }
__device__ __forceinline__ int dq_take(Frame& F, unsigned v, int slot) {
    __syncthreads();
    if (F.tid == 0) F.MISC[slot] = v;
    __syncthreads();
    return (int)F.MISC[slot];
}
template <class RowPtr>
__device__ __forceinline__ void transpose_item(const float* W, int ldw, int ncols, int k0, int n0, LAS float* scr, int lane, const RowPtr& rp) {
    float tv[32];
#pragma unroll
    for (int i = 0; i < 32; ++i) { const int kk = 2 * i + (lane >> 5), n = n0 + (lane & 31); tv[i] = (n < ncols) ? W[(size_t)(k0 + kk) * ldw + n] : 0.f; }
#pragma unroll
    for (int i = 0; i < 32; ++i) { const int kk = 2 * i + (lane >> 5); scr[kk * 33 + (lane & 31)] = tv[i]; }
    LDS_WAIT(); asm volatile("" ::: "memory");
    const int c = lane & 7;
#pragma unroll
    for (int j = 0; j < 4; ++j) { const int nl = (lane >> 3) + 8 * j, n = n0 + nl; const LAS float* s = scr + (8 * c) * 33 + nl;
        v4u o; o.x = pk2(s[0 * 33], s[1 * 33]); o.y = pk2(s[2 * 33], s[3 * 33]); o.z = pk2(s[4 * 33], s[5 * 33]); o.w = pk2(s[6 * 33], s[7 * 33]);
        if (n < ncols) *(v4u*)(rp(n) + k0 + 8 * c) = o; }
    LDS_WAIT(); asm volatile("" ::: "memory");
}
constexpr int IT_WIN = 16 * 233, IT_WBR = 3 * 8 * 32, IT_WOUT = 16 * 32, IT_WGU = 32 * 16 * 16, IT_WDN = 32 * 4 * 32, IT_LAYER = IT_WIN + IT_WBR + IT_WOUT + IT_WGU + IT_WDN;

__device__ __forceinline__ void p0_prologue(Frame& F, const Args& A) {
    LAS float* sv = (LAS float*)(F.lds + RING_OFF);
    LAS float* part = (LAS float*)(F.lds + RING_OFF + 17 * 1024 * 4);
    float* MOD = (float*)(F.ws + WS_MOD);
    if ((int)blockIdx.x < DEPTH * 24) {
        for (int idx = F.tid; idx < 17 * 1024; idx += 512) { const int rr = idx >> 10, kk = idx & 1023; const float cv = (rr < 16) ? A.in[I_C][rr * 1024 + kk] : A.in[I_CCTX][kk]; sv[idx] = cv / (1.0f + expf(-cv)); }
        __syncthreads();
        for (int it = blockIdx.x; it < DEPTH * 24; it += F.G) {
            const int l = it / 24, jb = it % 24;
            const int j = jb * 256 + (F.tid & 255), kh = F.tid >> 8;
            float acc[17];
#pragma unroll
            for (int rr = 0; rr < 17; ++rr) acc[rr] = 0.f;
            const float* wp = A.in[I_WMOD] + ((size_t)l * 1024 + kh * 512) * 6144 + j;
            for (int k0 = 0; k0 < 512; k0 += 32) { float wv[32];
#pragma unroll
                for (int u = 0; u < 32; ++u) wv[u] = wp[(size_t)(k0 + u) * 6144];
#pragma unroll
                for (int u = 0; u < 32; ++u) {
#pragma unroll
                    for (int rr = 0; rr < 17; ++rr) acc[rr] += sv[rr * 1024 + kh * 512 + k0 + u] * wv[u]; } }
            if (kh == 1) {
#pragma unroll
                for (int rr = 0; rr < 17; ++rr) part[(F.tid & 255) * 17 + rr] = acc[rr]; }
            __syncthreads();
            if (kh == 0) { const float bm = A.in[I_BMOD][l * 6144 + j];
#pragma unroll
                for (int rr = 0; rr < 17; ++rr) MOD[((size_t)l * 17 + rr) * 6144 + j] = (acc[rr] + part[(F.tid & 255) * 17 + rr]) + bm; }
            __syncthreads();
        }
    }
    __syncthreads();
    LAS float* scr = (LAS float*)(F.lds + RING_OFF + F.wave * 16384);
    bf16* const wsb = (bf16*)F.ws;
    unsigned* itq = F.ctl + CW_Q + 64 * 60;
    for (;;) {
        int it_ = 0; if (F.lane == 0) it_ = (int)__hip_atomic_fetch_add(itq, 16u, RLX_AGENT);
        const int itb = __builtin_amdgcn_readfirstlane(it_); if (itb >= DEPTH * IT_LAYER) break;
        for (int it = itb; it < itb + 16 && it < DEPTH * IT_LAYER; ++it) {
        const int l = it / IT_LAYER; int r = it % IT_LAYER;
        if (r < IT_WIN) { const int kb = r / 233, nb = r % 233; bf16* win = (bf16*)(F.ws + WS_WIN + l * WIN_L);
            transpose_item(A.in[I_WIN] + (size_t)l * DM * INW, INW, INW, kb * 64, nb * 32, scr, F.lane, [=](int n) { int r = n < 4368 ? n : n + 240; if (n < 640 || (n >= 768 && n < 1792)) { const int d = n & 63, nn = d >> 5, rr = d & 31; r = (n & ~63) + 32 * (rr >> 4) + 8 * ((rr >> 2) & 3) + 4 * nn + (rr & 3); } return win + (size_t)r * 1024; }); continue; }
        r -= IT_WIN;
        if (r < IT_WBR) { const int br = r / 256, q = r % 256, kb = q / 32, nb = q % 32; bf16* d = (bf16*)(F.ws + WS_WBR + l * WBR_L) + (size_t)br * 512;
            transpose_item(A.in[I_WBRANCH] + ((size_t)l * 3 + br) * 512 * 1024, 1024, 1024, kb * 64, nb * 32, scr, F.lane, [=](int n) { return d + (size_t)n * 1536; }); continue; }
        r -= IT_WBR;
        if (r < IT_WOUT) { const int kb = r / 32, nb = r % 32; bf16* d = (bf16*)(F.ws + WS_WOUT + l * WOUT_L);
            transpose_item(A.in[I_WOUT] + (size_t)l * 1024 * 1024, 1024, 1024, kb * 64, nb * 32, scr, F.lane, [=](int n) { return d + (size_t)n * 1024; }); continue; }
        r -= IT_WOUT;
        if (r < IT_WGU) { const int e = r / 256, q = r % 256, kb = q / 16, nb = q % 16; bf16* d = (bf16*)(F.ws + WS_WGU + l * WGU_L) + (size_t)e * 512 * 1024;
            transpose_item(A.in[I_WGU] + ((size_t)l * NEXP + e) * 1024 * 512, 512, 512, kb * 64, nb * 32, scr, F.lane,
                [=](int n) { const int m = n & 255, row = (m >> 7) * 256 + ((n >> 8) << 7) + (m & 127); return d + (size_t)row * 1024; }); continue; }
        r -= IT_WGU;
        { const int e = r / 128, q = r % 128, kb = q / 32, nb = q % 32; bf16* d = (bf16*)(F.ws + WS_WDN + l * WDN_L) + (size_t)e * 1024 * 256;
            transpose_item(A.in[I_WDN] + ((size_t)l * NEXP + e) * 256 * 1024, 1024, 1024, kb * 64, nb * 32, scr, F.lane, [=](int n) { return d + (size_t)n * 256; }); }
        }
    }
    for (int i = blockIdx.x * 512 + F.tid; i < DEPTH * 240 * 128; i += F.G * 512) { const int l = i / (240 * 128), q = i % (240 * 128);
        *(v4u*)(F.ws + WS_WIN + l * WIN_L + (size_t)4368 * 2048 + (size_t)q * 16) = (v4u){0u, 0u, 0u, 0u}; }
    for (int i = blockIdx.x * 512 + F.tid; i < DEPTH * 48 * 1024; i += F.G * 512) { const int l = i / (48 * 1024), n = (i >> 10) % 48, k = i & 1023;
        const float wv = (n < 4) ? A.in[I_WGROUP][((size_t)l * 1024 + k) * 4 + n] : (n < 36) ? A.in[I_WROUTER][((size_t)l * 1024 + k) * 32 + (n - 4)] : 0.f;
        const unsigned hi = f2bf(wv), lo = f2bf(wv - __builtin_bit_cast(float, hi << 16));
        bf16* wr = (bf16*)(F.ws + WS_WR) + (size_t)l * 2 * 48 * 1024; wr[n * 1024 + k] = (bf16)hi; wr[48 * 1024 + n * 1024 + k] = (bf16)lo; }
    for (int i = blockIdx.x * 512 + F.tid; i < NLAT * 32; i += F.G * 512) { const int t = i >> 5, k = i & 31, f = k & 15; const float pos = (float)((k < 16) ? (t >> 6) : (t & 63));
        const float inv = exp2f(-(float)f * (13.287712379549449f / 16.0f)); const float ang = pos * inv;
        ((f32x2*)(F.ws + WS_ROPE))[i] = (f32x2){cosf(ang), sinf(ang)}; }
}

__device__ __forceinline__ void phase_norm1(Frame& F, const Args& A, int l, int g) {
    const float* xlat = (l == 0) ? A.in[I_X] : F.out; const float* xctx = (l == 0) ? A.in[I_CTX] : (const float*)(F.ws + WS_XC);
    const float* MOD = (const float*)(F.ws + WS_MOD); bf16* H = (bf16*)(F.ws + WS_H);
    const float* gn = A.in[I_GNORM] + (size_t)(l * 2 + 0) * 1024;
    for (int lr0 = F.gw; lr0 < TG; lr0 += 2 * F.NGW) {
        f32x4 v[2][4]; const float* md[2]; bool ok[2];
#pragma unroll
        for (int k = 0; k < 2; ++k) { const int lr = lr0 + k * F.NGW; ok[k] = lr < TG; if (ok[k]) {
            const int bl = lr / TPS, t = lr % TPS, b = g * GBS + bl;
            const float* src = (t < NLAT) ? xlat + ((size_t)b * NLAT + t) * DM : xctx + ((size_t)b * NCTX + (t - NLAT)) * DM;
            md[k] = MOD + ((size_t)l * 17 + ((t < NLAT) ? b : 16)) * 6144;
            const f32x4* xr = (const f32x4*)src + F.lane;
#pragma unroll
            for (int j = 0; j < 4; ++j) v[k][j] = xr[64 * j]; } }
#pragma unroll
        for (int k = 0; k < 2; ++k) if (ok[k]) { const int lr = lr0 + k * F.NGW; float s = 0.f;
#pragma unroll
            for (int j = 0; j < 4; ++j) s += (v[k][j].x * v[k][j].x + v[k][j].y * v[k][j].y) + (v[k][j].z * v[k][j].z + v[k][j].w * v[k][j].w);
            const float rstd = rsq_(wave_sum(s) * (1.0f / DM) + EPS);
            v2u* o8 = (v2u*)(H + (size_t)lr * DM) + F.lane;
#pragma unroll
            for (int j = 0; j < 4; ++j) { const f32x4 gg = ((const f32x4*)gn)[F.lane + 64 * j], sh = ((const f32x4*)md[k])[F.lane + 64 * j], sc = ((const f32x4*)(md[k] + 1024))[F.lane + 64 * j];
                const f32x4 y = (v[k][j] * rstd * gg) * (1.0f + sc) + sh; o8[64 * j] = (v2u){pk2(y.x, y.y), pk2(y.z, y.w)}; } }
    }
}

struct DenseOrder {
    int nM, nN, nwg, G, c; bool skipctx; const char* A; const char* Bt; size_t a_tile, b_tile;
    __device__ __forceinline__ bool next(int i, pg8::Unit& u) const {
        const long L = (long)i * G + c; if (L >= nwg) return false;
        int wgid = (int)L; { const int q = nwg / pg8::NXCD, r = nwg % pg8::NXCD, xcd = wgid % pg8::NXCD, off = wgid / pg8::NXCD; wgid = (xcd < r ? xcd * (q + 1) : r * (q + 1) + (xcd - r) * q) + off; }
        const int nig = pg8::WGM * nN, gid = wgid / nig, fm = gid * pg8::WGM, gsz = (nM - fm) < pg8::WGM ? (nM - fm) : pg8::WGM;
        const int pmq = fm + ((wgid % nig) % gsz), pn = (wgid % nig) / gsz;
        const int pm = skipctx ? (pmq >> 4) * 17 + (pmq & 15) : pmq;
        u.pm = pm; u.pn = pn; u.aux = 0; u.gl = nullptr; u.gn = 0; u.a = A + (size_t)pm * a_tile; u.b = Bt + (size_t)pn * b_tile; return true;
    }
};
struct BranchOrder {
    int nM, G, c; bool skipctx; const char* A; const char* Bt;
    __device__ __forceinline__ bool next(int i, pg8::Unit& u) const {
        const int tl = (i / 3) * G + c, br = i % 3; if (tl >= nM * 4) return false;
        const int pmq = tl >> 2, pn = tl & 3, pm = skipctx ? (pmq >> 4) * 17 + (pmq & 15) : pmq;
        u.pm = pm; u.pn = pn; u.aux = br; u.gl = nullptr; u.gn = 0; u.a = A + (size_t)pm * 256 * OW * 2 + (size_t)br * 512 * 2; u.b = Bt + (size_t)br * 1024 * 512 * 2 + (size_t)pn * 256 * 512 * 2; return true;
    }
};
struct MoeOrder {
    int ntiles, ncol, G, c; const LAS int* tile_e; const LAS int* eoff; const unsigned* ecnt; const int* list; const char* A; size_t a_tile; const char* Bt; size_t e_stride, b_tile;
    __device__ __forceinline__ bool next(int i, pg8::Unit& u) const {
        const int L = i * G + c, rt = L / ncol, pn = L % ncol; if (rt >= ntiles) return false;
        const int e = __builtin_amdgcn_readfirstlane(tile_e[rt]);
        u.pm = rt; u.pn = pn; u.aux = e; u.a = A + (size_t)rt * a_tile; u.b = Bt + (size_t)e * e_stride + (size_t)pn * b_tile;
        if (list) { const int rank0 = rt * 256 - __builtin_amdgcn_readfirstlane(eoff[e]); u.gl = list + (size_t)e * LIST_CAP + rank0; u.gn = __builtin_amdgcn_readfirstlane(eoff[400 + e]) - rank0; } else { u.gl = nullptr; u.gn = 0; }
        return true;
    }
};

struct EpiInproj {
    static constexpr bool PERM = true, HOOK = false;
    bf16* P; float* GT; const float* bml; bf16* SG; const float* bmerge; const float* gq; const f32x2* rope; LAS float* ssq;
    __device__ __forceinline__ void operator()(const f32x4 (&acc)[2][2][4][2], const pg8::Unit& u, int wr, int wc, int fr, int fq) const {
        const int row0 = u.pm * 256 + wr * 64 + fr;
        if (u.pn < 7) {
            int typ[2];
#pragma unroll
            for (int bj = 0; bj < 2; ++bj) { const int col = u.pn * 256 + bj * 128; typ[bj] = col < 512 ? 0 : col < 640 ? 1 : col < 768 ? -1 : col < 1280 ? 2 : 3; }
            const int ti_ = u.pm % 17; const bool lat_ = ti_ < 16 && u.pn < 3; const int tb_ = ti_ * 256 + wr * 64 + fr;
            f32x4 csA[4][2];
#define ROPE_LOAD(dst, ai_) do { _Pragma("unroll") for (int m = 0; m < 4; ++m) { if (lat_) { const f32x4* rp = (const f32x4*)(rope + (size_t)(tb_ + (ai_) * 128 + m * 16) * 32 + 16 * (wc & 1) + 4 * fq); dst[m][0] = rp[0]; dst[m][1] = rp[1]; } \
                else { dst[m][0] = (f32x4){1.f, 0.f, 1.f, 0.f}; dst[m][1] = (f32x4){1.f, 0.f, 1.f, 0.f}; } } } while (0)
            ROPE_LOAD(csA, 0);
#pragma unroll
            for (int ai = 0; ai < 2; ++ai)
#pragma unroll
                for (int m = 0; m < 4; ++m)
#pragma unroll
                    for (int bj = 0; bj < 2; ++bj) { const f32x4 v0 = acc[ai][bj][m][0], v1 = acc[ai][bj][m][1];
                        float ss = (v0[0] * v0[0] + v0[1] * v0[1]) + (v0[2] * v0[2] + v0[3] * v0[3]) + (v1[0] * v1[0] + v1[1] * v1[1]) + (v1[2] * v1[2] + v1[3] * v1[3]);
                        { auto r16 = __builtin_amdgcn_permlane16_swap(__float_as_uint(ss), __float_as_uint(ss), false, false); ss = __uint_as_float(r16[0]) + __uint_as_float(r16[1]);
                          auto r32 = __builtin_amdgcn_permlane32_swap(__float_as_uint(ss), __float_as_uint(ss), false, false); ss = __uint_as_float(r32[0]) + __uint_as_float(r32[1]); }
                        if (fq == 0) ssq[((ai * 128 + wr * 64 + m * 16 + fr) * 2 + bj) * 4 + wc] = ss; }
            asm volatile("s_waitcnt lgkmcnt(0)\n\ts_barrier" ::: "memory");
            const int ws = wc & 1;
            f32x4 g0[2], g1[2];
#pragma unroll
            for (int bj = 0; bj < 2; ++bj) { const int ty = typ[bj] < 0 ? 0 : typ[bj]; g0[bj] = *(const f32x4*)(gq + ty * 64 + 16 * ws + 4 * fq); g1[bj] = *(const f32x4*)(gq + ty * 64 + 32 + 16 * ws + 4 * fq); }
#pragma unroll
            for (int ai = 0; ai < 2; ++ai) {
                if (ai == 1) ROPE_LOAD(csA, 1);
#pragma unroll
                for (int m = 0; m < 4; ++m) { const int rowl = ai * 128 + wr * 64 + m * 16 + fr; bf16* rowp = P + (size_t)(row0 + ai * 128 + m * 16) * PW + u.pn * 256 + wc * 32 + 8 * fq;
                    const f32x4 cs0 = csA[m][0], cs1 = csA[m][1];
#pragma unroll
                    for (int bj = 0; bj < 2; ++bj) { f32x4 v0 = acc[ai][bj][m][0], v1 = acc[ai][bj][m][1];
                        if (typ[bj] >= 0) { const float tot = ssq[(rowl * 2 + bj) * 4 + wc] + ssq[(rowl * 2 + bj) * 4 + (wc ^ 1)]; const float rstd = rsq_(tot * (1.0f / 64.0f) + EPS);
                            v0 = v0 * rstd * g0[bj]; v1 = v1 * rstd * g1[bj];
                            if (typ[bj] < 2) { const f32x4 a = v0, b = v1;
                                v0[0] = a[0] * cs0[0] - b[0] * cs0[1]; v1[0] = b[0] * cs0[0] + a[0] * cs0[1]; v0[1] = a[1] * cs0[2] - b[1] * cs0[3]; v1[1] = b[1] * cs0[2] + a[1] * cs0[3];
                                v0[2] = a[2] * cs1[0] - b[2] * cs1[1]; v1[2] = b[2] * cs1[0] + a[2] * cs1[1]; v0[3] = a[3] * cs1[2] - b[3] * cs1[3]; v1[3] = b[3] * cs1[2] + a[3] * cs1[3]; }
                            if ((typ[bj] & 1) == 0) { v0 = v0 * QSCALE; v1 = v1 * QSCALE; } }
                        v4u w; w.x = pg8::cvt_pk_bf16(v0[0], v0[1]); w.y = pg8::cvt_pk_bf16(v0[2], v0[3]); w.z = pg8::cvt_pk_bf16(v1[0], v1[1]); w.w = pg8::cvt_pk_bf16(v1[2], v1[3]);
                        *(v4u*)(rowp + bj * 128) = w; } }
            }
#undef ROPE_LOAD
        } else if (u.pn < 17) {
#pragma unroll
            for (int ai = 0; ai < 2; ++ai)
#pragma unroll
                for (int m = 0; m < 4; ++m) { bf16* rowp = P + (size_t)(row0 + ai * 128 + m * 16) * PW + u.pn * 256 + wc * 32 + 8 * fq;
#pragma unroll
                    for (int bj = 0; bj < 2; ++bj) { const f32x4 v0 = acc[ai][bj][m][0], v1 = acc[ai][bj][m][1];
                        v4u w; w.x = pg8::cvt_pk_bf16(v0[0], v0[1]); w.y = pg8::cvt_pk_bf16(v0[2], v0[3]); w.z = pg8::cvt_pk_bf16(v1[0], v1[1]); w.w = pg8::cvt_pk_bf16(v1[2], v1[3]);
                        *(v4u*)(rowp + bj * 128) = w; } }
        } else if (u.pn == 17) {
            if (wc == 0 && fq < 2) {
                const f32x4 b0 = *(const f32x4*)(bml + 8 * fq), b1 = *(const f32x4*)(bml + 8 * fq + 4);
#pragma unroll
                for (int ai = 0; ai < 2; ++ai)
#pragma unroll
                    for (int m = 0; m < 4; ++m) { float* rowp = GT + (size_t)(row0 + ai * 128 + m * 16) * 16 + 8 * fq;
                        *(f32x4*)(rowp) = acc[ai][0][m][0] + b0; *(f32x4*)(rowp + 4) = acc[ai][0][m][1] + b1; }
            }
        } else {
            const int col0 = (u.pn - 18) * 256 + wc * 32 + 8 * fq;
            f32x4 bv[2][2];
#pragma unroll
            for (int bj = 0; bj < 2; ++bj)
#pragma unroll
                for (int n = 0; n < 2; ++n) bv[bj][n] = *(const f32x4*)(bmerge + col0 + bj * 128 + 4 * n);
            v4u* sgf = (v4u*)SG + ((((size_t)u.pm * 12 + (u.pn - 18)) * 8 + (wr * 4 + wc)) * 16) * 64 + (fq * 16 + fr);
#pragma unroll
            for (int ai = 0; ai < 2; ++ai)
#pragma unroll
                for (int m = 0; m < 4; ++m)
#pragma unroll
                    for (int bj = 0; bj < 2; ++bj) { f32x4 v0 = acc[ai][bj][m][0] + bv[bj][0], v1 = acc[ai][bj][m][1] + bv[bj][1];
#pragma unroll
                        for (int i = 0; i < 4; ++i) { v0[i] = sigmoidf_(v0[i]); v1[i] = sigmoidf_(v1[i]); }
                        v4u w; w.x = pg8::cvt_pk_bf16(v0[0], v0[1]); w.y = pg8::cvt_pk_bf16(v0[2], v0[3]); w.z = pg8::cvt_pk_bf16(v1[0], v1[1]); w.w = pg8::cvt_pk_bf16(v1[2], v1[3]);
                        sgf[(ai * 8 + m * 2 + bj) * 64] = w; }
        }
    }
};
struct EpiBranch {
    static constexpr bool PERM = true, HOOK = true;
    const bf16* SG; bf16* MG;
    __device__ __forceinline__ void mid(f32x4 (&acc)[2][2][4][2], const pg8::Unit& u, int seg, int wr, int wc, int fr, int fq) const {
        const v4u* sgf = (const v4u*)SG + ((((size_t)u.pm * 12 + u.pn) * 8 + (wr * 4 + wc)) * 16) * 64 + (fq * 16 + fr);
#pragma unroll
        for (int ai = 0; ai < 2; ++ai) {
            v4u sa[4][2], sb[4][2];
#pragma unroll
            for (int m = 0; m < 4; ++m) {
#pragma unroll
                for (int bj = 0; bj < 2; ++bj) { const v4u* p = sgf + (size_t)(seg * 4) * 8192 + (ai * 8 + m * 2 + bj) * 64; sa[m][bj] = p[0]; sb[m][bj] = p[4 * 8192]; } }
#pragma unroll
            for (int m = 0; m < 4; ++m)
#pragma unroll
                for (int bj = 0; bj < 2; ++bj) { const v4u a = sa[m][bj], b = sb[m][bj]; f32x4& a0 = acc[ai][bj][m][0]; f32x4& a1 = acc[ai][bj][m][1];
                    a0[0] *= bf_lo(a.x) * __builtin_amdgcn_rcpf(bf_lo(b.x)); a0[1] *= bf_hi(a.x) * __builtin_amdgcn_rcpf(bf_hi(b.x)); a0[2] *= bf_lo(a.y) * __builtin_amdgcn_rcpf(bf_lo(b.y)); a0[3] *= bf_hi(a.y) * __builtin_amdgcn_rcpf(bf_hi(b.y));
                    a1[0] *= bf_lo(a.z) * __builtin_amdgcn_rcpf(bf_lo(b.z)); a1[1] *= bf_hi(a.z) * __builtin_amdgcn_rcpf(bf_hi(b.z)); a1[2] *= bf_lo(a.w) * __builtin_amdgcn_rcpf(bf_lo(b.w)); a1[3] *= bf_hi(a.w) * __builtin_amdgcn_rcpf(bf_hi(b.w)); }
        }
    }
    __device__ __forceinline__ void operator()(const f32x4 (&acc)[2][2][4][2], const pg8::Unit& u, int wr, int wc, int fr, int fq) const {
        const int row0 = u.pm * 256 + wr * 64 + fr, col0 = u.pn * 256 + wc * 32 + 8 * fq;
        const v4u* sgf = (const v4u*)SG + ((((size_t)u.pm * 12 + u.pn) * 8 + (wr * 4 + wc)) * 16) * 64 + (fq * 16 + fr);
#pragma unroll
        for (int ai = 0; ai < 2; ++ai) {
            v4u sg[4][2];
#pragma unroll
            for (int m = 0; m < 4; ++m) {
#pragma unroll
                for (int bj = 0; bj < 2; ++bj) sg[m][bj] = sgf[(size_t)8 * 8192 + (ai * 8 + m * 2 + bj) * 64]; }
#pragma unroll
            for (int m = 0; m < 4; ++m) { const size_t row = (size_t)(row0 + ai * 128 + m * 16);
#pragma unroll
                for (int bj = 0; bj < 2; ++bj) { const v4u s = sg[m][bj]; const f32x4 a0 = acc[ai][bj][m][0], a1 = acc[ai][bj][m][1];
                    v4u w; w.x = pg8::cvt_pk_bf16(a0[0] * bf_lo(s.x), a0[1] * bf_hi(s.x)); w.y = pg8::cvt_pk_bf16(a0[2] * bf_lo(s.y), a0[3] * bf_hi(s.y));
                    w.z = pg8::cvt_pk_bf16(a1[0] * bf_lo(s.z), a1[1] * bf_hi(s.z)); w.w = pg8::cvt_pk_bf16(a1[2] * bf_lo(s.w), a1[3] * bf_hi(s.w));
                    *(v4u*)(MG + row * 1024 + col0 + bj * 128) = w; } }
        }
    }
};
struct EpiWout {
    static constexpr bool PERM = true, HOOK = false;
    bf16* Y;
    __device__ __forceinline__ void operator()(const f32x4 (&acc)[2][2][4][2], const pg8::Unit& u, int wr, int wc, int fr, int fq) const {
        const int row0 = u.pm * 256 + wr * 64 + fr, col0 = u.pn * 256 + wc * 32 + 8 * fq;
#pragma unroll
        for (int ai = 0; ai < 2; ++ai)
#pragma unroll
            for (int m = 0; m < 4; ++m) { bf16* rowp = Y + (size_t)(row0 + ai * 128 + m * 16) * DM + col0;
#pragma unroll
                for (int bj = 0; bj < 2; ++bj) { const f32x4 v0 = acc[ai][bj][m][0], v1 = acc[ai][bj][m][1];
                    v4u w; w.x = pg8::cvt_pk_bf16(v0[0], v0[1]); w.y = pg8::cvt_pk_bf16(v0[2], v0[3]); w.z = pg8::cvt_pk_bf16(v1[0], v1[1]); w.w = pg8::cvt_pk_bf16(v1[2], v1[3]);
                    *(v4u*)(rowp + bj * 128) = w; } }
    }
};
struct EpiMoe1 {
    static constexpr bool PERM = true, HOOK = false;
    bf16* ACT;
    __device__ __forceinline__ void operator()(const f32x4 (&acc)[2][2][4][2], const pg8::Unit& u, int wr, int wc, int fr, int fq) const {
        const int row0 = u.pm * 256 + wr * 64 + fr, col0 = u.pn * 128 + wc * 32 + 8 * fq;
#pragma unroll
        for (int ai = 0; ai < 2; ++ai)
#pragma unroll
            for (int m = 0; m < 4; ++m) { bf16* rowp = ACT + (size_t)(row0 + ai * 128 + m * 16) * DEXP + col0; float r[8];
#pragma unroll
                for (int n = 0; n < 2; ++n)
#pragma unroll
                    for (int i = 0; i < 4; ++i) { const float gt = acc[ai][0][m][n][i], up = acc[ai][1][m][n][i]; r[4 * n + i] = gt * sigmoidf_(gt) * up; }
                v4u w; w.x = pg8::cvt_pk_bf16(r[0], r[1]); w.y = pg8::cvt_pk_bf16(r[2], r[3]); w.z = pg8::cvt_pk_bf16(r[4], r[5]); w.w = pg8::cvt_pk_bf16(r[6], r[7]);
                *(v4u*)rowp = w; }
    }
};
struct EpiMoe2 {
    static constexpr bool PERM = true, HOOK = false;
    bf16* YS;
    __device__ __forceinline__ void operator()(const f32x4 (&acc)[2][2][4][2], const pg8::Unit& u, int wr, int wc, int fr, int fq) const {
        const int row0 = u.pm * 256 + wr * 64 + fr, col0 = u.pn * 256 + wc * 32 + 8 * fq;
#pragma unroll
        for (int ai = 0; ai < 2; ++ai)
#pragma unroll
            for (int m = 0; m < 4; ++m) { bf16* rowp = YS + (size_t)(row0 + ai * 128 + m * 16) * DM + col0;
#pragma unroll
                for (int bj = 0; bj < 2; ++bj) { const f32x4 v0 = acc[ai][bj][m][0], v1 = acc[ai][bj][m][1];
                    v4u w; w.x = pg8::cvt_pk_bf16(v0[0], v0[1]); w.y = pg8::cvt_pk_bf16(v0[2], v0[3]); w.z = pg8::cvt_pk_bf16(v1[0], v1[1]); w.w = pg8::cvt_pk_bf16(v1[2], v1[3]);
                    *(v4u*)(rowp + bj * 128) = w; } }
    }
};

__device__ __forceinline__ void qk_head8(v4u& w, const float* gain, const f32x2* rope  , int lane, float post) {
    float x[8] = {bf_lo(w.x), bf_hi(w.x), bf_lo(w.y), bf_hi(w.y), bf_lo(w.z), bf_hi(w.z), bf_lo(w.w), bf_hi(w.w)};
    float ss = 0.f;
#pragma unroll
    for (int e = 0; e < 8; ++e) ss += x[e] * x[e];
    ss += __shfl_xor(ss, 1); ss += __shfl_xor(ss, 2); ss += __shfl_xor(ss, 4);
    const float rstd = rsq_(ss * (1.0f / 64.0f) + EPS);
    const int j = lane & 7;
#pragma unroll
    for (int e = 0; e < 8; ++e) x[e] = x[e] * rstd * gain[j * 8 + e];
    if (rope) {
#pragma unroll
        for (int e = 0; e < 8; ++e) { const float part = __shfl_xor(x[e], 4); const f32x2 cs = rope[(j & 3) * 8 + e];
            x[e] = (j < 4) ? (x[e] * cs.x - part * cs.y) : (x[e] * cs.x + part * cs.y); }
    }
#pragma unroll
    for (int e = 0; e < 8; ++e) x[e] *= post;
    w.x = pk2(x[0], x[1]); w.y = pk2(x[2], x[3]); w.z = pk2(x[4], x[5]); w.w = pk2(x[6], x[7]);
}
__device__ __forceinline__ void phase_qknorm(Frame& F, const Args& A, int l, bool commit = true, bool dummy = false) {
    bf16* P = (bf16*)(F.ws + WS_P); bf16* DP = dummy ? (bf16*)(F.ws + WS_OUTS) : P; const int dpw = dummy ? 2048 : PW; const float* gq = A.in[I_GQK] + (size_t)l * 4 * 64; const f32x2* ROPE = (const f32x2*)(F.ws + WS_ROPE);
    for (int lr0 = F.gw; lr0 < TG; lr0 += 2 * F.NGW) {
        v4u w[2][4]; bool ok[2];
#pragma unroll
        for (int k = 0; k < 2; ++k) { const int lr = lr0 + k * F.NGW; ok[k] = lr < TG; if (ok[k]) { bf16* prow = P + (size_t)lr * PW;
            w[k][0] = *((v4u*)(prow + C_AQ) + F.lane); w[k][1] = *((v4u*)(prow + C_AK) + (F.lane & 15)); w[k][2] = *((v4u*)(prow + C_BQ) + F.lane); w[k][3] = *((v4u*)(prow + C_BK) + F.lane); } }
#pragma unroll
        for (int k = 0; k < 2; ++k) if (ok[k]) { const int lr = lr0 + k * F.NGW, t = lr % TPS; bf16* prow = DP + (size_t)lr * dpw; const f32x2* rp = (t < NLAT) ? ROPE + (size_t)t * 32 : nullptr;
            qk_head8(w[k][0], gq, rp, F.lane, QSCALE); qk_head8(w[k][1], gq + 64, rp, F.lane, 1.0f); qk_head8(w[k][2], gq + 128, nullptr, F.lane, QSCALE); qk_head8(w[k][3], gq + 192, nullptr, F.lane, 1.0f);
            if (commit) { *((v4u*)(prow + C_AQ) + F.lane) = w[k][0]; if (F.lane < 16) *((v4u*)(prow + C_AK) + F.lane) = w[k][1]; *((v4u*)(prow + C_BQ) + F.lane) = w[k][2]; *((v4u*)(prow + C_BK) + F.lane) = w[k][3]; } }
    }
}

__device__ __forceinline__ void phase_mlstm_finish(Frame& F, const Args& A, int l) {
    const bf16* HD = (const bf16*)(F.ws + WS_HDIR); const bf16* P = (const bf16*)(F.ws + WS_P); bf16* OUTS = (bf16*)(F.ws + WS_OUTS); const float* gm = A.in[I_GML] + (size_t)l * 512 + F.lane * 8;
    const f32x4 g0 = *(const f32x4*)gm, g1 = *(const f32x4*)(gm + 4);
    const float gg[8] = {g0.x, g0.y, g0.z, g0.w, g1.x, g1.y, g1.z, g1.w};
    for (int lr0 = F.gw; lr0 < TG; lr0 += 2 * F.NGW) {
        v4u ra[2], rb[2], ro[2]; bool ok[2];
#pragma unroll
        for (int k = 0; k < 2; ++k) { const int lr = lr0 + k * F.NGW; ok[k] = lr < TG && !(l == DEPTH - 1 && (lr % TPS) >= NLAT); if (ok[k]) {
            ra[k] = *((const v4u*)(HD + (size_t)lr * 512) + F.lane); rb[k] = *((const v4u*)(HD + ((size_t)TG + lr) * 512) + F.lane); ro[k] = *((const v4u*)(P + (size_t)lr * PW + C_CO) + F.lane); } }
#pragma unroll
        for (int k = 0; k < 2; ++k) if (ok[k]) { const int lr = lr0 + k * F.NGW; const v4u a = ra[k], b = rb[k], og = ro[k];
            float h[8] = {bf_lo(a.x) + bf_lo(b.x), bf_hi(a.x) + bf_hi(b.x), bf_lo(a.y) + bf_lo(b.y), bf_hi(a.y) + bf_hi(b.y), bf_lo(a.z) + bf_lo(b.z), bf_hi(a.z) + bf_hi(b.z), bf_lo(a.w) + bf_lo(b.w), bf_hi(a.w) + bf_hi(b.w)};
            const float o[8] = {bf_lo(og.x), bf_hi(og.x), bf_lo(og.y), bf_hi(og.y), bf_lo(og.z), bf_hi(og.z), bf_lo(og.w), bf_hi(og.w)};
            float ss = 0.f;
#pragma unroll
            for (int e = 0; e < 8; ++e) ss += h[e] * h[e];
            ss = row16_sum(ss);
            const float rstd = rsq_(ss * (1.0f / 128.0f) + EPS);
#pragma unroll
            for (int e = 0; e < 8; ++e) h[e] = h[e] * rstd * gg[e] * sigmoidf_(o[e]);
            *((v4u*)(OUTS + (size_t)lr * OW + 1024) + F.lane) = (v4u){pk2(h[0], h[1]), pk2(h[2], h[3]), pk2(h[4], h[5]), pk2(h[6], h[7])}; }
    }
}

__device__ __forceinline__ void phase_norm2_route(Frame& F, const Args& A, int l, int g, bool commit = true) {
    const float* xlat = (l == 0) ? A.in[I_X] : F.out; const float* xctx = (l == 0) ? A.in[I_CTX] : (const float*)(F.ws + WS_XC); const bf16* Y = (const bf16*)(F.ws + WS_Y);
    const float* MOD = (const float*)(F.ws + WS_MOD); bf16* H = (bf16*)(F.ws + WS_H); unsigned* TOK = (unsigned*)(F.ws + WS_TOK);
    const float* gn = A.in[I_GNORM] + (size_t)(l * 2 + 1) * 1024;
    const bf16* WR = (const bf16*)(F.ws + WS_WR) + (size_t)l * 2 * 48 * 1024;
    unsigned* ecnt = F.ctl + CW_ECNT + 64 * (l * 2 + g); int* LIST = (int*)(F.ws + WS_LIST);
    constexpr int TP2 = 2064;
    LAS unsigned char* THI = F.lds; LAS unsigned char* TLO = F.lds + 16 * TP2;
    LAS float* part = (LAS float*)(F.lds + 66048);
    LAS float* LG = (LAS float*)(F.lds + 90624);
    LAS unsigned* rec = (LAS unsigned*)(F.lds + 93696);
    LAS unsigned* blkcnt = (LAS unsigned*)(F.lds + 98304); LAS unsigned* blkbase = blkcnt + 32;
    const int w = F.wave, fr = F.lane & 15, fq = F.lane >> 4;
    const int g_lo = (int)(((long)blockIdx.x * (TG / 16)) / F.G), g_hi = (int)(((long)(blockIdx.x + 1) * (TG / 16)) / F.G);
    LAS float* MDL = (LAS float*)(F.lds + 102400);
    LAS float* GNL = (LAS float*)(F.lds + 102400 + 24576);
    int md_bl = -1;
    bf16x8 bh[4][3], bo[4][3];
#pragma unroll
    for (int ks = 0; ks < 4; ++ks)
#pragma unroll
        for (int nt = 0; nt < 3; ++nt) { const bf16* p = WR + (size_t)(16 * nt + fr) * 1024 + 128 * w + 32 * ks + 8 * fq; bh[ks][nt] = *(const bf16x8*)p; bo[ks][nt] = *(const bf16x8*)(p + 48 * 1024); }
    if (F.tid < 32) blkcnt[F.tid] = 0u;
    for (int i = F.tid; i < 1024; i += 512) GNL[i] = gn[i];
    for (int i = F.tid; i < 3072; i += 512) MDL[3072 + i] = MOD[((size_t)l * 17 + 16) * 6144 + 2048 + i];
    __syncthreads();
    f32x4 xv[2][4]; v2u yv[2][4];
#define RT_LOAD(gi_) do { const int lr0_ = (gi_) * 16; if ((gi_) < g_hi && !(l == DEPTH - 1 && (lr0_ % TPS) >= NLAT)) { _Pragma("unroll") for (int rr = 0; rr < 2; ++rr) { \
        const int lr_ = lr0_ + 2 * w + rr, bl_ = lr_ / TPS, t_ = lr_ % TPS, b_ = g * GBS + bl_; \
        const float* src_ = (t_ < NLAT) ? xlat + ((size_t)b_ * NLAT + t_) * DM : xctx + ((size_t)b_ * NCTX + (t_ - NLAT)) * DM; \
        _Pragma("unroll") for (int j = 0; j < 4; ++j) { xv[rr][j] = ((const f32x4*)src_)[F.lane + 64 * j]; yv[rr][j] = ((const v2u*)(Y + (size_t)lr_ * DM))[F.lane + 64 * j]; } } } } while (0)
    RT_LOAD(g_lo);
    int it = 0;
    for (int gi = g_lo; gi < g_hi; ++gi, ++it) {
        const int lr0 = gi * 16; const bool valid = !(l == DEPTH - 1 && (lr0 % TPS) >= NLAT);
        if (lr0 / TPS != md_bl) { md_bl = lr0 / TPS; __syncthreads();
            for (int i = F.tid; i < 3072; i += 512) MDL[i] = MOD[((size_t)l * 17 + g * GBS + md_bl) * 6144 + 2048 + i];
            __syncthreads(); }
        if (valid) {
#pragma unroll
            for (int rr = 0; rr < 2; ++rr) {
                const int r = 2 * w + rr, lr = lr0 + r, bl = lr / TPS, t = lr % TPS, b = g * GBS + bl;
                const LAS float* md = MDL + ((t < NLAT) ? 0 : 3072); (void)b;
                f32x4 v[4]; float s = 0.f;
#pragma unroll
                for (int j = 0; j < 4; ++j) { const v2u yy = yv[rr][j]; const f32x4 g1 = ((const LAS f32x4*)md)[F.lane + 64 * j]; v[j] = xv[rr][j];
                    v[j].x += g1.x * bf_lo(yy.x); v[j].y += g1.y * bf_hi(yy.x); v[j].z += g1.z * bf_lo(yy.y); v[j].w += g1.w * bf_hi(yy.y);
                    s += (v[j].x * v[j].x + v[j].y * v[j].y) + (v[j].z * v[j].z + v[j].w * v[j].w); }
                const float rstd = rsq_(wave_sum(s) * (1.0f / DM) + EPS);
                v2u* o8 = (v2u*)(H + (size_t)lr * DM) + F.lane;
#pragma unroll
                for (int j = 0; j < 4; ++j) { const f32x4 gg = ((const LAS f32x4*)GNL)[F.lane + 64 * j], sh = ((const LAS f32x4*)(md + 1024))[F.lane + 64 * j], sc = ((const LAS f32x4*)(md + 2048))[F.lane + 64 * j];
                    const f32x4 y = (v[j] * rstd * gg) * (1.0f + sc) + sh;
                    const unsigned h0 = pk2(y.x, y.y), h1 = pk2(y.z, y.w);
                    const unsigned l0 = pk2(y.x - bf_lo(h0), y.y - bf_hi(h0)), l1 = pk2(y.z - bf_lo(h1), y.w - bf_hi(h1));
                    o8[64 * j] = (v2u){h0, h1};
                    *(LAS v2u*)(THI + r * TP2 + (64 * j + F.lane) * 8) = (v2u){h0, h1}; *(LAS v2u*)(TLO + r * TP2 + (64 * j + F.lane) * 8) = (v2u){l0, l1}; }
            }
        }
        RT_LOAD(gi + 1);
        LDS_BARRIER();
        if (valid) {
            f32x4 acc[3];
#pragma unroll
            for (int nt = 0; nt < 3; ++nt) acc[nt] = (f32x4){0.f, 0.f, 0.f, 0.f};
#pragma unroll
            for (int ks = 0; ks < 4; ++ks) { const bf16x8 ah = *(const LAS bf16x8*)(THI + fr * TP2 + (128 * w + 32 * ks + 8 * fq) * 2), al = *(const LAS bf16x8*)(TLO + fr * TP2 + (128 * w + 32 * ks + 8 * fq) * 2);
#pragma unroll
                for (int nt = 0; nt < 3; ++nt) { acc[nt] = __builtin_amdgcn_mfma_f32_16x16x32_bf16(ah, bh[ks][nt], acc[nt], 0, 0, 0); acc[nt] = __builtin_amdgcn_mfma_f32_16x16x32_bf16(ah, bo[ks][nt], acc[nt], 0, 0, 0);
                    acc[nt] = __builtin_amdgcn_mfma_f32_16x16x32_bf16(al, bh[ks][nt], acc[nt], 0, 0, 0); } }
#pragma unroll
            for (int nt = 0; nt < 3; ++nt)
#pragma unroll
                for (int i = 0; i < 4; ++i) part[(w * 16 + 4 * fq + i) * 48 + 16 * nt + fr] = acc[nt][i];
        }
        LDS_BARRIER();
        if (valid) for (int idx = F.tid; idx < 768; idx += 512) { const int row = idx / 48, n = idx % 48; float s = 0.f;
#pragma unroll
            for (int w8 = 0; w8 < 8; ++w8) s += part[(w8 * 16 + row) * 48 + n];
            LG[idx] = s + ((n < 4) ? A.in[I_BGROUP][l * 4 + n] : (n < 36) ? A.in[I_BROUTER][l * 32 + n - 4] : 0.f); }
        LDS_BARRIER();
        if (F.tid < 16) {
            const int li = it * 16 + F.tid;
            if (!valid) rec[li * 8] = 0xffffffffu;
            else {
                const LAS float* lg = LG + F.tid * 48;
                int gs = 0; float gm = lg[0];
#pragma unroll
                for (int o = 1; o < 4; ++o) if (lg[o] > gm) { gm = lg[o]; gs = o; }
                float gden = 0.f;
#pragma unroll
                for (int o = 0; o < 4; ++o) gden += expf(lg[o] - gm);
                const float pgs = 1.0f / gden;
                const LAS float* ls = lg + 4 + gs * 8;
                int i0 = 0; float m0 = ls[0];
#pragma unroll
                for (int k = 1; k < 8; ++k) if (ls[k] > m0) { m0 = ls[k]; i0 = k; }
                int i1 = -1; float m1 = -INFINITY;
#pragma unroll
                for (int k = 0; k < 8; ++k) if (k != i0 && ls[k] > m1) { m1 = ls[k]; i1 = k; }
                const float ed = expf(m1 - m0); const float w0 = pgs / (1.0f + ed), w1 = pgs * ed / (1.0f + ed);
                const unsigned e0 = gs * 8 + i0, e1 = gs * 8 + i1;
                const unsigned r0 = atomicAdd((unsigned*)(blkcnt + e0), 1u), r1 = atomicAdd((unsigned*)(blkcnt + e1), 1u);
                rec[li * 8 + 0] = e0; rec[li * 8 + 1] = r0; rec[li * 8 + 2] = e1; rec[li * 8 + 3] = r1; rec[li * 8 + 4] = __float_as_uint(w0); rec[li * 8 + 5] = __float_as_uint(w1);
            }
        }
    }
#undef RT_LOAD
    __syncthreads();
    if (F.tid < 32) { const unsigned n = blkcnt[F.tid]; blkbase[F.tid] = (n && commit) ? __hip_atomic_fetch_add(ecnt + F.tid, n, RLX_AGENT) : 0u; }
    __syncthreads();
    for (int li = F.tid; li < it * 16; li += 512) { const int lr = (g_lo + (li >> 4)) * 16 + (li & 15);
        const unsigned e0 = rec[li * 8 + 0]; if (e0 == 0xffffffffu) continue;
        const unsigned e1 = rec[li * 8 + 2];
        v4u a; a.x = e0; a.y = blkbase[e0] + rec[li * 8 + 1]; a.z = e1; a.w = blkbase[e1] + rec[li * 8 + 3];
        v4u bb; bb.x = rec[li * 8 + 4]; bb.y = rec[li * 8 + 5]; bb.z = 0u; bb.w = 0u;
        if (commit) { *(v4u*)(TOK + (size_t)lr * 8) = a; *(v4u*)(TOK + (size_t)lr * 8 + 4) = bb; LIST[(size_t)e0 * LIST_CAP + a.y] = lr; LIST[(size_t)e1 * LIST_CAP + a.w] = lr; } }
    __syncthreads();
}

__device__ __forceinline__ void moe_tables(Frame& F, const Args& A, int l, int g, LAS int* eoff, LAS int* tile_e) {
    const unsigned* ecnt = F.ctl + CW_ECNT + 64 * (l * 2 + g);
    __syncthreads();
    if (F.tid < 33) { int off = 0; for (int e = 0; e < F.tid; ++e) off += (int)((__hip_atomic_load(ecnt + e, RLX_AGENT) + 255u) & ~255u); eoff[F.tid] = off; }
    if (F.tid >= 64 && F.tid < 96) eoff[400 + F.tid - 64] = (int)__hip_atomic_load(ecnt + (F.tid - 64), RLX_AGENT);
    __syncthreads();
    for (int rt = F.tid; rt < XS_ROWS / 256; rt += 512) { int e = 31; for (int k = 31; k >= 0; --k) if (rt * 256 < eoff[k + 1]) e = k; tile_e[rt] = e; }
    __syncthreads();
}
__device__ __forceinline__ void phase_moe_combine(Frame& F, const Args& A, int l, int g, bool commit = true, bool next_norm = false) {
    const float* xlat_s = (l == 0) ? A.in[I_X] : F.out; const float* xctx_s = (l == 0) ? A.in[I_CTX] : (const float*)(F.ws + WS_XC);
    float* xlat = F.out; float* xctx = (float*)(F.ws + WS_XC); const float* MOD = (const float*)(F.ws + WS_MOD);
    const bf16* YS = (const bf16*)(F.ws + WS_YS); const bf16* Y = (const bf16*)(F.ws + WS_Y); const unsigned* TOK = (const unsigned*)(F.ws + WS_TOK);
    bf16* H = (bf16*)(F.ws + WS_H); const float* gn1 = A.in[I_GNORM] + (size_t)((l + 1 < DEPTH ? l + 1 : l) * 2 + 0) * 1024;
    LAS int* eoff = (LAS int*)(F.lds + LDSX_OFF); LAS int* tile_e = eoff + 64; moe_tables(F, A, l, g, eoff, tile_e);
    for (int lr0 = F.gw; lr0 < TG; lr0 += 2 * F.NGW) {
        v4u bb[2]; v4u ta[2]; bool ok[2]; size_t ro[2]; bool lat[2]; const float* md[2];
#pragma unroll
        for (int k = 0; k < 2; ++k) { const int lr = lr0 + k * F.NGW; const int bl = lr / TPS, t = lr % TPS, b = g * GBS + bl; ok[k] = lr < TG && !(l == DEPTH - 1 && t >= NLAT); lat[k] = t < NLAT;
            ro[k] = lat[k] ? ((size_t)b * NLAT + t) * DM : ((size_t)b * NCTX + (t - NLAT)) * DM; md[k] = MOD + ((size_t)l * 17 + (lat[k] ? b : 16)) * 6144;
            if (ok[k]) { ta[k] = *(const v4u*)(TOK + (size_t)lr * 8); bb[k] = *(const v4u*)(TOK + (size_t)lr * 8 + 4); } }
        v2u ya[2][4], yc[2][4], yy[2][4]; f32x4 xv[2][4];
#pragma unroll
        for (int k = 0; k < 2; ++k) if (ok[k]) { const int lr = lr0 + k * F.NGW;
            const unsigned p0 = (unsigned)eoff[ta[k].x] + ta[k].y, p1 = (unsigned)eoff[ta[k].z] + ta[k].w;
            const v2u* y0 = (const v2u*)(YS + (size_t)p0 * DM) + F.lane; const v2u* y1 = (const v2u*)(YS + (size_t)p1 * DM) + F.lane; const v2u* yp = (const v2u*)(Y + (size_t)lr * DM) + F.lane;
            const f32x4* xr = (const f32x4*)((lat[k] ? xlat_s : xctx_s) + ro[k]) + F.lane;
#pragma unroll
            for (int j = 0; j < 4; ++j) { ya[k][j] = y0[64 * j]; yc[k][j] = y1[64 * j]; yy[k][j] = yp[64 * j]; xv[k][j] = xr[64 * j]; } }
#pragma unroll
        for (int k = 0; k < 2; ++k) if (ok[k]) { const float w0 = __uint_as_float(bb[k].x), w1 = __uint_as_float(bb[k].y); f32x4* xo = (f32x4*)((lat[k] ? xlat : xctx) + ro[k]) + F.lane;
#pragma unroll
            for (int j = 0; j < 4; ++j) { const v2u a = ya[k][j], c = yc[k][j], y = yy[k][j]; const f32x4 g1 = ((const f32x4*)(md[k] + 2048))[F.lane + 64 * j], g2 = ((const f32x4*)(md[k] + 5120))[F.lane + 64 * j]; f32x4 x = xv[k][j];
                x.x += g1.x * bf_lo(y.x) + g2.x * (w0 * bf_lo(a.x) + w1 * bf_lo(c.x)); x.y += g1.y * bf_hi(y.x) + g2.y * (w0 * bf_hi(a.x) + w1 * bf_hi(c.x));
                x.z += g1.z * bf_lo(y.y) + g2.z * (w0 * bf_lo(a.y) + w1 * bf_lo(c.y)); x.w += g1.w * bf_hi(y.y) + g2.w * (w0 * bf_hi(a.y) + w1 * bf_hi(c.y)); if (commit) xo[64 * j] = x; xv[k][j] = x; }
            if (next_norm) {
                const int lr = lr0 + k * F.NGW; float s = 0.f;
#pragma unroll
                for (int j = 0; j < 4; ++j) s += (xv[k][j].x * xv[k][j].x + xv[k][j].y * xv[k][j].y) + (xv[k][j].z * xv[k][j].z + xv[k][j].w * xv[k][j].w);
                const float rstd = rsq_(wave_sum(s) * (1.0f / DM) + EPS); const float* mdn = md[k] + 17 * 6144;
                v2u* o8 = (v2u*)(H + (size_t)lr * DM) + F.lane;
#pragma unroll
                for (int j = 0; j < 4; ++j) { const f32x4 gg = ((const f32x4*)gn1)[F.lane + 64 * j], sh = ((const f32x4*)mdn)[F.lane + 64 * j], sc = ((const f32x4*)(mdn + 1024))[F.lane + 64 * j];
                    const f32x4 yv = (xv[k][j] * rstd * gg) * (1.0f + sc) + sh; o8[64 * j] = (v2u){pk2(yv.x, yv.y), pk2(yv.z, yv.w)}; } } }
    }
}
namespace ml {
constexpr int QS_OFF = 0, QP = 272;
constexpr int KS_OFF = 17408;
constexpr int KG_OFF = 34816, KGP = 320;
constexpr int VS_OFF = 55296, VSP = 320;
constexpr int SS_OFF = 75776, TP = 144;
constexpr int CT_OFF = 84992;
constexpr int HS_OFF = 119808, HP = 272;
constexpr int NV_OFF = 137216;
constexpr int GA_OFF = 137728, GA_SZ = 1536;
constexpr int DQ_OFF = GA_OFF + 2 * GA_SZ;
constexpr int NVB_OFF = DQ_OFF + 256;
constexpr int GTS_OFF = NVB_OFF + 256;
static_assert(GTS_OFF + 4096 <= LDSCTL_OFF, "mLSTM LDS map");
constexpr int NCHUNK = TPS / 64;
constexpr float KSCALE = 0.08838834764831845f;
__device__ __forceinline__ int crow(int r, int hi) { return (r & 3) + 8 * (r >> 2) + 4 * hi; }
__device__ __forceinline__ f32x16 mfma32(bf16x8 a, bf16x8 b, f32x16 c) { return __builtin_amdgcn_mfma_f32_32x32x16_bf16(a, b, c, 0, 0, 0); }
__device__ __forceinline__ int tokrow(int p, int dir) { return dir == 0 ? (p < NCTX ? NLAT + p : p - NCTX) : (p < NCTX ? NLAT + NCTX - 1 - p : TPS - 1 - p); }
typedef short s16x4_ __attribute__((ext_vector_type(4)));
__device__ __forceinline__ bf16x8 trfrag(const LAS unsigned char* p, int koff, int pitch) {
    const s16x4_ lo = __builtin_bit_cast(s16x4_, __builtin_amdgcn_ds_read_tr16_b64_v4i16((LAS s16x4_*)(p + koff)));
    const s16x4_ hi = __builtin_bit_cast(s16x4_, __builtin_amdgcn_ds_read_tr16_b64_v4i16((LAS s16x4_*)(p + koff + 8 * pitch)));
    return (bf16x8){lo[0], lo[1], lo[2], lo[3], hi[0], hi[1], hi[2], hi[3]};
}
__device__ __forceinline__ bf16x8 rowfrag_perm(const LAS unsigned char* p, int ks) {
    const s16x4_ lo = *(const LAS s16x4_*)(p + 32 * ks), hi = *(const LAS s16x4_*)(p + 32 * ks + 16);
    return (bf16x8){lo[0], lo[1], lo[2], lo[3], hi[0], hi[1], hi[2], hi[3]};
}
}
struct MlRegs { v4u q0, q1, k0, k1, v0, v1; f32x4 g4; };
struct MlCtx { LAS unsigned char* L; const bf16* P; const float* GT; bf16* HD; int h, dir, tid, lane, w, r32, hi; };
__device__ __forceinline__ void ml_load(const MlCtx& c, MlRegs& r, int j) {
    using namespace ml;
    const int jj = j;
    const int s0 = c.tid >> 4, ch = c.tid & 15;
    const bf16* p0 = c.P + (size_t)tokrow(jj * 64 + s0, c.dir) * PW + c.h * 128 + ch * 8;
    const bf16* p1 = c.P + (size_t)tokrow(jj * 64 + s0 + 32, c.dir) * PW + c.h * 128 + ch * 8;
    r.q0 = *(const v4u*)(p0 + C_CQ); r.q1 = *(const v4u*)(p1 + C_CQ); r.k0 = *(const v4u*)(p0 + C_CK); r.k1 = *(const v4u*)(p1 + C_CK);
    r.v0 = *(const v4u*)(p0 + C_CV); r.v1 = *(const v4u*)(p1 + C_CV);
    const int rlo = c.dir == 0 ? tokrow(jj * 64, 0) : tokrow(jj * 64 + 63, 1);
    r.g4 = *(const f32x4*)(c.GT + (size_t)rlo * 16 + (c.tid & 255) * 4);
}
__device__ __forceinline__ void ml_scan(const MlCtx& c, int gb, float& m_carry) {
    using namespace ml;
    LAS float* ga = (LAS float*)(c.L + GA_OFF + gb * GA_SZ); const int lane = c.lane;
    const LAS float* gt = (const LAS float*)(c.L + GTS_OFF) + (c.dir == 0 ? lane : 63 - lane) * 16 + c.dir * 8 + c.h;
    const float rig = gt[0], rfp = gt[4];
    const float lf = fminf(rfp, 0.f) - __logf(1.0f + __expf(-fabsf(rfp)));
    const float b = wave_scan_add(lf);
    const float u = rig - b; const float pm = wave_scan_max(u);
    const float Mt = fmaxf(m_carry, pm); const float bend = lane63(b), M63 = lane63(Mt);
    ga[lane] = u; ga[64 + lane] = Mt; ga[128 + lane] = __expf(m_carry - Mt); ga[192 + lane] = __expf(-(b + Mt)); ga[256 + lane] = __expf(u - M63) * KSCALE;
    if (lane == 0) ga[320] = __expf(m_carry - M63);
    m_carry = bend + M63;
}
__device__ __forceinline__ void ml_stage_gates(const MlCtx& c, const MlRegs& r) { if (c.tid < 256) *(LAS f32x4*)(c.L + ml::GTS_OFF + c.tid * 16) = r.g4; }
__device__ __forceinline__ void ml_stage_qk(const MlCtx& c, const MlRegs& r) {
    using namespace ml;
    LAS unsigned char* L = c.L; const int s0 = c.tid >> 4, ch = c.tid & 15;
    *(LAS v4u*)(L + QS_OFF + s0 * QP + ch * 16) = r.q0; *(LAS v4u*)(L + QS_OFF + (s0 + 32) * QP + ch * 16) = r.q1;
    *(LAS v4u*)(L + KS_OFF + s0 * QP + ch * 16) = r.k0; *(LAS v4u*)(L + KS_OFF + (s0 + 32) * QP + ch * 16) = r.k1;
}
__device__ __forceinline__ void ml_stage_kgvs(const MlCtx& c, const MlRegs& r, int gb) {
    using namespace ml;
    LAS unsigned char* L = c.L; const int s0 = c.tid >> 4, ch = c.tid & 15;
    const LAS float* gsp = (const LAS float*)(L + GA_OFF + gb * GA_SZ) + 256;
    const float gs0 = gsp[s0], gs1 = gsp[s0 + 32];
    v4u g0, g1;
    g0.x = pk2(bf_lo(r.k0.x) * gs0, bf_hi(r.k0.x) * gs0); g0.y = pk2(bf_lo(r.k0.y) * gs0, bf_hi(r.k0.y) * gs0); g0.z = pk2(bf_lo(r.k0.z) * gs0, bf_hi(r.k0.z) * gs0); g0.w = pk2(bf_lo(r.k0.w) * gs0, bf_hi(r.k0.w) * gs0);
    g1.x = pk2(bf_lo(r.k1.x) * gs1, bf_hi(r.k1.x) * gs1); g1.y = pk2(bf_lo(r.k1.y) * gs1, bf_hi(r.k1.y) * gs1); g1.z = pk2(bf_lo(r.k1.z) * gs1, bf_hi(r.k1.z) * gs1); g1.w = pk2(bf_lo(r.k1.w) * gs1, bf_hi(r.k1.w) * gs1);
    *(LAS v4u*)(L + KG_OFF + s0 * KGP + ch * 16) = g0; *(LAS v4u*)(L + KG_OFF + (s0 + 32) * KGP + ch * 16) = g1;
    *(LAS v4u*)(L + VS_OFF + s0 * VSP + ch * 16) = r.v0; *(LAS v4u*)(L + VS_OFF + (s0 + 32) * VSP + ch * 16) = r.v1;
}
__device__ __forceinline__ void ml_step(const MlCtx& c, int j, MlRegs& rl, const MlRegs& rs, f32x16& cacc0, f32x16& cacc1, float& m_carry) {
    using namespace ml;
    int tid = c.tid; asm volatile("" : "+v"(tid));
    LAS unsigned char* L = c.L; const int lane = tid & 63, w = c.w, r32 = lane & 31, hi = lane >> 5;
    const int gb = j & 1; const int hstep = c.dir ? -1 : 1;
    LAS float* ga = (LAS float*)(L + GA_OFF + gb * GA_SZ);
    unsigned one2 = 0x3F803F80u; asm volatile("" : "+v"(one2));
    const bf16x8 ones = __builtin_bit_cast(bf16x8, (v4u){one2, one2, one2, one2});
    ml_stage_kgvs(c, rl, gb);
    ml_load(c, rl, (j + 2 < NCHUNK) ? j + 2 : NCHUNK - 1);
    f32x16 hacc0, hacc1;
    ml_stage_gates(c, rs);
    if (j > 0) { const int hp0 = tokrow((j - 1) * 64, c.dir); const int t = tid >> 4, ch = tid & 15;
        const v4u hv0 = *(const LAS v4u*)(L + HS_OFF + t * HP + ch * 16), hv1 = *(const LAS v4u*)(L + HS_OFF + (t + 32) * HP + ch * 16);
        *(v4u*)(c.HD + (size_t)(hp0 + hstep * t) * 512 + ch * 8) = hv0; *(v4u*)(c.HD + (size_t)(hp0 + hstep * (t + 32)) * 512 + ch * 8) = hv1; }
    if (w < 4) {
        const int tb = w >> 1, dbp = w & 1;
#pragma unroll
        for (int r = 0; r < 16; ++r) { hacc0[r] = 0.f; hacc1[r] = 0.f; }
        bf16x8 fa[8], fb[8];
#pragma unroll
        for (int ks = 0; ks < 8; ++ks) { fa[ks] = *(const LAS bf16x8*)(L + QS_OFF + (32 * tb + r32) * QP + (16 * ks + 8 * hi) * 2); fb[ks] = *(const LAS bf16x8*)(L + CT_OFF + (64 * dbp + r32) * QP + (16 * ks + 8 * hi) * 2); }
        __builtin_amdgcn_sched_barrier(0);
#pragma unroll
        for (int ks = 0; ks < 8; ++ks) hacc0 = mfma32(fa[ks], fb[ks], hacc0);
#pragma unroll
        for (int ks = 0; ks < 8; ++ks) fb[ks] = *(const LAS bf16x8*)(L + CT_OFF + (64 * dbp + 32 + r32) * QP + (16 * ks + 8 * hi) * 2);
        __builtin_amdgcn_sched_barrier(0);
#pragma unroll
        for (int ks = 0; ks < 8; ++ks) hacc1 = mfma32(fa[ks], fb[ks], hacc1);
    } else if (w < 7) {
        const int tb = (w == 4) ? 0 : 1, sb = (w == 6) ? 1 : 0;
        f32x16 sacc;
#pragma unroll
        for (int r = 0; r < 16; ++r) sacc[r] = 0.f;
        bf16x8 fa[8], fb[8];
#pragma unroll
        for (int ks = 0; ks < 8; ++ks) { fa[ks] = *(const LAS bf16x8*)(L + QS_OFF + (32 * tb + r32) * QP + (16 * ks + 8 * hi) * 2); fb[ks] = *(const LAS bf16x8*)(L + KS_OFF + (32 * sb + r32) * QP + (16 * ks + 8 * hi) * 2); }
        const int s = 32 * sb + r32; const float us = ga[s];
        f32x4 mtv[4];
#pragma unroll
        for (int gq = 0; gq < 4; ++gq) mtv[gq] = *(const LAS f32x4*)(ga + 64 + 32 * tb + 8 * gq + 4 * hi);
        __builtin_amdgcn_sched_barrier(0);
#pragma unroll
        for (int ks = 0; ks < 8; ++ks) sacc = mfma32(fa[ks], fb[ks], sacc);
#pragma unroll
        for (int gq = 0; gq < 4; ++gq) { const f32x4 mt = mtv[gq];
#pragma unroll
            for (int i = 0; i < 4; ++i) { const int t = 32 * tb + 8 * gq + 4 * hi + i; const float val = (s <= t) ? sacc[4 * gq + i] * KSCALE * __expf(us - mt[i]) : 0.f;
                *(LAS bf16*)(L + SS_OFF + t * TP + s * 2) = (bf16)f2bf(val); } }
    } else {
        {
            const int fr = lane & 15, fq = lane >> 4;
            typedef float f32x4_ __attribute__((ext_vector_type(4)));
            bf16x8 nb[4];
#pragma unroll
            for (int ks = 0; ks < 4; ++ks) nb[ks] = *(const LAS bf16x8*)(L + NVB_OFF + (32 * ks + 8 * fq) * 2);
            bf16x8 qa[4][4];
#pragma unroll
            for (int rb = 0; rb < 4; ++rb)
#pragma unroll
                for (int ks = 0; ks < 4; ++ks) qa[rb][ks] = *(const LAS bf16x8*)(L + QS_OFF + (16 * rb + fr) * QP + (32 * ks + 8 * fq) * 2);
            __builtin_amdgcn_sched_barrier(0);
#pragma unroll
            for (int rb = 0; rb < 4; ++rb) { f32x4_ d = {0.f, 0.f, 0.f, 0.f};
#pragma unroll
                for (int ks = 0; ks < 4; ++ks) d = __builtin_amdgcn_mfma_f32_16x16x32_bf16(qa[rb][ks], nb[ks], d, 0, 0, 0);
                if (fr == 0) *(LAS f32x4_*)(L + DQ_OFF + (16 * rb + 4 * fq) * 4) = d; }
        }
        { const int row = lane >> 1, half = lane & 1; unsigned z = 0u; asm volatile("" : "+v"(z)); *(LAS v4u*)(L + SS_OFF + row * TP + 64 + half * 32) = (v4u){z, z, z, z}; *(LAS v4u*)(L + SS_OFF + row * TP + 64 + half * 32 + 16) = (v4u){z, z, z, z}; }
    }
    LDS_BARRIER();
    const int q4 = (lane & 15) >> 2, p4 = lane & 3, h16 = (lane >> 4) & 1;
    const int dbp = w & 1;
    const LAS unsigned char* vtr_ = L + VS_OFF + (4 * hi + q4) * VSP + (16 * h16 + 4 * p4) * 2 + 128 * dbp;
    if (w < 4) {
        const int tb = w >> 1;
        f32x4 wv[4];
#pragma unroll
        for (int gq = 0; gq < 4; ++gq) { wv[gq] = *(const LAS f32x4*)(ga + 128 + 32 * tb + 8 * gq + 4 * hi);
#pragma unroll
            for (int i = 0; i < 4; ++i) { hacc0[4 * gq + i] *= wv[gq][i]; hacc1[4 * gq + i] *= wv[gq][i]; } }
        f32x16 racc;
#pragma unroll
        for (int r = 0; r < 16; ++r) racc[r] = 0.f;
        const LAS unsigned char* sp = L + SS_OFF + (32 * tb + r32) * TP + 8 * hi;
        bf16x8 fa[4], fb0[4], fb1[4];
#pragma unroll
        for (int ks = 0; ks < 4; ++ks) { fa[ks] = rowfrag_perm(sp, ks); fb0[ks] = trfrag(vtr_, 16 * ks * VSP, VSP); fb1[ks] = trfrag(vtr_, 16 * ks * VSP + 64, VSP); }
        __builtin_amdgcn_sched_barrier(0);
#pragma unroll
        for (int ks = 0; ks < 4; ++ks) { hacc0 = mfma32(fa[ks], fb0[ks], hacc0); hacc1 = mfma32(fa[ks], fb1[ks], hacc1); racc = mfma32(fa[ks], ones, racc); }
#pragma unroll
        for (int gq = 0; gq < 4; ++gq) { const f32x4 dqv = *(const LAS f32x4*)(L + DQ_OFF + (32 * tb + 8 * gq + 4 * hi) * 4), emv = *(const LAS f32x4*)(ga + 192 + 32 * tb + 8 * gq + 4 * hi);
#pragma unroll
            for (int i = 0; i < 4; ++i) { const int t = 32 * tb + 8 * gq + 4 * hi + i; const float den = wv[gq][i] * dqv[i] + racc[4 * gq + i];
                const float inv = __builtin_amdgcn_rcpf(fmaxf(fabsf(den), emv[i]));
                *(LAS bf16*)(L + HS_OFF + t * HP + (64 * dbp + r32) * 2) = (bf16)f2bf(hacc0[4 * gq + i] * inv);
                *(LAS bf16*)(L + HS_OFF + t * HP + (64 * dbp + 32 + r32) * 2) = (bf16)f2bf(hacc1[4 * gq + i] * inv); } }
    }
    {
        const int kb = w >> 1; const float gi = ga[320];
        const LAS unsigned char* ktr_ = L + KG_OFF + (4 * hi + q4) * KGP + (16 * h16 + 4 * p4) * 2;
#pragma unroll
        for (int r = 0; r < 16; ++r) { cacc0[r] *= gi; cacc1[r] *= gi; }
        bf16x8 ca[4], cb0[4], cb1[4];
#pragma unroll
        for (int ks = 0; ks < 4; ++ks) { ca[ks] = trfrag(ktr_, 16 * ks * KGP + 64 * kb, KGP); cb0[ks] = trfrag(vtr_, 16 * ks * VSP, VSP); cb1[ks] = trfrag(vtr_, 16 * ks * VSP + 64, VSP); }
        __builtin_amdgcn_sched_barrier(0);
#pragma unroll
        for (int ks = 0; ks < 4; ++ks) { cacc0 = mfma32(ca[ks], cb0[ks], cacc0); cacc1 = mfma32(ca[ks], cb1[ks], cacc1); }
#pragma unroll
        for (int gq = 0; gq < 4; ++gq) {
            *(LAS v2u*)(L + CT_OFF + (64 * dbp + r32) * QP + (32 * kb + 8 * gq + 4 * hi) * 2) = (v2u){pk2(cacc0[4 * gq], cacc0[4 * gq + 1]), pk2(cacc0[4 * gq + 2], cacc0[4 * gq + 3])};
            *(LAS v2u*)(L + CT_OFF + (64 * dbp + 32 + r32) * QP + (32 * kb + 8 * gq + 4 * hi) * 2) = (v2u){pk2(cacc1[4 * gq], cacc1[4 * gq + 1]), pk2(cacc1[4 * gq + 2], cacc1[4 * gq + 3])}; }
        if (w == 6) {
#pragma unroll
            for (int kb2 = 0; kb2 < 4; ++kb2) { f32x16 nacc; bf16x8 nf[4];
#pragma unroll
                for (int ks = 0; ks < 4; ++ks) nf[ks] = trfrag(ktr_, 16 * ks * KGP + 64 * kb2, KGP);
#pragma unroll
                for (int r = 0; r < 16; ++r) nacc[r] = 0.f;
                __builtin_amdgcn_sched_barrier(0);
#pragma unroll
                for (int ks = 0; ks < 4; ++ks) nacc = mfma32(ones, nf[ks], nacc);
                if (hi == 0) { LAS float* nv = (LAS float*)(L + NV_OFF); const int dk = 32 * kb2 + r32; const float nn = gi * nv[dk] + nacc[0]; nv[dk] = nn; *(LAS bf16*)(L + NVB_OFF + dk * 2) = (bf16)f2bf(nn); } }
        }
        if (w == 7 && j + 1 < NCHUNK) ml_scan(c, gb ^ 1, m_carry);
    }
    if (j + 1 < NCHUNK) ml_stage_qk(c, rs);
    LDS_BARRIER();
}
__device__ __forceinline__ void mlstm_chain(Frame& F, const Args& A, int l, int bl, int h, int dir) {
    using namespace ml;
    MlCtx c; c.L = F.lds; c.tid = F.tid; c.lane = F.lane; c.w = F.wave; c.r32 = F.lane & 31; c.hi = F.lane >> 5; c.h = h; c.dir = dir;
    c.P = (const bf16*)(F.ws + WS_P) + (size_t)bl * TPS * PW;
    c.GT = (const float*)(F.ws + WS_GATES) + (size_t)bl * TPS * 16;
    c.HD = (bf16*)(F.ws + WS_HDIR) + ((size_t)dir * TG + (size_t)bl * TPS) * 512 + h * 128;
    f32x16 cacc0, cacc1;
#pragma unroll
    for (int r = 0; r < 16; ++r) { cacc0[r] = 0.f; cacc1[r] = 0.f; }
    __syncthreads();
    { unsigned z = 0u; asm volatile("" : "+v"(z));
      for (int i = c.tid; i < (128 * QP) / 16; i += 512) *(LAS v4u*)(c.L + CT_OFF + i * 16) = (v4u){z, z, z, z}; }
    if (c.tid < 128) { ((LAS float*)(c.L + NV_OFF))[c.tid] = 0.f; *(LAS bf16*)(c.L + NVB_OFF + c.tid * 2) = (bf16)0; }
    float m_carry = 0.f;
    MlRegs ra, rb;
    ml_load(c, ra, 0); ml_load(c, rb, 1);
    ml_stage_gates(c, ra);
    __syncthreads();
    if (c.w == 7) ml_scan(c, 0, m_carry);
    __syncthreads();
    ml_stage_qk(c, ra);
    __syncthreads();
    for (int j = 0; j < NCHUNK; j += 2) {
        ml_step(c, j, ra, rb, cacc0, cacc1, m_carry);
        ml_step(c, j + 1, rb, ra, cacc0, cacc1, m_carry);
    }
    { const int hp0 = tokrow((NCHUNK - 1) * 64, dir), hstep = dir ? -1 : 1; const int t = c.tid >> 4, ch = c.tid & 15;
      const v4u hv0 = *(const LAS v4u*)(c.L + HS_OFF + t * HP + ch * 16), hv1 = *(const LAS v4u*)(c.L + HS_OFF + (t + 32) * HP + ch * 16);
      *(v4u*)(c.HD + (size_t)(hp0 + hstep * t) * 512 + ch * 8) = hv0; *(v4u*)(c.HD + (size_t)(hp0 + hstep * (t + 32)) * 512 + ch * 8) = hv1; }
    __syncthreads();
}
#define MLPROBE ((DBL_MASK >> 20) & 1)
constexpr int NA_TAB_OFF = 131072, NA_TAB_STRIDE = 2560;
__device__ __forceinline__ void phase_mixers(Frame& F, const Args& A, int l, int g, int r1 = 1, int r2 = 1, int r3 = 1) {
    unsigned* q0 = F.ctl + CW_Q + 64 * ((l * 2 + g) * 4);
    const bf16* P = (const bf16*)(F.ws + WS_P); bf16* OUTS = (bf16*)(F.ws + WS_OUTS);
    char* shm = (char*)(F.lds + RING_OFF);
    const bool ctxq = (l < DEPTH - 1);
    for (int rep = 0; rep < r1; ++rep) { unsigned* q = q0 + rep * 4096; for (;;) { const int i = dequeue(F, q, 16); if (i >= GBS * 8) break; mlstm_chain(F, A, l, i >> 3, (i >> 1) & 3, i & 1); } }
    const int nU = 1024 + (ctxq ? 128 : 0);
    for (int rep = 0; rep < r2; ++rep) { unsigned* q = q0 + rep * 4096; for (int i = dequeue(F, q + 64, 17); i < nU; ) {
        const unsigned nxq = dq_issue(F, q + 64);
        const bf16 *Qw, *Kh, *Vh; bf16* Ow; int NT, nA;
        if (i < 1024) { const int g4 = i & 3, qb = (i >> 2) & 15, kvh = (i >> 6) & 1, bl = i >> 7, h = kvh * 4 + g4; const size_t r0 = (size_t)bl * TPS;
            Qw = P + (r0 + qb * 256) * PW + C_AQ + h * 64; Kh = P + r0 * PW + C_AK + kvh * 64; Vh = P + r0 * PW + C_AV + kvh * 64; Ow = OUTS + (r0 + qb * 256) * OW + h * 64; NT = TPS / 64; nA = TPS / 64; }
        else if (i < 1088) { const int jj = i - 1024, h = jj & 7, bl = jj >> 3, kvh = h >> 2; const size_t r0 = (size_t)bl * TPS + NLAT;
            Qw = P + r0 * PW + C_AQ + h * 64; Kh = P + r0 * PW + C_AK + kvh * 64; Vh = P + r0 * PW + C_AV + kvh * 64; Ow = OUTS + r0 * OW + h * 64; NT = 4; nA = 4; }
        else { const int jj = i - 1088, h = jj & 7, bl = jj >> 3; const size_t r0 = (size_t)bl * TPS + NLAT;
            Qw = P + r0 * PW + C_BQ + h * 64; Kh = P + r0 * PW + C_BK + h * 64; Vh = P + r0 * PW + C_BV + h * 64; Ow = OUTS + r0 * OW + 512 + h * 64; NT = 4; nA = 4; }
        attn_body::attn_unit<0, 1000>(Qw, PW, Kh, Vh, PW, NT, nA, 0, Ow, OW, shm, (attn_body::lds_cptr)(F.lds + NA_TAB_OFF + 256), 0, 0);
        i = dq_take(F, nxq, 17);
    } }
    int tab_h = -1;
    for (int rep = 0; rep < r3; ++rep) { unsigned* q = q0 + rep * 4096; for (int i = dequeue(F, q + 128, 18); i < 1024; ) {
        const unsigned nxq = dq_issue(F, q + 128);
        const int rg = i & 15, h = (i >> 4) & 7, bl = i >> 7; const size_t r0 = (size_t)bl * TPS;
        if (h != tab_h) { tab_h = h;
            for (int idx = F.tid; idx < NA_TAB_STRIDE / 4; idx += 512) { const int r = idx - 64, dr = r >> 5, dc = r & 31;
                float v = 0.f; if (r >= 0 && r < 480) v = (dc < 31) ? A.in[I_RPB][((size_t)l * 8 + h) * 15 * 31 + dr * 31 + dc] * LOG2E : -INFINITY;
                ((LAS float*)(F.lds + NA_TAB_OFF))[idx] = v; }
            __syncthreads(); }
        attn_body::na_unit<0>(P + r0 * PW, h, rg, OUTS + r0 * OW, shm, (attn_body::lds_cptr)(F.lds + NA_TAB_OFF + 256));
        i = dq_take(F, nxq, 18);
    } }
}

#ifndef MK_PER_PHASE
#define MK_PER_PHASE 0
#endif
#ifndef PHASE_MASK
#define PHASE_MASK 0xffff
#endif
#define PHM(k) ((PHASE_MASK >> (k)) & 1)
#ifndef DBL_MASK
#define DBL_MASK 0
#endif
#define DBL(k) ((DBL_MASK >> (k)) & 1)
constexpr int NPHASE = 1 + NGRP * (DEPTH * 9 + 1);
__global__ void __launch_bounds__(512, 2) fwd_kernel(Args A) {
    extern __shared__ __attribute__((aligned(16))) unsigned char lds[];
    Frame F;
    F.lds = (LAS unsigned char*)lds;
    F.MISC = (volatile LAS unsigned*)(F.lds + LDSCTL_OFF);
    F.tid = threadIdx.x; F.lane = F.tid & 63; F.wave = __builtin_amdgcn_readfirstlane(F.tid >> 6);
    F.G = gridDim.x; F.gw = blockIdx.x * 8 + F.wave; F.NGW = F.G * 8;
    F.ws = A.ws; F.ctl = (unsigned*)(A.ws + WS_CTL); F.out = A.out;
    A.in[I_X] = A.in[0]; A.in[I_C] = A.in[1]; A.in[I_CTX] = A.in[2]; A.in[I_CCTX] = A.in[3]; A.in[I_WMOD] = A.in[4]; A.in[I_BMOD] = A.in[5]; A.in[I_GNORM] = A.in[6]; A.in[I_WIN] = A.in[7];
    A.in[I_BMERGE] = A.in[8]; A.in[I_GQK] = A.in[9]; A.in[I_RPB] = A.in[10]; A.in[I_BMLSTM] = A.in[11]; A.in[I_GML] = A.in[12]; A.in[I_WBRANCH] = A.in[13]; A.in[I_WOUT] = A.in[14];
    A.in[I_WGROUP] = A.in[15]; A.in[I_BGROUP] = A.in[16]; A.in[I_WROUTER] = A.in[17]; A.in[I_BROUTER] = A.in[18]; A.in[I_WGU] = A.in[19]; A.in[I_WDN] = A.in[20];
    for (int u = F.tid; u < 128; u += 512) ((LAS unsigned*)(F.lds + LDSCTL_OFF))[u] = 0u;
    __syncthreads();
    XcdBarrier bar; bar.bar = F.ctl + CW_BAR; bar.x = 0; bar.st = nullptr;
    if (!MK_PER_PHASE) bar = xcd_barrier_post(F.ctl + CW_BAR, F.MISC + 8);
    const int lo = A.ph_lo, hi = A.ph_hi; int ph = 0;
#define SEAM() do { if (!MK_PER_PHASE) { if (ph + 1 < hi) { xcd_barrier(bar); if (DBL(19)) xcd_barrier(bar); } } } while (0)
#define ON() (ph >= lo && ph < hi && refresh(F))
    if (PHM(0) && ON()) { p0_prologue(F, A); if (DBL(0)) { __syncthreads(); p0_prologue(F, A); } SEAM(); } ++ph;
    for (int g = 0; g < NGRP; ++g) {
        for (int l = 0; l < DEPTH; ++l) {
            const bool skipctx = (l == DEPTH - 1); const int nMrows = skipctx ? GBS * 16 : RTG;
            if (l == 0) { if (PHM(1) && ON()) { phase_norm1(F, A, l, g); if (DBL(1)) phase_norm1(F, A, l, g); SEAM(); } ++ph; }
            if (PHM(2) && ON()) {
                DenseOrder S{RTG, 30, RTG * 30, F.G, (int)blockIdx.x, false, (const char*)(F.ws + WS_H), (const char*)(F.ws + WS_WIN + l * WIN_L), (size_t)256 * 1024 * 2, (size_t)256 * 1024 * 2};
                EpiInproj E{(bf16*)(F.ws + WS_P), (float*)(F.ws + WS_GATES), A.in[I_BMLSTM] + l * 16, (bf16*)(F.ws + WS_SG), A.in[I_BMERGE] + l * 3072, A.in[I_GQK] + (size_t)l * 256, (const f32x2*)(F.ws + WS_ROPE), (LAS float*)(F.lds + LDSX_OFF)};
                for (int rep_ = 0; rep_ < 1 + DBL(2); ++rep_) { pg8::gemm_phase<EpiInproj, DenseOrder, true, true>(F.lds + RING_OFF, pg8::Gemm{1024, 1024, 1024}, S, E); }
                SEAM(); } ++ph;
            if (PHM(4) && ON()) { phase_mixers(F, A, l, g, 1 + DBL(16), 1 + DBL(17), 1 + DBL(18)); SEAM(); } ++ph;
            if (PHM(5) && ON()) { phase_mlstm_finish(F, A, l); if (DBL(5)) phase_mlstm_finish(F, A, l); SEAM(); } ++ph;
            if (PHM(7) && ON()) {
                DenseOrder S{nMrows, 4, nMrows * 4, F.G, (int)blockIdx.x, skipctx, (const char*)(F.ws + WS_OUTS), (const char*)(F.ws + WS_WBR + l * WBR_L), (size_t)256 * OW * 2, (size_t)256 * 1536 * 2};
                EpiBranch E{(const bf16*)(F.ws + WS_SG), (bf16*)(F.ws + WS_MERGED)};
                for (int rep_ = 0; rep_ < 1 + DBL(7); ++rep_) { pg8::gemm_phase<EpiBranch, DenseOrder, true, true>(F.lds + RING_OFF, pg8::Gemm{OW, 1536, 1536}, S, E); }
                SEAM(); } ++ph;
            if (PHM(8) && ON()) {
                DenseOrder S{nMrows, 4, nMrows * 4, F.G, (int)blockIdx.x, skipctx, (const char*)(F.ws + WS_MERGED), (const char*)(F.ws + WS_WOUT + l * WOUT_L), (size_t)256 * 1024 * 2, (size_t)256 * 1024 * 2};
                EpiWout E{(bf16*)(F.ws + WS_Y)};
                for (int rep_ = 0; rep_ < 1 + DBL(8); ++rep_) { pg8::gemm_phase<EpiWout, DenseOrder, true, true>(F.lds + RING_OFF, pg8::Gemm{1024, 1024, 1024}, S, E); }
                SEAM(); } ++ph;
            if (PHM(9) && ON()) { phase_norm2_route(F, A, l, g); if (DBL(9)) phase_norm2_route(F, A, l, g, F.G == 12345); SEAM(); } ++ph;
            if (PHM(11) && ON()) {
                LAS int* eoff = (LAS int*)(F.lds + LDSX_OFF); LAS int* tile_e = eoff + 64; moe_tables(F, A, l, g, eoff, tile_e);
                MoeOrder S{eoff[32] / 256, 2, F.G, (int)blockIdx.x, tile_e, eoff, F.ctl + CW_ECNT + 64 * (l * 2 + g), (const int*)(F.ws + WS_LIST), (const char*)(F.ws + WS_H), (size_t)0, (const char*)(F.ws + WS_WGU + l * WGU_L), (size_t)512 * 1024 * 2, (size_t)256 * 1024 * 2};
                EpiMoe1 E{(bf16*)(F.ws + WS_ACT)};
                for (int rep_ = 0; rep_ < 1 + DBL(11); ++rep_) { pg8::gemm_phase<EpiMoe1, MoeOrder, true, true, true>(F.lds + RING_OFF, pg8::Gemm{1024, 1024, 1024}, S, E); }
                SEAM(); } ++ph;
            if (PHM(12) && ON()) {
                LAS int* eoff = (LAS int*)(F.lds + LDSX_OFF); LAS int* tile_e = eoff + 64; moe_tables(F, A, l, g, eoff, tile_e);
                MoeOrder S{eoff[32] / 256, 4, F.G, (int)blockIdx.x, tile_e, eoff, F.ctl + CW_ECNT + 64 * (l * 2 + g), (const int*)nullptr, (const char*)(F.ws + WS_ACT), (size_t)256 * 256 * 2, (const char*)(F.ws + WS_WDN + l * WDN_L), (size_t)1024 * 256 * 2, (size_t)256 * 256 * 2};
                EpiMoe2 E{(bf16*)(F.ws + WS_YS)};
                for (int rep_ = 0; rep_ < 1 + DBL(12); ++rep_) { pg8::gemm_phase<EpiMoe2, MoeOrder, true, true>(F.lds + RING_OFF, pg8::Gemm{256, 256, 256}, S, E); }
                SEAM(); } ++ph;
            if (PHM(13) && ON()) { phase_moe_combine(F, A, l, g, true, l + 1 < DEPTH); if (DBL(13) && l == 0) phase_moe_combine(F, A, l, g, true, true); SEAM(); } ++ph;
        }
    }
#undef SEAM
#undef ON
}

extern "C" void kernel_launch(void* const* d_in, const int* in_sizes, int n_in, void* d_out, int out_size, void* d_ws, size_t ws_size, hipStream_t stream) {
    static int grid = 0;
    if (grid == 0) {
        if (n_in != 21 || out_size != NB * NLAT * DM || ws_size < WS_END) { fprintf(stderr, "kernel_launch: unexpected shapes (n_in %d, out %d, ws %zu)\n", n_in, out_size, ws_size); grid = -1; return; }
        int dev = 0, cus = 0, per_cu = 0;
        if (hipGetDevice(&dev) != hipSuccess || hipDeviceGetAttribute(&cus, hipDeviceAttributeMultiprocessorCount, dev) != hipSuccess) { grid = -1; return; }
        if (hipFuncSetAttribute((const void*)fwd_kernel, hipFuncAttributeMaxDynamicSharedMemorySize, LDS_BYTES) != hipSuccess) { fprintf(stderr, "kernel_launch: hipFuncSetAttribute failed\n"); grid = -1; return; }
        if (hipOccupancyMaxActiveBlocksPerMultiprocessor(&per_cu, (const void*)fwd_kernel, 512, LDS_BYTES) != hipSuccess || per_cu < 1) fprintf(stderr, "kernel_launch: occupancy query reports %d\n", per_cu);
        (void)hipGetLastError();
        grid = cus;
    }
    if (grid < 0) return;
    (void)in_sizes;
    if (hipMemsetAsync((char*)d_ws + WS_CTL, 0, CTL_ZERO_BYTES, stream) != hipSuccess) return;
    Args a{};
    for (int i = 0; i < 21; ++i) a.in[i] = (const float*)d_in[i];
    a.out = (float*)d_out; a.ws = (unsigned char*)d_ws;
#if MK_PER_PHASE
    for (int p = 0; p < NPHASE; ++p) { a.ph_lo = p; a.ph_hi = p + 1; hipLaunchKernelGGL(fwd_kernel, dim3(grid), dim3(512), LDS_BYTES, stream, a); }
#else
    a.ph_lo = 0; a.ph_hi = NPHASE;
    hipLaunchKernelGGL(fwd_kernel, dim3(grid), dim3(512), LDS_BYTES, stream, a);
#endif
}
```

```cpp
#include <hip/hip_runtime.h>
#include <cstdio>
#include <cstdint>

constexpr int NB = 16, NLAT = 4096, NCTX = 256, TPS = NLAT + NCTX  , DM = 1024, DEPTH = 2;
constexpr int GBS = 8  , NGRP = NB / GBS, TG = GBS * TPS  , RTG = TG / 256  ;
constexpr int PW = 4352;
constexpr int C_AQ = 0, C_AK = 512, C_AV = 640, C_BQ = 768, C_BK = 1280, C_BV = 1792, C_CQ = 2304, C_CK = 2816, C_CV = 3328, C_CO = 3840;
constexpr int INW = 7440, NPADW = 4608;
constexpr int OW = 1536;
constexpr int NEXP = 32, DEXP = 256;
constexpr float EPS = 1e-6f;
constexpr float LOG2E = 1.4426950408889634f;
constexpr float QSCALE = 0.125f * LOG2E;

#define LAS __attribute__((address_space(3)))
typedef unsigned short bf16;
typedef unsigned v4u __attribute__((ext_vector_type(4)));
typedef unsigned v2u __attribute__((ext_vector_type(2)));
typedef float f32x4 __attribute__((ext_vector_type(4)));
typedef float f32x2 __attribute__((ext_vector_type(2)));
typedef short bf16x8 __attribute__((ext_vector_type(8)));
typedef float f32x16 __attribute__((ext_vector_type(16)));

typedef float f32x2_hw __attribute__((ext_vector_type(2))); typedef __bf16 bf16x2_hw __attribute__((ext_vector_type(2)));
__device__ __forceinline__ unsigned pk2(float lo, float hi) { f32x2_hw v = {lo, hi}; bf16x2_hw b = __builtin_convertvector(v, bf16x2_hw); return __builtin_bit_cast(unsigned, b); }
__device__ __forceinline__ unsigned f2bf(float f) { return pk2(f, 0.f) & 0xffffu; }
__device__ __forceinline__ float bf_lo(unsigned w) { return __builtin_bit_cast(float, w << 16); }
__device__ __forceinline__ float bf_hi(unsigned w) { return __builtin_bit_cast(float, w & 0xffff0000u); }
__device__ __forceinline__ float bf2f(bf16 b) { return __builtin_bit_cast(float, ((unsigned)b) << 16); }
template <int CTRL, int ROWMASK> __device__ __forceinline__ float dpp_f(float identity, float x) {
    return __builtin_bit_cast(float, __builtin_amdgcn_update_dpp(__builtin_bit_cast(int, identity), __builtin_bit_cast(int, x), CTRL, ROWMASK, 0xf, false)); }
__device__ __forceinline__ float wave_scan_add(float x) {
    x += dpp_f<0x111, 0xf>(0.f, x); x += dpp_f<0x112, 0xf>(0.f, x); x += dpp_f<0x114, 0xf>(0.f, x); x += dpp_f<0x118, 0xf>(0.f, x);
    x += dpp_f<0x142, 0xa>(0.f, x); x += dpp_f<0x143, 0xc>(0.f, x); return x; }
__device__ __forceinline__ float wave_scan_max(float x) {
    const float ninf = -INFINITY;
    x = fmaxf(x, dpp_f<0x111, 0xf>(ninf, x)); x = fmaxf(x, dpp_f<0x112, 0xf>(ninf, x)); x = fmaxf(x, dpp_f<0x114, 0xf>(ninf, x)); x = fmaxf(x, dpp_f<0x118, 0xf>(ninf, x));
    x = fmaxf(x, dpp_f<0x142, 0xa>(ninf, x)); x = fmaxf(x, dpp_f<0x143, 0xc>(ninf, x)); return x; }
__device__ __forceinline__ float lane63(float x) { return __builtin_bit_cast(float, __builtin_amdgcn_readlane(__builtin_bit_cast(int, x), 63)); }
__device__ __forceinline__ float wave_sum(float v) { return lane63(wave_scan_add(v)); }
__device__ __forceinline__ float row16_sum(float x) {
    x += dpp_f<0xB1, 0xf>(0.f, x); x += dpp_f<0x4E, 0xf>(0.f, x); x += dpp_f<0x141, 0xf>(0.f, x); x += dpp_f<0x140, 0xf>(0.f, x); return x; }
__device__ __forceinline__ float rcp_(float x) { return __builtin_amdgcn_rcpf(x); }
__device__ __forceinline__ float rsq_(float x) { return __builtin_amdgcn_rsqf(x); }
__device__ __forceinline__ float sigmoidf_(float x) { return rcp_(1.0f + __builtin_amdgcn_exp2f(-LOG2E * x)); }
#define SIG(k, x) sigmoidf_(x)
#define LDS_BARRIER() asm volatile("s_waitcnt lgkmcnt(0)\n\ts_barrier" ::: "memory")
#ifndef DBL_MASK
#define DBL_MASK 0
#endif
#define MLCUT ((DBL_MASK >> 21) & 255)
#ifndef MK_PER_PHASE
#define MK_PER_PHASE 0
#endif
namespace pg8 {
#define PG8_LAS __attribute__((address_space(3)))
typedef unsigned short bf16_t;
typedef short bf16x8 __attribute__((ext_vector_type(8)));
typedef float f32x4 __attribute__((ext_vector_type(4)));
typedef unsigned u32x4 __attribute__((ext_vector_type(4)));
constexpr int BM = 256, BK = 64, HALF = 128, HTB = HALF * BK * 2  , STAGE_BYTES = 8 * HTB, NXCD = 8, WGM = 8;

__host__ __device__ __forceinline__ int lds_byte(int r, int c) { const int st = (r >> 4) * 2 + (c >> 5), rr = r & 15, cc = c & 31, ob = rr * 64 + cc * 2; return st * 1024 + (ob ^ (((ob >> 9) & 1) << 5)); }
__host__ __device__ __forceinline__ void stage_rc(int b, int& R, int& C) { const int st = b / 1024, sb = b % 1024, swz = sb ^ (((sb >> 9) & 1) << 5); R = (st >> 1) * 16 + swz / 64; C = (st & 1) * 32 + (swz % 64) / 2; }
__host__ __device__ __forceinline__ int perm32(int rho) { const int n = rho >> 4, i = rho & 15; return 8 * (i >> 2) + 4 * n + (i & 3); }

struct Unit { const char* a; const char* b; int pm, pn, aux; const int* gl; int gn; };
struct Gemm { int lda, ldb, K; };

__device__ __forceinline__ unsigned cvt_pk_bf16(float lo, float hi) { return pk2(lo, hi); }

template <class Epi, class Sched, bool ALIGN_EPI = false, bool SP2 = false, bool GATHER = false>
__device__ __forceinline__ void gemm_phase(PG8_LAS unsigned char* lds, const Gemm g, const Sched& S, const Epi& E) {
    int tid = threadIdx.x; asm volatile("" : "+v"(tid));
    const int wid = __builtin_amdgcn_readfirstlane(tid >> 6), lane = tid & 63, wr = wid >> 2, wc = wid & 3, fr = lane & 15, fq = lane >> 4;
    int K = g.K; asm volatile("" : "+s"(K)); const int nt = K / BK;
    unsigned voffA[2][2], voffN[2][2], voffB[2];
    int RA[2], CA[2];
#pragma unroll
    for (int i = 0; i < 2; ++i) { int R, C; stage_rc(tid * 16 + i * 8192, R, C); const int Rb = Epi::PERM ? ((R & ~31) + perm32(R & 31)) : R; RA[i] = R; CA[i] = C;
        voffA[0][i] = (unsigned)(R * g.lda + C) * 2u; voffA[1][i] = (unsigned)((R + HALF) * g.lda + C) * 2u; voffN[0][i] = voffA[0][i]; voffN[1][i] = voffA[1][i]; voffB[i] = (unsigned)(Rb * g.ldb + C) * 2u; }
#define PG8_GOFF(dst, u) do { _Pragma("unroll") for (int h_ = 0; h_ < 2; ++h_) _Pragma("unroll") for (int i_ = 0; i_ < 2; ++i_) { const int r_ = h_ * HALF + RA[i_]; const int idx_ = (r_ < (u).gn) ? (u).gl[r_] : 0; \
        dst[h_][i_] = (unsigned)(idx_ * g.lda + CA[i_]) * 2u; } } while (0)
    const size_t kstep = (size_t)(BK * 2);
    int lda_ = g.lda, ldb_ = g.ldb; asm volatile("" : "+s"(lda_), "+s"(ldb_));
    const size_t hB = (size_t)HALF * ldb_ * 2; (void)lda_;
    const unsigned ldsw = (unsigned)wid * 1024u;
    const int aoff = lds_byte(wr * 64 + fr, fq * 8), boff = lds_byte(wc * 32 + fr, fq * 8);
#define PG8_SA(b, h) (((b) * 2 + (h)) * HTB)
#define PG8_SB(b, h) ((4 + (b) * 2 + (h)) * HTB)
#define PG8_STAGE(bufoff, gbase, voff) do { _Pragma("unroll") for (int _i = 0; _i < 2; ++_i) \
        __builtin_amdgcn_global_load_lds((const unsigned*)((const char*)(gbase) + (voff)[_i]), (PG8_LAS unsigned*)(lds + (bufoff) + ldsw + _i * 8192), 16, 0, 0); } while (0)
#define PG8_STAGE_A(bufoff, gbase, vo, h) do { _Pragma("unroll") for (int _i = 0; _i < 2; ++_i) \
        __builtin_amdgcn_global_load_lds((const unsigned*)((const char*)(gbase) + (vo)[h][_i]), (PG8_LAS unsigned*)(lds + (bufoff) + ldsw + _i * 8192), 16, 0, 0); } while (0)
#define PG8_LDA(dst, b, h) do { _Pragma("unroll") for (int m = 0; m < 4; ++m) _Pragma("unroll") for (int k = 0; k < 2; ++k) dst[m][k] = *(const PG8_LAS bf16x8*)(lds + PG8_SA(b, h) + aoff + m * 2048 + k * 1024); } while (0)
#define PG8_LDB(dst, b, h) do { _Pragma("unroll") for (int n = 0; n < 2; ++n) _Pragma("unroll") for (int k = 0; k < 2; ++k) dst[n][k] = *(const PG8_LAS bf16x8*)(lds + PG8_SB(b, h) + boff + n * 2048 + k * 1024); } while (0)
#define PG8_MMA(ai, bj, At, Bt) do { __builtin_amdgcn_s_setprio(1); _Pragma("unroll") for (int m = 0; m < 4; ++m) _Pragma("unroll") for (int n = 0; n < 2; ++n) _Pragma("unroll") for (int k = 0; k < 2; ++k) \
        acc[ai][bj][m][n] = __builtin_amdgcn_mfma_f32_16x16x32_bf16(Bt[n][k], At[m][k], acc[ai][bj][m][n], 0, 0, 0); __builtin_amdgcn_s_setprio(0); } while (0)
#define PG8_WAIT_V(n) asm volatile("s_waitcnt vmcnt(" #n ")" ::: "memory")
#define PG8_WAIT_L(n) asm volatile("s_waitcnt lgkmcnt(" #n ")" ::: "memory")
#define PG8_BAR __builtin_amdgcn_s_barrier()
#define PG8_SCHED __builtin_amdgcn_sched_barrier(0)
    Unit cur, nxt; int ui = 0;
    if (!S.next(0, cur)) return;
    f32x4 acc[2][2][4][2];
#pragma unroll
    for (int a = 0; a < 2; ++a)
#pragma unroll
        for (int b = 0; b < 2; ++b)
#pragma unroll
            for (int m = 0; m < 4; ++m)
#pragma unroll
                for (int n = 0; n < 2; ++n) acc[a][b][m][n] = (f32x4){0.f, 0.f, 0.f, 0.f};
    bf16x8 At[4][2], B0[2][2], B1[2][2];
    const char* cA = cur.a; const char* cB = cur.b;
    if constexpr (GATHER) PG8_GOFF(voffA, cur);
    if constexpr (SP2) {
        PG8_STAGE(PG8_SB(0, 0), cB, voffB); PG8_STAGE(PG8_SB(0, 1), cB + hB, voffB); PG8_STAGE_A(PG8_SA(0, 0), cA, voffA, 0); PG8_STAGE_A(PG8_SA(0, 1), cA, voffA, 1);
        if (wr == 1) PG8_BAR;
        PG8_WAIT_V(2); PG8_BAR;
        PG8_STAGE(PG8_SB(1, 0), cB + kstep, voffB); PG8_STAGE_A(PG8_SA(1, 0), cA + kstep, voffA, 0); PG8_STAGE(PG8_SB(1, 1), cB + hB + kstep, voffB);
        PG8_WAIT_V(6); PG8_BAR;
    } else {
        PG8_STAGE(PG8_SB(0, 0), cB, voffB); PG8_STAGE_A(PG8_SA(0, 0), cA, voffA, 0); PG8_STAGE(PG8_SB(0, 1), cB + hB, voffB); PG8_STAGE_A(PG8_SA(0, 1), cA, voffA, 1);
        if (wr == 1) PG8_BAR;
        PG8_WAIT_V(4); PG8_BAR;
        PG8_STAGE(PG8_SB(1, 0), cB + kstep, voffB); PG8_STAGE_A(PG8_SA(1, 0), cA + kstep, voffA, 0); PG8_STAGE(PG8_SB(1, 1), cB + hB + kstep, voffB);
        PG8_WAIT_V(6); PG8_BAR;
    }
    for (;;) {
        const bool has_next = S.next(ui + 1, nxt);
        const char* nA = has_next ? nxt.a : cA; const char* nB = has_next ? nxt.b : cB;
        if constexpr (GATHER) { if (has_next) PG8_GOFF(voffN, nxt); else { _Pragma("unroll") for (int h_ = 0; h_ < 2; ++h_) _Pragma("unroll") for (int i_ = 0; i_ < 2; ++i_) voffN[h_][i_] = voffA[h_][i_]; } }
        for (int t = 0; t < nt; t += 2) {
            const bool last = (t == nt - 2);
            const char* a1 = cA + (size_t)(t + 1) * kstep;
            const char* a2 = last ? nA : cA + (size_t)(t + 2) * kstep; const char* b2 = last ? nB : cB + (size_t)(t + 2) * kstep;
            const char* a3 = a2 + kstep; const char* b3 = b2 + kstep;
            unsigned vo2[2][2];
            _Pragma("unroll") for (int h_ = 0; h_ < 2; ++h_) _Pragma("unroll") for (int i_ = 0; i_ < 2; ++i_) vo2[h_][i_] = (GATHER && last) ? voffN[h_][i_] : voffA[h_][i_];
            if constexpr (SP2) {
            PG8_LDB(B0, 0, 0); PG8_LDB(B1, 0, 1); PG8_SCHED; PG8_LDA(At, 0, 0); PG8_STAGE_A(PG8_SA(1, 1), a1, voffA, 1);
            PG8_WAIT_V(8); PG8_WAIT_L(0); PG8_BAR; PG8_MMA(0, 0, At, B0); PG8_MMA(0, 1, At, B1); PG8_BAR; PG8_SCHED;
            if constexpr (Epi::NAI == 2) PG8_LDA(At, 0, 1); PG8_STAGE(PG8_SB(0, 0), b2, voffB); PG8_STAGE(PG8_SB(0, 1), b2 + hB, voffB); PG8_STAGE_A(PG8_SA(0, 0), a2, vo2, 0);
            PG8_WAIT_V(8); PG8_WAIT_L(0); PG8_BAR; if constexpr (Epi::NAI == 2) { PG8_MMA(1, 0, At, B0); PG8_MMA(1, 1, At, B1); } PG8_BAR; PG8_SCHED;
            PG8_LDB(B0, 1, 0); PG8_LDB(B1, 1, 1); PG8_SCHED; PG8_LDA(At, 1, 0); PG8_STAGE_A(PG8_SA(0, 1), a2, vo2, 1);
            PG8_WAIT_V(8); PG8_WAIT_L(0); PG8_BAR; PG8_MMA(0, 0, At, B0); PG8_MMA(0, 1, At, B1); PG8_BAR; PG8_SCHED;
            if constexpr (Epi::NAI == 2) PG8_LDA(At, 1, 1); PG8_STAGE(PG8_SB(1, 0), b3, voffB); PG8_STAGE(PG8_SB(1, 1), b3 + hB, voffB); PG8_STAGE_A(PG8_SA(1, 0), a3, vo2, 0);
            PG8_WAIT_V(8); PG8_WAIT_L(0); PG8_BAR; if constexpr (Epi::NAI == 2) { PG8_MMA(1, 0, At, B0); PG8_MMA(1, 1, At, B1); } PG8_BAR; PG8_SCHED;
            } else {
            PG8_LDB(B0, 0, 0); PG8_SCHED; PG8_LDA(At, 0, 0); PG8_STAGE_A(PG8_SA(1, 1), a1, voffA, 1);
            PG8_WAIT_L(8); PG8_BAR; PG8_WAIT_L(0); PG8_MMA(0, 0, At, B0); PG8_BAR; PG8_SCHED;
            PG8_LDB(B1, 0, 1); PG8_STAGE(PG8_SB(0, 0), b2, voffB);
            PG8_BAR; PG8_WAIT_L(0); PG8_MMA(0, 1, At, B1); PG8_BAR;
            PG8_LDA(At, 0, 1); PG8_STAGE_A(PG8_SA(0, 0), a2, vo2, 0);
            PG8_BAR; PG8_WAIT_L(0); PG8_MMA(1, 0, At, B0); PG8_BAR; PG8_SCHED;
            PG8_STAGE(PG8_SB(0, 1), b2 + hB, voffB);
            PG8_WAIT_V(6); PG8_BAR; PG8_MMA(1, 1, At, B1); PG8_BAR;
            PG8_LDB(B0, 1, 0); PG8_SCHED; PG8_LDA(At, 1, 0); PG8_STAGE_A(PG8_SA(0, 1), a2, vo2, 1);
            PG8_WAIT_L(8); PG8_BAR; PG8_WAIT_L(0); PG8_MMA(0, 0, At, B0); PG8_BAR; PG8_SCHED;
            PG8_LDB(B1, 1, 1); PG8_STAGE(PG8_SB(1, 0), b3, voffB);
            PG8_BAR; PG8_WAIT_L(0); PG8_MMA(0, 1, At, B1); PG8_BAR;
            PG8_LDA(At, 1, 1); PG8_STAGE_A(PG8_SA(1, 0), a3, vo2, 0);
            PG8_BAR; PG8_WAIT_L(0); PG8_MMA(1, 0, At, B0); PG8_BAR; PG8_SCHED;
            PG8_STAGE(PG8_SB(1, 1), b3 + hB, voffB);
            PG8_WAIT_V(6); PG8_BAR; PG8_MMA(1, 1, At, B1); PG8_BAR;
            }
            if constexpr (Epi::HOOK) { if (t + 2 == 8 || t + 2 == 16) { int t3_ = threadIdx.x; asm volatile("" : "+v"(t3_)); E.mid(acc, cur, (t + 2) / 8 - 1, wr, wc, t3_ & 15, (t3_ >> 4) & 3); } }
        }
        if constexpr (ALIGN_EPI) { if (wr == 0) PG8_BAR; }
        { int t2_ = threadIdx.x; asm volatile("" : "+v"(t2_)); const int fr_ = t2_ & 15, fq_ = (t2_ >> 4) & 3;
          E(acc, cur, wr, wc, fr_, fq_); }
        if (!has_next) break;
#pragma unroll
        for (int a = 0; a < 2; ++a)
#pragma unroll
            for (int b = 0; b < 2; ++b)
#pragma unroll
                for (int m = 0; m < 4; ++m)
#pragma unroll
                    for (int n = 0; n < 2; ++n) acc[a][b][m][n] = (f32x4){0.f, 0.f, 0.f, 0.f};
        cur = nxt; cA = nA; cB = nB; ++ui;
        if constexpr (GATHER) { _Pragma("unroll") for (int h_ = 0; h_ < 2; ++h_) _Pragma("unroll") for (int i_ = 0; i_ < 2; ++i_) voffA[h_][i_] = voffN[h_][i_]; }
        if constexpr (ALIGN_EPI) { if (wr == 1) PG8_BAR; }
    }
    PG8_WAIT_V(0);
    if constexpr (!ALIGN_EPI) { if (wr == 0) PG8_BAR; }
    PG8_BAR;
#undef PG8_SA
#undef PG8_SB
#undef PG8_STAGE
#undef PG8_STAGE_A
#undef PG8_GOFF
#undef PG8_LDA
#undef PG8_LDB
#undef PG8_MMA
#undef PG8_WAIT_V
#undef PG8_WAIT_L
#undef PG8_BAR
#undef PG8_SCHED
}
}
namespace attn_body {
using bf16x8=__attribute__((ext_vector_type(8)))short;
using s16x4=__attribute__((ext_vector_type(4)))short;
using f32x16=__attribute__((ext_vector_type(16)))float;
using u32x4=__attribute__((ext_vector_type(4)))unsigned;
typedef unsigned short bf16;
constexpr int D=64,NW=8,QBLK=32,QB=QBLK*NW,KVBLK=64;
__device__ __forceinline__ int crow(int r,int hi){return (r&3)+8*(r>>2)+4*hi;}
#define SBAR() __builtin_amdgcn_sched_barrier(0)
constexpr int NSLOT=3, SLOTB=8192;
constexpr int LDS_K=0, LDS_V=NSLOT*SLOTB, LDS_WS=2*NSLOT*SLOTB, LDS_OST=LDS_WS+NW*64*4, LDS_BYTES=LDS_OST+NW*4096;
__device__ __forceinline__ void glds16(const void*gsrc,unsigned lds_dst){unsigned keep;
  asm volatile("s_mov_b32 %0, m0\n\ts_mov_b32 m0, %2\n\ts_nop 0\n\tglobal_load_lds_dwordx4 %1, off\n\ts_mov_b32 m0, %0":"=&s"(keep):"v"(gsrc),"s"(lds_dst):"memory");}
__device__ __forceinline__ float max3f(float a,float b,float c){float r;asm("v_max3_f32 %0, %1, %2, %3":"=v"(r):"v"(a),"v"(b),"v"(c));return r;}
__device__ __forceinline__ float max2f(float a,float b){float r;asm("v_max_f32_e32 %0, %1, %2":"=v"(r):"v"(a),"v"(b));return r;}
__device__ __forceinline__ float fadd_s(float a,float b){float r;asm("v_add_f32_e32 %0, %1, %2":"=v"(r):"v"(a),"v"(b));return r;}
__device__ __forceinline__ float fsub_s(float a,float b){float r;asm("v_sub_f32_e32 %0, %1, %2":"=v"(r):"v"(a),"v"(b));return r;}
typedef float f32x2_t __attribute__((ext_vector_type(2))); typedef __bf16 bf16x2_t __attribute__((ext_vector_type(2)));
__device__ __forceinline__ unsigned cvtpk_s(float lo,float hi){f32x2_t v={lo,hi};bf16x2_t b=__builtin_convertvector(v,bf16x2_t);return __builtin_bit_cast(unsigned,b);}
#define WAIT_BAR(N) asm volatile("s_waitcnt vmcnt(" #N ") lgkmcnt(0)\n\ts_barrier":::"memory")

__device__ __forceinline__ void qkt(f32x16&p0,f32x16&p1,const char*Kslot,const bf16x8*qr,const f32x16&negm,int r32,int hi){
  const char*kb=Kslot+hi*1024+r32*16;
  #pragma unroll
  for(int d0=0;d0<4;++d0){
    const bf16x8 b0=*reinterpret_cast<const bf16x8*>(kb+d0*2048);
    const bf16x8 b1=*reinterpret_cast<const bf16x8*>(kb+d0*2048+512);
    if(d0==0){p0=__builtin_amdgcn_mfma_f32_32x32x16_bf16(b0,qr[0],negm,0,0,0);p1=__builtin_amdgcn_mfma_f32_32x32x16_bf16(b1,qr[0],negm,0,0,0);}
    else{p0=__builtin_amdgcn_mfma_f32_32x32x16_bf16(b0,qr[d0],p0,0,0,0);p1=__builtin_amdgcn_mfma_f32_32x32x16_bf16(b1,qr[d0],p1,0,0,0);}}
}
typedef __attribute__((address_space(3))) const char* lds_cptr;
typedef short v4i16_t __attribute__((ext_vector_type(4)));
__device__ __forceinline__ void kload8(bf16x8*kf,lds_cptr kp){
  kf[0]=*(const __attribute__((address_space(3))) bf16x8*)(kp);      kf[1]=*(const __attribute__((address_space(3))) bf16x8*)(kp+512);
  kf[2]=*(const __attribute__((address_space(3))) bf16x8*)(kp+2048); kf[3]=*(const __attribute__((address_space(3))) bf16x8*)(kp+2560);
  kf[4]=*(const __attribute__((address_space(3))) bf16x8*)(kp+4096); kf[5]=*(const __attribute__((address_space(3))) bf16x8*)(kp+4608);
  kf[6]=*(const __attribute__((address_space(3))) bf16x8*)(kp+6144); kf[7]=*(const __attribute__((address_space(3))) bf16x8*)(kp+6656);
}
__device__ __forceinline__ void kload2(bf16x8*kf,lds_cptr kp,int j){ kf[2*j]=*(const __attribute__((address_space(3))) bf16x8*)(kp+j*2048); kf[2*j+1]=*(const __attribute__((address_space(3))) bf16x8*)(kp+j*2048+512); }
__device__ __forceinline__ s16x4 vtr(lds_cptr p){ return __builtin_bit_cast(s16x4,__builtin_amdgcn_ds_read_tr16_b64_v4i16((__attribute__((address_space(3))) v4i16_t*)p)); }
__device__ __forceinline__ float rowmax(const f32x16&p0,const f32x16&p1){
  float a=max3f(p0[0],p0[1],p1[0]),b=max3f(p0[2],p0[3],p1[1]);a=max3f(a,p1[2],p1[3]);
  #pragma unroll
  for(int r=4;r<16;r+=4){a=max3f(a,p0[r],p0[r+1]);b=max3f(b,p0[r+2],p0[r+3]);a=max3f(a,p1[r],p1[r+1]);b=max3f(b,p1[r+2],p1[r+3]);}
  const float m=max2f(a,b);
  auto rr=__builtin_amdgcn_permlane32_swap(__float_as_uint(m),__float_as_uint(m),false,false);
  return max2f(__uint_as_float(rr[0]),__uint_as_float(rr[1]));
}
__device__ __forceinline__ float rowmax16(const f32x16&p){
  float a=__builtin_fmaxf(__builtin_fmaxf(p[0],p[1]),p[2]),b=__builtin_fmaxf(__builtin_fmaxf(p[3],p[4]),p[5]);
  a=__builtin_fmaxf(__builtin_fmaxf(a,p[6]),p[7]); b=__builtin_fmaxf(__builtin_fmaxf(b,p[8]),p[9]); a=__builtin_fmaxf(__builtin_fmaxf(a,p[10]),p[11]); b=__builtin_fmaxf(__builtin_fmaxf(b,p[12]),p[13]);
  a=__builtin_fmaxf(__builtin_fmaxf(a,p[14]),p[15]);
  const float m=__builtin_fmaxf(a,b);
  auto rr=__builtin_amdgcn_permlane32_swap(__float_as_uint(m),__float_as_uint(m),false,false);
  return __builtin_fmaxf(__uint_as_float(rr[0]),__uint_as_float(rr[1]));
}
__device__ __forceinline__ void pv(f32x16*o,int vb,bf16x8 pa0,bf16x8 pa1,bf16x8 pa2,bf16x8 pa3){
  #pragma unroll
  for(int d0=0;d0<2;++d0){s16x4 lo[4],hi[4];
    #pragma unroll
    for(int ks=0;ks<4;++ks){
      asm volatile("ds_read_b64_tr_b16 %0,%1 offset:%c2":"=&v"(lo[ks]):"v"(vb),"i"(d0*4096+ks*1024):"memory");
      asm volatile("ds_read_b64_tr_b16 %0,%1 offset:%c2":"=&v"(hi[ks]):"v"(vb),"i"(d0*4096+ks*1024+512):"memory");}
    asm volatile("s_waitcnt lgkmcnt(0)":::"memory");SBAR();
    #define PK(k) (bf16x8){lo[k][0],lo[k][1],lo[k][2],lo[k][3],hi[k][0],hi[k][1],hi[k][2],hi[k][3]}
    o[d0]=__builtin_amdgcn_mfma_f32_32x32x16_bf16(pa0,PK(0),o[d0],0,0,0);
    o[d0]=__builtin_amdgcn_mfma_f32_32x32x16_bf16(pa1,PK(1),o[d0],0,0,0);
    o[d0]=__builtin_amdgcn_mfma_f32_32x32x16_bf16(pa2,PK(2),o[d0],0,0,0);
    o[d0]=__builtin_amdgcn_mfma_f32_32x32x16_bf16(pa3,PK(3),o[d0],0,0,0);
    #undef PK
  }
}

template<int MODE,int THRL> __device__ __forceinline__ void attn_unit(const bf16*Qw,long qpitch,const bf16*__restrict__ Kh,const bf16*__restrict__ Vh,long kvpitch,
    int NT,int nA,long rowB,bf16*Ow,long opitch,char*shm,lds_cptr btab_c,int qrow0,int jb0){
  int tid=threadIdx.x; asm volatile("":"+v"(tid)); const int lane=tid&63,r32=lane&31,hi=lane>>5; const int wid=__builtin_amdgcn_readfirstlane(tid>>6);
  const unsigned lds0=(unsigned)(uintptr_t)shm;
  float*wsf=(float*)(shm+LDS_WS)+wid*64;
  const bf16*ksrc=Kh+(long)lane*kvpitch+wid*8;
  const bf16*vsrc=Vh+(long)(16*(wid&3)+(lane>>2))*kvpitch+(wid>>2)*32+(lane&3)*8;
  const unsigned kdst=lds0+LDS_K+wid*1024, vdst=lds0+LDS_V+wid*1024;
  #define TR(t) (((t)<nA)?(long)(t)*KVBLK:rowB+(long)((t)-nA)*KVBLK)
  #define DMA_K(t,slot) glds16(ksrc+TR(t)*kvpitch,(unsigned)__builtin_amdgcn_readfirstlane(kdst+(slot)))
  #define DMA_V(t,slot) glds16(vsrc+TR(t)*kvpitch,(unsigned)__builtin_amdgcn_readfirstlane(vdst+(slot)))
  const int vb0=(int)(lds0+LDS_V)+((lane>>4)&1)*32+(lane&3)*8+(4*hi+((lane&15)>>2))*64;
  const char*Kbase=shm+LDS_K; bf16x8 kf[8];
  const lds_cptr shm3=(lds_cptr)shm; const lds_cptr kp0=shm3+LDS_K+hi*1024+r32*16; const lds_cptr vp0=shm3+LDS_V+((lane>>4)&1)*32+(lane&3)*8+(4*hi+((lane&15)>>2))*64;
  const int qrow_=qrow0+(wid>>1), qc_=32*(wid&1)+r32;
  const int cs_=min(max(qc_-8,0),48), rs_=min(max(qrow_-4,0),56);
  const int koff_=4*hi-cs_, boff_=15-qc_+4*hi;
  const float NEGV=-INFINITY;
  #define NAMASK(C0,C1,t) do{ if(MODE==1 && (t)>=4){ const int jrow_=jb0+(t)-4; \
      if(jrow_<rs_||jrow_>rs_+7){ _Pragma("unroll") for(int r=0;r<16;++r){C0[r]=NEGV;C1[r]=NEGV;} } \
      else { const __attribute__((address_space(3))) float* tb_=(const __attribute__((address_space(3))) float*)btab_c+((jrow_-qrow_+7)*32+boff_); \
        _Pragma("unroll") for(int r=0;r<16;++r){ const int kc_=(r&3)+8*(r>>2); const float b0_=tb_[kc_], b1_=tb_[kc_+32]; \
          C0[r]=((unsigned)(kc_+koff_)<16u)?(C0[r]+b0_):NEGV; C1[r]=((unsigned)(kc_+32+koff_)<16u)?(C1[r]+b1_):NEGV; } } } }while(0)
  DMA_K(0,0);DMA_V(0,0);DMA_K(1,SLOTB);
  bf16x8 qr[4];
  { const bf16*Qr=Qw+(long)(wid*QBLK+r32)*qpitch;
  #pragma unroll
  for(int d0=0;d0<4;++d0)qr[d0]=*reinterpret_cast<const bf16x8*>(&Qr[d0*16+hi*8]); }
  float mhat=0.f,l_reg=0.f;f32x16 o[2];o[0]=f32x16{};o[1]=f32x16{};f32x16 negm=f32x16{};asm volatile("":"+v"(negm));
  bool resc=false;
  #define START(P0,P1) do{ const float rm=rowmax(P0,P1); resc=false; \
    { const float dl=rm; mhat=fadd_s(mhat,dl); \
      _Pragma("unroll") for(int r=0;r<16;++r){P0[r]=fsub_s(P0[r],dl);P1[r]=fsub_s(P1[r],dl);} \
      _Pragma("unroll") for(int r=0;r<16;++r)negm[r]=-mhat; asm volatile("":"+v"(negm)); } \
    _Pragma("unroll") for(int r=0;r<16;++r)P0[r]=__builtin_amdgcn_exp2f(P0[r]); }while(0)
  #define RESC() do{ if(resc){ asm volatile("s_waitcnt lgkmcnt(0)":::"memory"); \
      _Pragma("unroll") for(int d_=0;d_<2;++d_) _Pragma("unroll") for(int r=0;r<16;++r)o[d_][r]*=wsf[crow(r,hi)]; } }while(0)
  f32x16 pA0,pA1,pB0,pB1;
  int sl_prev=0,sl_cur=0,sl_next=SLOTB;
  #define ROT() do{sl_prev=sl_cur;sl_cur=sl_next;sl_next=(sl_next==(NSLOT-1)*SLOTB)?0:sl_next+SLOTB;}while(0)
  DMA_K(2,2*SLOTB);
  WAIT_BAR(3);
  qkt(pA0,pA1,Kbase,qr,negm,r32,hi);asm volatile("s_nop 15\n\ts_nop 7":"+v"(pA0),"+v"(pA1));
  START(pA0,pA1);
  _Pragma("unroll") for(int r=0;r<16;++r)pA1[r]=__builtin_amdgcn_exp2f(pA1[r]);
  WAIT_BAR(0);
  DMA_K(3,0);DMA_V(1,SLOTB);
  ROT();
  kload8(kf,kp0+sl_cur);
  WAIT_BAR(2);
  s16x4 vlo[8],vhi[8]; u32x4 pw0,pw1,pw2,pw3;
  #define PKW(P,B) cvtpk_s(P[B],P[B+1])
  #define PAF(k) __builtin_bit_cast(bf16x8,pw##k)
  #define VFR(i) (bf16x8){vlo[i][0],vlo[i][1],vlo[i][2],vlo[i][3],vhi[i][0],vhi[i][1],vhi[i][2],vhi[i][3]}
  #define PIN(x) asm volatile("":"+v"(x))
  #define MX3(a,b,c) __builtin_fmaxf(__builtin_fmaxf((a),(b)),(c))
  #define GAPA(MF,A0,A1,A2,A3,W0,W1,PW) do{ MF; sacc+=A0; sacc+=A1; sacc+=A2; sacc+=A3; PIN(sacc); W0; W1; PIN(PW); SBAR(); }while(0)
  #define EX(v) __builtin_amdgcn_exp2f(v)
  #define GAPB(MF,X,B) do{ MF; X[B]=EX(X[B]); X[B+1]=EX(X[B+1]); X[B+2]=EX(X[B+2]); X[B+3]=EX(X[B+3]); PIN(X); SBAR(); }while(0)
  #define VRD(i) do{ vlo[i]=vtr(vp_+(((i)>>2)*4096+((i)&3)*1024)); vhi[i]=vtr(vp_+(((i)>>2)*4096+((i)&3)*1024+512)); }while(0)
  #define KRD(G,j) do{ if(G){ kload2(kf,kp0+sl_next,j); SBAR(); } }while(0)
  #define STEP(C0,C1,P0,P1,t,GK,GV,GL) do{ SBAR(); \
    const lds_cptr vp_=vp0+sl_prev; \
    VRD(0); SBAR(); float sacc=(P0[0]+P0[1]); \
    GAPA(C0=__builtin_amdgcn_mfma_f32_32x32x16_bf16(kf[0],qr[0],negm,0,0,0), P0[2],P0[3],P0[4],P0[5],     pw0[0]=PKW(P0,0), pw0[1]=PKW(P0,2), pw0); \
    VRD(4); SBAR(); GAPA(C1=__builtin_amdgcn_mfma_f32_32x32x16_bf16(kf[1],qr[0],negm,0,0,0), P0[6],P0[7],P0[8],P0[9],     pw0[2]=PKW(P0,4), pw0[3]=PKW(P0,6), pw0); \
    VRD(1); SBAR(); GAPA(C0=__builtin_amdgcn_mfma_f32_32x32x16_bf16(kf[2],qr[1],C0,0,0,0),   P0[10],P0[11],P0[12],P0[13], pw1[0]=PKW(P0,8), pw1[1]=PKW(P0,10), pw1); \
    VRD(5); SBAR(); GAPA(C1=__builtin_amdgcn_mfma_f32_32x32x16_bf16(kf[3],qr[1],C1,0,0,0),   P0[14],P0[15],P1[0],P1[1],   pw1[2]=PKW(P0,12),pw1[3]=PKW(P0,14), pw1); \
    VRD(2); SBAR(); GAPA(C0=__builtin_amdgcn_mfma_f32_32x32x16_bf16(kf[4],qr[2],C0,0,0,0),   P1[2],P1[3],P1[4],P1[5],     pw2[0]=PKW(P1,0), pw2[1]=PKW(P1,2), pw2); \
    VRD(6); SBAR(); GAPA(C1=__builtin_amdgcn_mfma_f32_32x32x16_bf16(kf[5],qr[2],C1,0,0,0),   P1[6],P1[7],P1[8],P1[9],     pw2[2]=PKW(P1,4), pw2[3]=PKW(P1,6), pw2); \
    VRD(3); SBAR(); GAPA(C0=__builtin_amdgcn_mfma_f32_32x32x16_bf16(kf[6],qr[3],C0,0,0,0),   P1[10],P1[11],P1[12],P1[13], pw3[0]=PKW(P1,8), pw3[1]=PKW(P1,10), pw3); \
    VRD(7); SBAR(); GAPA(C1=__builtin_amdgcn_mfma_f32_32x32x16_bf16(kf[7],qr[3],C1,0,0,0),   P1[14],P1[15],0.f,0.f,       pw3[2]=PKW(P1,12),pw3[3]=PKW(P1,14), pw3); \
    l_reg+=sacc; \
    if(GK){DMA_K((t)+3,sl_cur);} if(GV){DMA_V((t)+1,sl_next);} \
    NAMASK(C0,C1,t); \
    if constexpr (THRL < 1000) { \
    { float a=MX3(C0[0],C0[1],C1[0]),b=MX3(C0[2],C0[3],C1[1]); a=MX3(a,C1[2],C1[3]); \
      _Pragma("unroll") for(int r=4;r<16;r+=4){a=MX3(a,C0[r],C0[r+1]);b=MX3(b,C0[r+2],C0[r+3]);a=MX3(a,C1[r],C1[r+1]);b=MX3(b,C1[r+2],C1[r+3]);} \
      float rm=__builtin_fmaxf(a,b); { auto rr=__builtin_amdgcn_permlane32_swap(__float_as_uint(rm),__float_as_uint(rm),false,false); rm=__builtin_fmaxf(__uint_as_float(rr[0]),__uint_as_float(rr[1])); } \
      resc=false; \
      if(__builtin_expect(__any(rm>(float)THRL),0)){ const float dl=__builtin_fmaxf(rm,0.f); mhat+=dl; \
        _Pragma("unroll") for(int r=0;r<16;++r){C0[r]-=dl;C1[r]-=dl;} \
        _Pragma("unroll") for(int r=0;r<16;++r)negm[r]=-mhat; asm volatile("":"+v"(negm)); \
        const float f=__builtin_amdgcn_exp2f(-dl); l_reg*=f; if(hi==0)wsf[r32]=f; resc=true; } } \
    } \
    SBAR(); \
    GAPB(o[0]=__builtin_amdgcn_mfma_f32_32x32x16_bf16(PAF(0),VFR(0),o[0],0,0,0), C0,0); \
    GAPB(o[1]=__builtin_amdgcn_mfma_f32_32x32x16_bf16(PAF(0),VFR(4),o[1],0,0,0), C0,4); \
    KRD(GL,0); GAPB(o[0]=__builtin_amdgcn_mfma_f32_32x32x16_bf16(PAF(1),VFR(1),o[0],0,0,0), C0,8); \
    KRD(GL,1); GAPB(o[1]=__builtin_amdgcn_mfma_f32_32x32x16_bf16(PAF(1),VFR(5),o[1],0,0,0), C0,12); \
    KRD(GL,2); GAPB(o[0]=__builtin_amdgcn_mfma_f32_32x32x16_bf16(PAF(2),VFR(2),o[0],0,0,0), C1,0); \
    KRD(GL,3); GAPB(o[1]=__builtin_amdgcn_mfma_f32_32x32x16_bf16(PAF(2),VFR(6),o[1],0,0,0), C1,4); \
    GAPB(o[0]=__builtin_amdgcn_mfma_f32_32x32x16_bf16(PAF(3),VFR(3),o[0],0,0,0), C1,8); \
    GAPB(o[1]=__builtin_amdgcn_mfma_f32_32x32x16_bf16(PAF(3),VFR(7),o[1],0,0,0), C1,12); \
    }while(0)
  int t=1;
  for(;t+5<NT;t+=2){
    STEP(pB0,pB1,pA0,pA1,t,true,true,true);     WAIT_BAR(2); RESC(); ROT();
    STEP(pA0,pA1,pB0,pB1,t+1,true,true,true);   WAIT_BAR(2); RESC(); ROT();
  }
  #define ENDW(tt) do{ if((tt)+3<NT){WAIT_BAR(2);} else if((tt)+2<NT){WAIT_BAR(1);} else {WAIT_BAR(0);} }while(0)
  for(;t+1<NT;t+=2){
    STEP(pB0,pB1,pA0,pA1,t,(t+3<NT),(t+1<NT),(t+1<NT));       ENDW(t);   RESC(); ROT();
    STEP(pA0,pA1,pB0,pB1,t+1,(t+4<NT),(t+2<NT),(t+2<NT));     ENDW(t+1); RESC(); ROT();
  }
  STEP(pB0,pB1,pA0,pA1,NT-1,false,false,false); RESC();
  { float sacc=pB0[0]+pB0[1]; _Pragma("unroll") for(int r=2;r<16;++r)sacc+=pB0[r]; _Pragma("unroll") for(int r=0;r<16;++r)sacc+=pB1[r]; l_reg+=sacc;
    pw0=(u32x4){PKW(pB0,0),PKW(pB0,2),PKW(pB0,4),PKW(pB0,6)};pw1=(u32x4){PKW(pB0,8),PKW(pB0,10),PKW(pB0,12),PKW(pB0,14)};pw2=(u32x4){PKW(pB1,0),PKW(pB1,2),PKW(pB1,4),PKW(pB1,6)};pw3=(u32x4){PKW(pB1,8),PKW(pB1,10),PKW(pB1,12),PKW(pB1,14)};
    SBAR(); pv(o,vb0+sl_cur,PAF(0),PAF(1),PAF(2),PAF(3)); }
  #undef PKW
  #undef PAF
  #undef VFR
  #undef PIN
  #undef MX3
  #undef GAPA
  #undef GAPB
  #undef EX
  #undef VRD
  #undef KRD
  #undef STEP
  #undef ENDW
  {auto rr=__builtin_amdgcn_permlane32_swap(__float_as_uint(l_reg),__float_as_uint(l_reg),false,false);l_reg=__uint_as_float(rr[0])+__uint_as_float(rr[1]);}
  if(hi==0)wsf[32+r32]=l_reg;asm volatile("s_waitcnt lgkmcnt(0)":::"memory");
  float rli[16];
  #pragma unroll
  for(int r=0;r<16;++r)rli[r]=__builtin_amdgcn_rcpf(wsf[32+crow(r,hi)]);
  bf16*Owv=Ow+(long)(wid*QBLK)*opitch;
  { bf16*stg=(bf16*)(shm+LDS_OST)+wid*2048;
    #pragma unroll
    for(int r=0;r<16;++r){const int orow=crow(r,hi);
      #pragma unroll
      for(int d0=0;d0<2;++d0)stg[orow*64+d0*32+r32]=(bf16)f2bf(o[d0][r]*rli[r]);}
    asm volatile("s_waitcnt lgkmcnt(0)":::"memory");
    #pragma unroll
    for(int i=0;i<4;++i){const int row=i*8+(lane>>3),ch=lane&7; const u32x4 v=*(const u32x4*)(stg+row*64+ch*8); *(u32x4*)(Owv+(long)row*opitch+ch*8)=v;} }
  asm volatile("s_waitcnt lgkmcnt(0)\n\ts_barrier":::"memory");
  #undef DMA_K
  #undef DMA_V
  #undef TR
  #undef NAMASK
  #undef START
  #undef RESC
  #undef ROT
}
constexpr int ATTN_LDS_BYTES=LDS_BYTES;

template<int NBLK_DUMMY=0> __device__ __forceinline__ void na_unit(const bf16* __restrict__ Pb  , int h, int rg, bf16* Ob  , char* shm, lds_cptr tab  ){
  int tid=threadIdx.x; asm volatile("":"+v"(tid)); const int lane=tid&63,r32=lane&31,hi=lane>>5; const int wid=__builtin_amdgcn_readfirstlane(tid>>6);
  const int y0=4*rg+2*(wid>>2), x0=16*(wid&3);
  const int jb=min(max(y0-4,0),55), cb=min(max(x0-8,0),32);
  const int qrow=y0+(r32>>4), qcol=x0+(r32&15), qtok=qrow*64+qcol;
  const int rsq=min(max(qrow-4,0),56), csq=min(max(qcol-8,0),48);
  const bf16* Qp=Pb+(long)qtok*PW+C_BQ+h*64+hi*8;
  bf16x8 qr[4];
  #pragma unroll
  for(int ks=0;ks<4;++ks)qr[ks]=*reinterpret_cast<const bf16x8*>(Qp+ks*16);
  const bf16* Ksrc=Pb+C_BK+h*64+(long)(lane>>3)*PW+(((lane&7)^(lane>>3))*8);
  const bf16* Vsrc=Pb+C_BV+h*64+(long)(lane>>3)*PW+(((lane&7)^(lane>>3))*8);
  const unsigned wb0=(unsigned)(uintptr_t)shm+wid*16384;
  typedef const __attribute__((address_space(3))) bf16x8* lds_b8;
  const lds_cptr wl=(lds_cptr)shm+wid*16384;
  int kofs[4];
  #pragma unroll
  for(int ks=0;ks<4;++ks) kofs[ks]=r32*128+(((2*ks+hi)^(r32&7))*16);
  const int q4=(lane&15)>>2, p4=lane&3, h16=(lane>>4)&1, sw=4*hi+q4;
  const int vofs0=sw*128+(((2*h16+(p4>>1))^sw)*16)+(p4&1)*8, vofs1=sw*128+(((4+2*h16+(p4>>1))^sw)*16)+(p4&1)*8;
  typedef const __attribute__((address_space(3))) float* lds_fptr;
  lds_fptr ta[16];
  #pragma unroll
  for(int r=0;r<16;++r){ const int kc=cb+(r&3)+8*(r>>2)+4*hi; const int idx=((unsigned)(kc-csq)<16u)?(kc-qcol+15):31; ta[r]=(lds_fptr)tab+(jb-qrow+7)*32+idx; }
  const float rm0=((unsigned)(jb-rsq)<8u)?1.f:0.f, rm8=((unsigned)(jb+8-rsq)<8u)?1.f:0.f;
  #define NA_TOK(i) ((i)<8 ? NLAT+32*(i) : (jb+(i)-8)*64+cb)
  #define NA_LOADK(i) do{ const long t0_=(long)NA_TOK(i); \
      _Pragma("unroll") for(int j_=0;j_<4;++j_) glds16(Ksrc+(t0_+8*j_)*PW,(unsigned)__builtin_amdgcn_readfirstlane(wb0+((i)&1)*4096+j_*1024)); }while(0)
  #define NA_LOADV(i) do{ const long t0_=(long)NA_TOK(i); \
      _Pragma("unroll") for(int j_=0;j_<4;++j_) glds16(Vsrc+(t0_+8*j_)*PW,(unsigned)__builtin_amdgcn_readfirstlane(wb0+8192+((i)&1)*4096+j_*1024)); }while(0)
  #define NA_QK(i,c_) do{ const lds_cptr kp_=wl+((i)&1)*4096; bf16x8 kf_[4]; _Pragma("unroll") for(int ks=0;ks<4;++ks) kf_[ks]=*(lds_b8)(kp_+kofs[ks]); \
    c_=__builtin_amdgcn_mfma_f32_32x32x16_bf16(kf_[0],qr[0],negm,0,0,0); c_=__builtin_amdgcn_mfma_f32_32x32x16_bf16(kf_[1],qr[1],c_,0,0,0); \
    c_=__builtin_amdgcn_mfma_f32_32x32x16_bf16(kf_[2],qr[2],c_,0,0,0); c_=__builtin_amdgcn_mfma_f32_32x32x16_bf16(kf_[3],qr[3],c_,0,0,0); }while(0)
  f32x16 o0=f32x16{},o1=f32x16{},negm=f32x16{}; float l_reg=0.f;
  asm volatile("s_waitcnt vmcnt(0)":::"memory");
  NA_LOADK(0); NA_LOADV(0); NA_LOADK(1); NA_LOADV(1);
  f32x16 cA,cB;
  asm volatile("s_waitcnt vmcnt(12)":::"memory");
  NA_QK(0,cA);
  { const float m_=rowmax16(cA); _Pragma("unroll") for(int r=0;r<16;++r){ cA[r]-=m_; negm[r]=-m_; } }
  #define NA_STEP(i,cc_,cn_) do{ \
    if((i)+2<17){ NA_LOADK((i)+2); asm volatile("s_waitcnt vmcnt(8)":::"memory"); } else if((i)+1<17){ asm volatile("s_waitcnt vmcnt(4)":::"memory"); } else { asm volatile("s_waitcnt vmcnt(0)":::"memory"); } \
    if((i)+1<17){ NA_QK((i)+1,cn_); } \
    const lds_cptr vp_=wl+8192+((i)&1)*4096; \
    s16x4 vl_[4],vh_[4]; \
    _Pragma("unroll") for(int kg=0;kg<2;++kg){ vl_[kg]=vtr(vp_+vofs0+kg*2048); vh_[kg]=vtr(vp_+vofs0+kg*2048+1024); vl_[2+kg]=vtr(vp_+vofs1+kg*2048); vh_[2+kg]=vtr(vp_+vofs1+kg*2048+1024); } \
    if((i)>=8){ _Pragma("unroll") for(int r=0;r<16;++r) cc_[r]+=ta[r][((i)-8)*32]; } \
    _Pragma("unroll") for(int r=0;r<16;++r) cc_[r]=__builtin_amdgcn_exp2f(cc_[r]); \
    if((i)==8){ _Pragma("unroll") for(int r=0;r<16;++r) cc_[r]*=rm0; } \
    if((i)==16){ _Pragma("unroll") for(int r=0;r<16;++r) cc_[r]*=rm8; } \
    { float s_=(cc_[0]+cc_[1])+(cc_[2]+cc_[3]); _Pragma("unroll") for(int r=4;r<16;r+=4) s_+=(cc_[r]+cc_[r+1])+(cc_[r+2]+cc_[r+3]); l_reg+=s_; } \
    const u32x4 pa_=(u32x4){cvtpk_s(cc_[0],cc_[1]),cvtpk_s(cc_[2],cc_[3]),cvtpk_s(cc_[4],cc_[5]),cvtpk_s(cc_[6],cc_[7])}, pb_=(u32x4){cvtpk_s(cc_[8],cc_[9]),cvtpk_s(cc_[10],cc_[11]),cvtpk_s(cc_[12],cc_[13]),cvtpk_s(cc_[14],cc_[15])}; \
    asm volatile("s_waitcnt lgkmcnt(0)":::"memory"); \
    if((i)+2<17){ NA_LOADV((i)+2); } \
    o0=__builtin_amdgcn_mfma_f32_32x32x16_bf16(__builtin_bit_cast(bf16x8,pa_),(bf16x8){vl_[0][0],vl_[0][1],vl_[0][2],vl_[0][3],vh_[0][0],vh_[0][1],vh_[0][2],vh_[0][3]},o0,0,0,0); \
    o1=__builtin_amdgcn_mfma_f32_32x32x16_bf16(__builtin_bit_cast(bf16x8,pa_),(bf16x8){vl_[2][0],vl_[2][1],vl_[2][2],vl_[2][3],vh_[2][0],vh_[2][1],vh_[2][2],vh_[2][3]},o1,0,0,0); \
    o0=__builtin_amdgcn_mfma_f32_32x32x16_bf16(__builtin_bit_cast(bf16x8,pb_),(bf16x8){vl_[1][0],vl_[1][1],vl_[1][2],vl_[1][3],vh_[1][0],vh_[1][1],vh_[1][2],vh_[1][3]},o0,0,0,0); \
    o1=__builtin_amdgcn_mfma_f32_32x32x16_bf16(__builtin_bit_cast(bf16x8,pb_),(bf16x8){vl_[3][0],vl_[3][1],vl_[3][2],vl_[3][3],vh_[3][0],vh_[3][1],vh_[3][2],vh_[3][3]},o1,0,0,0); \
  }while(0)
  NA_STEP(0,cA,cB); NA_STEP(1,cB,cA); NA_STEP(2,cA,cB); NA_STEP(3,cB,cA); NA_STEP(4,cA,cB); NA_STEP(5,cB,cA); NA_STEP(6,cA,cB); NA_STEP(7,cB,cA); NA_STEP(8,cA,cB);
  NA_STEP(9,cB,cA); NA_STEP(10,cA,cB); NA_STEP(11,cB,cA); NA_STEP(12,cA,cB); NA_STEP(13,cB,cA); NA_STEP(14,cA,cB); NA_STEP(15,cB,cA); NA_STEP(16,cA,cB);
  #undef NA_STEP
  #undef NA_QK
  #undef NA_LOADK
  #undef NA_LOADV
  #undef NA_TOK
  {auto rr=__builtin_amdgcn_permlane32_swap(__float_as_uint(l_reg),__float_as_uint(l_reg),false,false);l_reg=__uint_as_float(rr[0])+__uint_as_float(rr[1]);}
  float*wsf=(float*)(shm+wid*16384+4096);
  if(hi==0)wsf[r32]=l_reg; asm volatile("s_waitcnt lgkmcnt(0)":::"memory");
  float rli[16];
  #pragma unroll
  for(int r=0;r<16;++r)rli[r]=__builtin_amdgcn_rcpf(wsf[crow(r,hi)]);
  { bf16*stg=(bf16*)(shm+wid*16384);
    #pragma unroll
    for(int r=0;r<16;++r){const int orow=crow(r,hi); stg[orow*64+r32]=(bf16)f2bf(o0[r]*rli[r]); stg[orow*64+32+r32]=(bf16)f2bf(o1[r]*rli[r]);}
    asm volatile("s_waitcnt lgkmcnt(0)":::"memory");
    #pragma unroll
    for(int i=0;i<4;++i){const int row=i*8+(lane>>3),ch=lane&7; const u32x4 v=*(const u32x4*)(stg+row*64+ch*8);
      const int tok=(y0+(row>>4))*64+x0+(row&15); *(u32x4*)(Ob+(long)tok*OW+512+h*64+ch*8)=v;}
    asm volatile("s_waitcnt lgkmcnt(0)":::"memory"); }
}
#undef SBAR
#undef WAIT_BAR
}
constexpr size_t MiB = 1u << 20;
constexpr size_t WS_CTL = 0, CTL_ZERO_BYTES = 128 * 1024;
constexpr size_t WS_MOD = 1 * MiB;
constexpr size_t WS_ROPE = 2 * MiB;
constexpr size_t WS_TOK = 3 * MiB;
constexpr size_t WS_XC = 5 * MiB;
constexpr size_t WS_WR = 4 * MiB + 512 * 1024;
constexpr size_t WS_WIN = 21 * MiB, WIN_L = 15 * MiB;
constexpr size_t WS_WBR = 51 * MiB, WBR_L = 3 * MiB;
constexpr size_t WS_WOUT = 57 * MiB, WOUT_L = 2 * MiB;
constexpr size_t WS_WGU = 61 * MiB, WGU_L = 32 * MiB;
constexpr size_t WS_WDN = 125 * MiB, WDN_L = 16 * MiB;
constexpr size_t WS_H = 157 * MiB;
constexpr size_t WS_P = 225 * MiB;
constexpr size_t WS_GATES = 514 * MiB;
constexpr size_t WS_OUTS = 517 * MiB;
constexpr size_t WS_HDIR = 619 * MiB;
constexpr size_t WS_Y = WS_HDIR;
constexpr size_t WS_MERGED = 687 * MiB;
constexpr int MGP = 1088;
constexpr size_t WS_SG = 760 * MiB;
constexpr size_t WS_LIST = 965 * MiB;
constexpr int LIST_CAP = 2 * TG;
constexpr size_t WS_END = 974 * MiB;
static_assert(WS_MERGED + (size_t)TG * MGP * 2 <= WS_SG && WS_SG + (size_t)TG * 3072 * 2 <= WS_LIST, "workspace map");
constexpr int XS_ROWS = 77824;
constexpr size_t WS_XS = WS_P;
constexpr size_t WS_ACT = WS_P + 152 * MiB;
constexpr size_t WS_YS = WS_P + 190 * MiB;
static_assert(WS_YS + (size_t)XS_ROWS * 2048 <= WS_HDIR + 68 * MiB, "overlay map");
constexpr int CW_BAR = 4096;
constexpr int CW_Q = 8192;
constexpr int CW_ECNT = 16384;

constexpr int RING_OFF = 0, RING_BYTES = 131072;
constexpr int LDSX_OFF = RING_BYTES;
constexpr int LDSCTL_OFF = 144 * 1024 - 512;
constexpr int LDS_BYTES = 147456;

#define RLX_AGENT __ATOMIC_RELAXED, __HIP_MEMORY_SCOPE_AGENT
#define LDS_WAIT() asm volatile("s_waitcnt lgkmcnt(0)" ::: "memory")
#define VM_WAIT() asm volatile("s_waitcnt vmcnt(0)" ::: "memory")

#define XB_TMO      128
#define XB_XCNT(j)  (256  + 64 * (j))
#define XB_XSUB(j)  (1280 + 64 * (j))
#define XB_XGEN(j)  (2304 + 64 * (j))
#define XB_TOP      3328
#define XB_TOPGEN   3392
#define XCD_BAR_WORDS 3456
#define XB_SPIN_CAP (1u << 24)

__device__ __forceinline__ unsigned xb_ld(unsigned* p)              { return __hip_atomic_load(p, __ATOMIC_RELAXED, __HIP_MEMORY_SCOPE_AGENT); }
__device__ __forceinline__ unsigned xb_add(unsigned* p, unsigned v) { return __hip_atomic_fetch_add(p, v, __ATOMIC_RELAXED, __HIP_MEMORY_SCOPE_AGENT); }
__device__ __forceinline__ unsigned xb_xcc_id() { return (unsigned)__builtin_amdgcn_s_getreg((3 << 11) | 20) & 0xFu; }
#define XB_SPIN(cond, bar) do { unsigned _sp = 0; while (cond) { __builtin_amdgcn_s_sleep(1); \
    if ((++_sp & 255u) == 0u) { if (xb_ld(&(bar)[XB_TMO])) break; if (_sp > XB_SPIN_CAP) { atomicAdd(&(bar)[XB_TMO], 1u); break; } } } } while (0)

struct XcdBarrier { unsigned* bar; unsigned x; volatile LAS unsigned* st; };

__device__ __forceinline__ XcdBarrier xcd_barrier_post(unsigned* bar, volatile LAS unsigned* st) {
    XcdBarrier b; b.bar = bar; b.x = xb_xcc_id(); b.st = st;
    if (threadIdx.x == 0) (void)xb_add(&bar[XB_XCNT(b.x)], 1u);
    return b;
}
__device__ __forceinline__ void xcd_barrier_complete(unsigned* bar, unsigned x, unsigned& nloc, unsigned& nx) {
    const unsigned G = gridDim.x * gridDim.y * gridDim.z;
    unsigned sum, cnt, mine, sp = 0u;
    for (;;) {
        sum = 0u; cnt = 0u; mine = 0u;
#pragma unroll
        for (unsigned j = 0; j < 16; ++j) { const unsigned c = xb_ld(&bar[XB_XCNT(j)]); sum += c; cnt += (c > 0u) ? 1u : 0u; mine = (j == x) ? c : mine; }
        if (sum == G) break;
        __builtin_amdgcn_s_sleep(1);
        if ((++sp & 255u) == 0u) { if (xb_ld(&bar[XB_TMO])) break; if (sp > XB_SPIN_CAP) { atomicAdd(&bar[XB_TMO], 1u); break; } }
    }
    nloc = mine > 0u ? mine : 1u; nx = cnt > 0u ? cnt : 1u;
}
__device__ __forceinline__ void xcd_barrier(const XcdBarrier& b) {
    asm volatile("s_waitcnt vmcnt(0)" ::: "memory");
    __syncthreads();
    if (threadIdx.x == 0) {
        unsigned* bar = b.bar;
        __builtin_amdgcn_s_waitcnt(0);
        unsigned nloc = b.st[0], nx = b.st[1];
        if (nloc == 0u) { xcd_barrier_complete(bar, b.x, nloc, nx); b.st[0] = nloc; b.st[1] = nx; }
        const unsigned old = xb_add(&bar[XB_XSUB(b.x)], 1u);
        const unsigned gen = old / nloc;
        if (old + 1u == (gen + 1u) * nloc) {
            __builtin_amdgcn_fence(__ATOMIC_RELEASE, "agent");
            asm volatile("s_waitcnt vmcnt(0)" ::: "memory");
            const unsigned og = xb_add(&bar[XB_TOP], 1u);
            const unsigned tg = og / nx;
            if (og + 1u == (tg + 1u) * nx) xb_add(&bar[XB_TOPGEN], 1u);
            else XB_SPIN(xb_ld(&bar[XB_TOPGEN]) == tg, bar);
            __builtin_amdgcn_fence(__ATOMIC_ACQUIRE, "agent");
            xb_add(&bar[XB_XGEN(b.x)], 1u);
            asm volatile("s_waitcnt vmcnt(0)" ::: "memory");
        } else {
            XB_SPIN(xb_ld(&bar[XB_XGEN(b.x)]) == gen, bar);
            __builtin_amdgcn_fence(__ATOMIC_ACQUIRE, "agent");
            asm volatile("s_waitcnt vmcnt(0)" ::: "memory");
        }
    }
    __syncthreads();
}

struct Frame {
    LAS unsigned char* lds;
    volatile LAS unsigned* MISC;
    unsigned* ctl;
    unsigned char* ws;
    int tid, lane, wave, G, gw, NGW;
    float* out;
};
struct Args { const float* in[21]; float* out; unsigned char* ws; int ph_lo, ph_hi; };
enum { I_X = 0, I_C, I_CTX, I_CCTX, I_WMOD, I_BMOD, I_GNORM, I_WIN, I_BMERGE, I_GQK, I_RPB, I_BMLSTM, I_GML, I_WBRANCH, I_WOUT, I_WGROUP, I_BGROUP, I_WROUTER, I_BROUTER, I_WGU, I_WDN };
__device__ __forceinline__ bool refresh(Frame& F) { int t = threadIdx.x; asm volatile("" : "+v"(t)); F.tid = t; F.lane = t & 63; int w = F.wave; asm volatile("" : "+s"(w)); F.wave = w; F.gw = (int)blockIdx.x * 8 + w; return true; }
__device__ __forceinline__ int dequeue(Frame& F, unsigned* counter, int slot) {
    __syncthreads();
    if (F.tid == 0) F.MISC[slot] = __hip_atomic_fetch_add(counter, 1u, RLX_AGENT);
    __syncthreads();
    return (int)F.MISC[slot];
}
__device__ __forceinline__ unsigned dq_issue(Frame& F, unsigned* counter) { unsigned v = 0u; if (F.tid == 0) v = __hip_atomic_fetch_add(counter, 1u, RLX_AGENT); return v; }
__device__ __forceinline__ int dq_take(Frame& F, unsigned v, int slot) {
    __syncthreads();
    if (F.tid == 0) F.MISC[slot] = v;
    __syncthreads();
    return (int)F.MISC[slot];
}
template <class RowPtr>
__device__ __forceinline__ void transpose_item(const float* W, int ldw, int ncols, int k0, int n0, LAS float* scr, int lane, const RowPtr& rp) {
    float tv[32];
#pragma unroll
    for (int i = 0; i < 32; ++i) { const int kk = 2 * i + (lane >> 5), n = n0 + (lane & 31); tv[i] = (n < ncols) ? W[(size_t)(k0 + kk) * ldw + n] : 0.f; }
#pragma unroll
    for (int i = 0; i < 32; ++i) { const int kk = 2 * i + (lane >> 5); scr[kk * 33 + (lane & 31)] = tv[i]; }
    LDS_WAIT(); asm volatile("" ::: "memory");
    const int c = lane & 7;
#pragma unroll
    for (int j = 0; j < 4; ++j) { const int nl = (lane >> 3) + 8 * j, n = n0 + nl; const LAS float* s = scr + (8 * c) * 33 + nl;
        v4u o; o.x = pk2(s[0 * 33], s[1 * 33]); o.y = pk2(s[2 * 33], s[3 * 33]); o.z = pk2(s[4 * 33], s[5 * 33]); o.w = pk2(s[6 * 33], s[7 * 33]);
        if (n < ncols) *(v4u*)(rp(n) + k0 + 8 * c) = o; }
    LDS_WAIT(); asm volatile("" ::: "memory");
}
constexpr int IT_WIN = 16 * 233, IT_WBR = 3 * 8 * 32, IT_WOUT = 16 * 32, IT_WGU = 32 * 16 * 16, IT_WDN = 32 * 4 * 32, IT_LAYER = IT_WIN + IT_WBR + IT_WOUT + IT_WGU + IT_WDN;

__device__ __forceinline__ void p0_prologue(Frame& F, const Args& A) {
    LAS float* sv = (LAS float*)(F.lds + RING_OFF);
    LAS float* part = (LAS float*)(F.lds + RING_OFF + 17 * 1024 * 4);
    float* MOD = (float*)(F.ws + WS_MOD);
    if ((int)blockIdx.x < DEPTH * 24) {
        for (int idx = F.tid; idx < 17 * 1024; idx += 512) { const int rr = idx >> 10, kk = idx & 1023; const float cv = (rr < 16) ? A.in[I_C][rr * 1024 + kk] : A.in[I_CCTX][kk]; sv[idx] = cv / (1.0f + expf(-cv)); }
        __syncthreads();
        for (int it = blockIdx.x; it < DEPTH * 24; it += F.G) {
            const int l = it / 24, jb = it % 24;
            const int j = jb * 256 + (F.tid & 255), kh = F.tid >> 8;
            float acc[17];
#pragma unroll
            for (int rr = 0; rr < 17; ++rr) acc[rr] = 0.f;
            const float* wp = A.in[I_WMOD] + ((size_t)l * 1024 + kh * 512) * 6144 + j;
            for (int k0 = 0; k0 < 512; k0 += 32) { float wv[32];
#pragma unroll
                for (int u = 0; u < 32; ++u) wv[u] = wp[(size_t)(k0 + u) * 6144];
#pragma unroll
                for (int u = 0; u < 32; ++u) {
#pragma unroll
                    for (int rr = 0; rr < 17; ++rr) acc[rr] += sv[rr * 1024 + kh * 512 + k0 + u] * wv[u]; } }
            if (kh == 1) {
#pragma unroll
                for (int rr = 0; rr < 17; ++rr) part[(F.tid & 255) * 17 + rr] = acc[rr]; }
            __syncthreads();
            if (kh == 0) { const float bm = A.in[I_BMOD][l * 6144 + j];
#pragma unroll
                for (int rr = 0; rr < 17; ++rr) MOD[((size_t)l * 17 + rr) * 6144 + j] = (acc[rr] + part[(F.tid & 255) * 17 + rr]) + bm; }
            __syncthreads();
        }
    }
    __syncthreads();
    LAS float* scr = (LAS float*)(F.lds + RING_OFF + F.wave * 16384);
    bf16* const wsb = (bf16*)F.ws;
    unsigned* itq = F.ctl + CW_Q + 64 * 60;
    for (;;) {
        int it_ = 0; if (F.lane == 0) it_ = (int)__hip_atomic_fetch_add(itq, 16u, RLX_AGENT);
        const int itb = __builtin_amdgcn_readfirstlane(it_); if (itb >= DEPTH * IT_LAYER) break;
        for (int it = itb; it < itb + 16 && it < DEPTH * IT_LAYER; ++it) {
        const int l = it / IT_LAYER; int r = it % IT_LAYER;
        if (r < IT_WIN) { const int kb = r / 233, nb = r % 233; bf16* win = (bf16*)(F.ws + WS_WIN + l * WIN_L);
            transpose_item(A.in[I_WIN] + (size_t)l * DM * INW, INW, INW, kb * 64, nb * 32, scr, F.lane, [=](int n) { int r = n < 4368 ? n : n + 240; if (n < 640 || (n >= 768 && n < 1792)) { const int d = n & 63, nn = d >> 5, rr = d & 31; r = (n & ~63) + 32 * (rr >> 4) + 8 * ((rr >> 2) & 3) + 4 * nn + (rr & 3); } return win + (size_t)r * 1024; }); continue; }
        r -= IT_WIN;
        if (r < IT_WBR) { const int br = r / 256, q = r % 256, kb = q / 32, nb = q % 32; bf16* d = (bf16*)(F.ws + WS_WBR + l * WBR_L) + (size_t)br * 512;
            transpose_item(A.in[I_WBRANCH] + ((size_t)l * 3 + br) * 512 * 1024, 1024, 1024, kb * 64, nb * 32, scr, F.lane, [=](int n) { return d + (size_t)n * 1536; }); continue; }
        r -= IT_WBR;
        if (r < IT_WOUT) { const int kb = r / 32, nb = r % 32; bf16* d = (bf16*)(F.ws + WS_WOUT + l * WOUT_L);
            transpose_item(A.in[I_WOUT] + (size_t)l * 1024 * 1024, 1024, 1024, kb * 64, nb * 32, scr, F.lane, [=](int n) { return d + (size_t)n * 1024; }); continue; }
        r -= IT_WOUT;
        if (r < IT_WGU) { const int e = r / 256, q = r % 256, kb = q / 16, nb = q % 16; bf16* d = (bf16*)(F.ws + WS_WGU + l * WGU_L) + (size_t)e * 512 * 1024;
            transpose_item(A.in[I_WGU] + ((size_t)l * NEXP + e) * 1024 * 512, 512, 512, kb * 64, nb * 32, scr, F.lane,
                [=](int n) { const int m = n & 255, row = (m >> 7) * 256 + ((n >> 8) << 7) + (m & 127); return d + (size_t)row * 1024; }); continue; }
        r -= IT_WGU;
        { const int e = r / 128, q = r % 128, kb = q / 32, nb = q % 32; bf16* d = (bf16*)(F.ws + WS_WDN + l * WDN_L) + (size_t)e * 1024 * 256;
            transpose_item(A.in[I_WDN] + ((size_t)l * NEXP + e) * 256 * 1024, 1024, 1024, kb * 64, nb * 32, scr, F.lane, [=](int n) { return d + (size_t)n * 256; }); }
        }
    }
    for (int i = blockIdx.x * 512 + F.tid; i < DEPTH * 240 * 128; i += F.G * 512) { const int l = i / (240 * 128), q = i % (240 * 128);
        *(v4u*)(F.ws + WS_WIN + l * WIN_L + (size_t)4368 * 2048 + (size_t)q * 16) = (v4u){0u, 0u, 0u, 0u}; }
    for (int i = blockIdx.x * 512 + F.tid; i < DEPTH * 48 * 1024; i += F.G * 512) { const int l = i / (48 * 1024), n = (i >> 10) % 48, k = i & 1023;
        const float wv = (n < 4) ? A.in[I_WGROUP][((size_t)l * 1024 + k) * 4 + n] : (n < 36) ? A.in[I_WROUTER][((size_t)l * 1024 + k) * 32 + (n - 4)] : 0.f;
        const unsigned hi = f2bf(wv), lo = f2bf(wv - __builtin_bit_cast(float, hi << 16));
        bf16* wr = (bf16*)(F.ws + WS_WR) + (size_t)l * 2 * 48 * 1024; wr[n * 1024 + k] = (bf16)hi; wr[48 * 1024 + n * 1024 + k] = (bf16)lo; }
    for (int i = blockIdx.x * 512 + F.tid; i < NLAT * 32; i += F.G * 512) { const int t = i >> 5, k = i & 31, f = k & 15; const float pos = (float)((k < 16) ? (t >> 6) : (t & 63));
        const float inv = exp2f(-(float)f * (13.287712379549449f / 16.0f)); const float ang = pos * inv;
        ((f32x2*)(F.ws + WS_ROPE))[i] = (f32x2){cosf(ang), sinf(ang)}; }
}

__device__ __forceinline__ void row_range(const Frame& F, int& bl, int& r_lo, int& r_hi) {
    const int b = (int)blockIdx.x; bl = (b * GBS) / F.G;
    const int fb = (bl * F.G + GBS - 1) / GBS, nb = ((bl + 1) * F.G + GBS - 1) / GBS - fb, j = b - fb;
    r_lo = bl * TPS + (j * TPS) / nb; r_hi = bl * TPS + ((j + 1) * TPS) / nb;
}
__device__ __forceinline__ void phase_norm1(Frame& F, const Args& A, int l, int g) {
    const float* xlat = (l == 0) ? A.in[I_X] : F.out; const float* xctx = (l == 0) ? A.in[I_CTX] : (const float*)(F.ws + WS_XC);
    const float* MOD = (const float*)(F.ws + WS_MOD); bf16* H = (bf16*)(F.ws + WS_H);
    const float* gn = A.in[I_GNORM] + (size_t)(l * 2 + 0) * 1024;
    int bl, r_lo, r_hi; row_range(F, bl, r_lo, r_hi);
    LAS float* MDL = (LAS float*)F.lds;
    LAS float* GNL = MDL + 4096;
    __syncthreads();
    for (int i = F.tid; i < 2048; i += 512) { MDL[i] = MOD[((size_t)l * 17 + g * GBS + bl) * 6144 + i]; MDL[2048 + i] = MOD[((size_t)l * 17 + 16) * 6144 + i]; }
    for (int i = F.tid; i < 1024; i += 512) GNL[i] = gn[i];
    __syncthreads();
    for (int lr0 = r_lo + F.wave; lr0 < r_hi; lr0 += 16) {
        f32x4 v[2][4]; const LAS float* md[2]; bool ok[2];
#pragma unroll
        for (int k = 0; k < 2; ++k) { const int lr = lr0 + 8 * k; ok[k] = lr < r_hi; if (ok[k]) {
            const int t = lr - bl * TPS, b = g * GBS + bl;
            const float* src = (t < NLAT) ? xlat + ((size_t)b * NLAT + t) * DM : xctx + ((size_t)b * NCTX + (t - NLAT)) * DM;
            md[k] = MDL + ((t < NLAT) ? 0 : 2048);
            const f32x4* xr = (const f32x4*)src + F.lane;
#pragma unroll
            for (int j = 0; j < 4; ++j) v[k][j] = xr[64 * j]; } }
#pragma unroll
        for (int k = 0; k < 2; ++k) if (ok[k]) { const int lr = lr0 + 8 * k; float s = 0.f;
#pragma unroll
            for (int j = 0; j < 4; ++j) s += (v[k][j].x * v[k][j].x + v[k][j].y * v[k][j].y) + (v[k][j].z * v[k][j].z + v[k][j].w * v[k][j].w);
            const float rstd = rsq_(wave_sum(s) * (1.0f / DM) + EPS);
            v2u* o8 = (v2u*)(H + (size_t)lr * DM) + F.lane;
#pragma unroll
            for (int j = 0; j < 4; ++j) { const f32x4 gg = ((const LAS f32x4*)GNL)[F.lane + 64 * j], sh = ((const LAS f32x4*)md[k])[F.lane + 64 * j], sc = ((const LAS f32x4*)(md[k] + 1024))[F.lane + 64 * j];
                const f32x4 y = (v[k][j] * rstd * gg) * (1.0f + sc) + sh; o8[64 * j] = (v2u){pk2(y.x, y.y), pk2(y.z, y.w)}; } }
    }
}

struct DenseOrder {
    int nM, nN, nwg, G, c; bool skipctx; const char* A; const char* Bt; size_t a_tile, b_tile; int ncap = 1 << 30;
    __device__ __forceinline__ bool next(int i, pg8::Unit& u) const {
        const long L = (long)i * G + c; if (L >= nwg || L >= ncap) return false;
        int wgid = (int)L; { const int q = nwg / pg8::NXCD, r = nwg % pg8::NXCD, xcd = wgid % pg8::NXCD, off = wgid / pg8::NXCD; wgid = (xcd < r ? xcd * (q + 1) : r * (q + 1) + (xcd - r) * q) + off; }
        const int nig = pg8::WGM * nN, gid = wgid / nig, fm = gid * pg8::WGM, gsz = (nM - fm) < pg8::WGM ? (nM - fm) : pg8::WGM;
        const int pmq = fm + ((wgid % nig) % gsz), pn = (wgid % nig) / gsz;
        const int pm = skipctx ? (pmq >> 4) * 17 + (pmq & 15) : pmq;
        u.pm = pm; u.pn = pn; u.aux = 0; u.gl = nullptr; u.gn = 0; u.a = A + (size_t)pm * a_tile; u.b = Bt + (size_t)pn * b_tile; return true;
    }
};
struct DenseTail {
    DenseOrder D; int ntail;
    __device__ __forceinline__ bool next(int i, pg8::Unit& u) const {
        const int t = i * D.G + D.c; if (t >= ntail) return false;
        DenseOrder E = D; E.c = 0; E.G = 1;
        if (!E.next(D.nwg - (ntail >> 1) + (t >> 1), u)) return false;
        const int h = t & 1; u.aux = h; u.a += (size_t)h * (D.a_tile >> 1); return true;
    }
};
struct BranchOrder {
    int nM, G, c; bool skipctx; const char* A; const char* Bt;
    __device__ __forceinline__ bool next(int i, pg8::Unit& u) const {
        const int tl = (i / 3) * G + c, br = i % 3; if (tl >= nM * 4) return false;
        const int pmq = tl >> 2, pn = tl & 3, pm = skipctx ? (pmq >> 4) * 17 + (pmq & 15) : pmq;
        u.pm = pm; u.pn = pn; u.aux = br; u.gl = nullptr; u.gn = 0; u.a = A + (size_t)pm * 256 * OW * 2 + (size_t)br * 512 * 2; u.b = Bt + (size_t)br * 1024 * 512 * 2 + (size_t)pn * 256 * 512 * 2; return true;
    }
};
struct MoeOrder {
    int ntiles, ncol, G, c; const LAS int* tile_e; const LAS int* eoff; const unsigned* ecnt; const int* list; const char* A; size_t a_tile; const char* Bt; size_t e_stride, b_tile;
    __device__ __forceinline__ bool next(int i, pg8::Unit& u) const {
        int L = i * G + c; const int nwg = ntiles * ncol; if (L >= nwg) return false;
        { const int q = nwg / pg8::NXCD, r = nwg % pg8::NXCD, xcd = L % pg8::NXCD, off = L / pg8::NXCD; L = (xcd < r ? xcd * (q + 1) : r * (q + 1) + (xcd - r) * q) + off; }
        const int rt = L / ncol, pn = L % ncol;
        const int e = __builtin_amdgcn_readfirstlane(tile_e[rt]);
        u.pm = rt; u.pn = pn; u.aux = e; u.a = A + (size_t)rt * a_tile; u.b = Bt + (size_t)e * e_stride + (size_t)pn * b_tile;
        if (list) { const int rank0 = rt * 256 - __builtin_amdgcn_readfirstlane(eoff[e]); u.gl = list + (size_t)e * LIST_CAP + rank0; u.gn = __builtin_amdgcn_readfirstlane(eoff[400 + e]) - rank0; } else { u.gl = nullptr; u.gn = 0; }
        return true;
    }
};

struct EpiInproj {
    static constexpr bool PERM = true, HOOK = false;
    static constexpr int NAI = 2;
    bf16* P; float* GT; const float* bml; bf16* SG; const float* bmerge; const float* gq; const f32x2* rope; LAS float* ssq; const LAS unsigned* ropeL;
    __device__ __forceinline__ void operator()(const f32x4 (&acc)[2][2][4][2], const pg8::Unit& u, int wr, int wc, int fr, int fq) const {
        const int row0 = u.pm * 256 + wr * 64 + fr;
        if (u.pn < 7) {
            int typ[2];
#pragma unroll
            for (int bj = 0; bj < 2; ++bj) { const int col = u.pn * 256 + bj * 128; typ[bj] = col < 512 ? 0 : col < 640 ? 1 : col < 768 ? -1 : col < 1280 ? 2 : 3; }
            const int ti_ = u.pm % 17; const bool lat_ = ti_ < 16 && u.pn < 3; const int tb_ = ti_ * 256 + wr * 64 + fr;
            f32x4 csA[4][2];
#define H2F_LO(w_) ((float)__builtin_bit_cast(_Float16, (unsigned short)((w_) & 0xffffu)))
#define H2F_HI(w_) ((float)__builtin_bit_cast(_Float16, (unsigned short)((w_) >> 16)))
#define ROPE_LOAD(dst, ai_) do { _Pragma("unroll") for (int m = 0; m < 4; ++m) { if (lat_) { const int t_ = tb_ + (ai_) * 128 + m * 16; const int pos_ = (wc & 1) ? (t_ & 63) : (t_ >> 6);     \
                    const v4u h_ = *(const LAS v4u*)(ropeL + pos_ * 16 + 4 * fq); dst[m][0] = (f32x4){H2F_LO(h_.x), H2F_HI(h_.x), H2F_LO(h_.y), H2F_HI(h_.y)}; dst[m][1] = (f32x4){H2F_LO(h_.z), H2F_HI(h_.z), H2F_LO(h_.w), H2F_HI(h_.w)}; } \
                else { dst[m][0] = (f32x4){1.f, 0.f, 1.f, 0.f}; dst[m][1] = (f32x4){1.f, 0.f, 1.f, 0.f}; } } } while (0)
            ROPE_LOAD(csA, 0);
#pragma unroll
            for (int ai = 0; ai < 2; ++ai)
#pragma unroll
                for (int m = 0; m < 4; ++m)
#pragma unroll
                    for (int bj = 0; bj < 2; ++bj) { const f32x4 v0 = acc[ai][bj][m][0], v1 = acc[ai][bj][m][1];
                        float ss = (v0[0] * v0[0] + v0[1] * v0[1]) + (v0[2] * v0[2] + v0[3] * v0[3]) + (v1[0] * v1[0] + v1[1] * v1[1]) + (v1[2] * v1[2] + v1[3] * v1[3]);
                        { auto r16 = __builtin_amdgcn_permlane16_swap(__float_as_uint(ss), __float_as_uint(ss), false, false); ss = __uint_as_float(r16[0]) + __uint_as_float(r16[1]);
                          auto r32 = __builtin_amdgcn_permlane32_swap(__float_as_uint(ss), __float_as_uint(ss), false, false); ss = __uint_as_float(r32[0]) + __uint_as_float(r32[1]); }
                        if (fq == 0) ssq[((ai * 128 + wr * 64 + m * 16 + fr) * 2 + bj) * 4 + wc] = ss; }
            asm volatile("s_waitcnt lgkmcnt(0)\n\ts_barrier" ::: "memory");
            const int ws = wc & 1;
            f32x4 g0[2], g1[2];
#pragma unroll
            for (int bj = 0; bj < 2; ++bj) { const int ty = typ[bj] < 0 ? 0 : typ[bj]; const float qs = ((typ[bj] & 1) == 0) ? QSCALE : 1.0f;
                g0[bj] = *(const f32x4*)(gq + ty * 64 + 16 * ws + 4 * fq) * qs; g1[bj] = *(const f32x4*)(gq + ty * 64 + 32 + 16 * ws + 4 * fq) * qs; }
#pragma unroll
            for (int ai = 0; ai < 2; ++ai) {
                if (ai == 1) ROPE_LOAD(csA, 1);
#pragma unroll
                for (int m = 0; m < 4; ++m) { const int rowl = ai * 128 + wr * 64 + m * 16 + fr; bf16* rowp = P + (size_t)(row0 + ai * 128 + m * 16) * PW + u.pn * 256 + wc * 32 + 8 * fq;
                    const f32x4 cs0 = csA[m][0], cs1 = csA[m][1];
#pragma unroll
                    for (int bj = 0; bj < 2; ++bj) { f32x4 v0 = acc[ai][bj][m][0], v1 = acc[ai][bj][m][1];
                        if (typ[bj] >= 0) { const float tot = ssq[(rowl * 2 + bj) * 4 + wc] + ssq[(rowl * 2 + bj) * 4 + (wc ^ 1)]; const float rstd = rsq_(tot * (1.0f / 64.0f) + EPS);
                            v0 = v0 * (g0[bj] * rstd); v1 = v1 * (g1[bj] * rstd);
                            if (typ[bj] < 2) { const f32x4 a = v0, b = v1;
                                v0[0] = a[0] * cs0[0] - b[0] * cs0[1]; v1[0] = b[0] * cs0[0] + a[0] * cs0[1]; v0[1] = a[1] * cs0[2] - b[1] * cs0[3]; v1[1] = b[1] * cs0[2] + a[1] * cs0[3];
                                v0[2] = a[2] * cs1[0] - b[2] * cs1[1]; v1[2] = b[2] * cs1[0] + a[2] * cs1[1]; v0[3] = a[3] * cs1[2] - b[3] * cs1[3]; v1[3] = b[3] * cs1[2] + a[3] * cs1[3]; }
                        }
                        v4u w; w.x = pg8::cvt_pk_bf16(v0[0], v0[1]); w.y = pg8::cvt_pk_bf16(v0[2], v0[3]); w.z = pg8::cvt_pk_bf16(v1[0], v1[1]); w.w = pg8::cvt_pk_bf16(v1[2], v1[3]);
                        *(v4u*)(rowp + bj * 128) = w; } }
            }
#undef ROPE_LOAD
#undef H2F_LO
#undef H2F_HI
        } else if (u.pn < 17) {
#pragma unroll
            for (int ai = 0; ai < 2; ++ai)
#pragma unroll
                for (int m = 0; m < 4; ++m) { bf16* rowp = P + (size_t)(row0 + ai * 128 + m * 16) * PW + u.pn * 256 + wc * 32 + 8 * fq;
#pragma unroll
                    for (int bj = 0; bj < 2; ++bj) { const f32x4 v0 = acc[ai][bj][m][0], v1 = acc[ai][bj][m][1];
                        v4u w; w.x = pg8::cvt_pk_bf16(v0[0], v0[1]); w.y = pg8::cvt_pk_bf16(v0[2], v0[3]); w.z = pg8::cvt_pk_bf16(v1[0], v1[1]); w.w = pg8::cvt_pk_bf16(v1[2], v1[3]);
                        *(v4u*)(rowp + bj * 128) = w; } }
        } else if (u.pn == 17) {
            if (wc == 0 && fq < 2) {
                const f32x4 b0 = *(const f32x4*)(bml + 8 * fq), b1 = *(const f32x4*)(bml + 8 * fq + 4);
#pragma unroll
                for (int ai = 0; ai < 2; ++ai)
#pragma unroll
                    for (int m = 0; m < 4; ++m) { float* rowp = GT + (size_t)(row0 + ai * 128 + m * 16) * 16 + 8 * fq;
                        *(f32x4*)(rowp) = acc[ai][0][m][0] + b0; *(f32x4*)(rowp + 4) = acc[ai][0][m][1] + b1; }
            }
        } else {
            const int col0 = (u.pn - 18) * 256 + wc * 32 + 8 * fq;
            f32x4 bv[2][2];
#pragma unroll
            for (int bj = 0; bj < 2; ++bj)
#pragma unroll
                for (int n = 0; n < 2; ++n) bv[bj][n] = *(const f32x4*)(bmerge + col0 + bj * 128 + 4 * n) * (-LOG2E);
            v4u* sgf = (v4u*)SG + ((((size_t)u.pm * 12 + (u.pn - 18)) * 8 + (wr * 4 + wc)) * 16) * 64 + (fq * 16 + fr);
#pragma unroll
            for (int ai = 0; ai < 2; ++ai)
#pragma unroll
                for (int m = 0; m < 4; ++m)
#pragma unroll
                    for (int bj = 0; bj < 2; ++bj) { f32x4 v0, v1;
#pragma unroll
                        for (int i = 0; i < 4; ++i) { v0[i] = 1.0f + __builtin_amdgcn_exp2f(__builtin_fmaf(acc[ai][bj][m][0][i], -LOG2E, bv[bj][0][i])); v1[i] = 1.0f + __builtin_amdgcn_exp2f(__builtin_fmaf(acc[ai][bj][m][1][i], -LOG2E, bv[bj][1][i])); }
                        v4u w; w.x = pg8::cvt_pk_bf16(v0[0], v0[1]); w.y = pg8::cvt_pk_bf16(v0[2], v0[3]); w.z = pg8::cvt_pk_bf16(v1[0], v1[1]); w.w = pg8::cvt_pk_bf16(v1[2], v1[3]);
                        sgf[(ai * 8 + m * 2 + bj) * 64] = w; }
        }
    }
};
template <int NAI_ = 2> struct EpiBranchT {
    static constexpr bool PERM = true, HOOK = true; static constexpr int NAI = NAI_;
    const bf16* SG; bf16* MG;
    __device__ __forceinline__ void mid(f32x4 (&acc)[2][2][4][2], const pg8::Unit& u, int seg, int wr, int wc, int fr, int fq) const {
        const v4u* sgf = (const v4u*)SG + ((((size_t)u.pm * 12 + u.pn) * 8 + (wr * 4 + wc)) * 16) * 64 + (fq * 16 + fr);
#pragma unroll
        for (int ai = 0; ai < NAI; ++ai) { const int ag = ai + u.aux;
            v4u sa[4][2], sb[4][2];
#pragma unroll
            for (int m = 0; m < 4; ++m) {
#pragma unroll
                for (int bj = 0; bj < 2; ++bj) { const v4u* p = sgf + (size_t)(seg * 4) * 8192 + (ag * 8 + m * 2 + bj) * 64; sa[m][bj] = p[0]; sb[m][bj] = p[4 * 8192]; } }
#pragma unroll
            for (int m = 0; m < 4; ++m)
#pragma unroll
                for (int bj = 0; bj < 2; ++bj) { const v4u a = sa[m][bj], b = sb[m][bj]; f32x4& a0 = acc[ai][bj][m][0]; f32x4& a1 = acc[ai][bj][m][1];
                    a0[0] *= bf_lo(b.x) * __builtin_amdgcn_rcpf(bf_lo(a.x)); a0[1] *= bf_hi(b.x) * __builtin_amdgcn_rcpf(bf_hi(a.x)); a0[2] *= bf_lo(b.y) * __builtin_amdgcn_rcpf(bf_lo(a.y)); a0[3] *= bf_hi(b.y) * __builtin_amdgcn_rcpf(bf_hi(a.y));
                    a1[0] *= bf_lo(b.z) * __builtin_amdgcn_rcpf(bf_lo(a.z)); a1[1] *= bf_hi(b.z) * __builtin_amdgcn_rcpf(bf_hi(a.z)); a1[2] *= bf_lo(b.w) * __builtin_amdgcn_rcpf(bf_lo(a.w)); a1[3] *= bf_hi(b.w) * __builtin_amdgcn_rcpf(bf_hi(a.w)); }
        }
    }
    __device__ __forceinline__ void operator()(const f32x4 (&acc)[2][2][4][2], const pg8::Unit& u, int wr, int wc, int fr, int fq) const {
        const int row0 = u.pm * 256 + wr * 64 + fr, col0 = u.pn * 256 + wc * 32 + 8 * fq;
        const v4u* sgf = (const v4u*)SG + ((((size_t)u.pm * 12 + u.pn) * 8 + (wr * 4 + wc)) * 16) * 64 + (fq * 16 + fr);
#pragma unroll
        for (int ai = 0; ai < NAI; ++ai) { const int ag = ai + u.aux;
            v4u sg[4][2];
#pragma unroll
            for (int m = 0; m < 4; ++m) {
#pragma unroll
                for (int bj = 0; bj < 2; ++bj) sg[m][bj] = sgf[(size_t)8 * 8192 + (ag * 8 + m * 2 + bj) * 64]; }
#pragma unroll
            for (int m = 0; m < 4; ++m) { const size_t row = (size_t)(row0 + ag * 128 + m * 16);
#pragma unroll
                for (int bj = 0; bj < 2; ++bj) { const v4u s = sg[m][bj]; const f32x4 a0 = acc[ai][bj][m][0], a1 = acc[ai][bj][m][1];
                    v4u w; w.x = pg8::cvt_pk_bf16(a0[0] * __builtin_amdgcn_rcpf(bf_lo(s.x)), a0[1] * __builtin_amdgcn_rcpf(bf_hi(s.x))); w.y = pg8::cvt_pk_bf16(a0[2] * __builtin_amdgcn_rcpf(bf_lo(s.y)), a0[3] * __builtin_amdgcn_rcpf(bf_hi(s.y)));
                    w.z = pg8::cvt_pk_bf16(a1[0] * __builtin_amdgcn_rcpf(bf_lo(s.z)), a1[1] * __builtin_amdgcn_rcpf(bf_hi(s.z))); w.w = pg8::cvt_pk_bf16(a1[2] * __builtin_amdgcn_rcpf(bf_lo(s.w)), a1[3] * __builtin_amdgcn_rcpf(bf_hi(s.w)));
                    *(v4u*)(MG + row * MGP + col0 + bj * 128) = w; } }
        }
    }
};
using EpiBranch = EpiBranchT<2>;
template <int NAI_ = 2> struct EpiWoutT {
    static constexpr bool PERM = true, HOOK = false; static constexpr int NAI = NAI_;
    bf16* Y;
    __device__ __forceinline__ void operator()(const f32x4 (&acc)[2][2][4][2], const pg8::Unit& u, int wr, int wc, int fr, int fq) const {
        const int row0 = u.pm * 256 + wr * 64 + fr, col0 = u.pn * 256 + wc * 32 + 8 * fq;
#pragma unroll
        for (int ai = 0; ai < NAI; ++ai)
#pragma unroll
            for (int m = 0; m < 4; ++m) { bf16* rowp = Y + (size_t)(row0 + (ai + u.aux) * 128 + m * 16) * DM + col0;
#pragma unroll
                for (int bj = 0; bj < 2; ++bj) { const f32x4 v0 = acc[ai][bj][m][0], v1 = acc[ai][bj][m][1];
                    v4u w; w.x = pg8::cvt_pk_bf16(v0[0], v0[1]); w.y = pg8::cvt_pk_bf16(v0[2], v0[3]); w.z = pg8::cvt_pk_bf16(v1[0], v1[1]); w.w = pg8::cvt_pk_bf16(v1[2], v1[3]);
                    *(v4u*)(rowp + bj * 128) = w; } }
    }
};
using EpiWout = EpiWoutT<2>;
struct EpiMoe1 {
    static constexpr bool PERM = true, HOOK = false;
    static constexpr int NAI = 2;
    bf16* ACT;
    __device__ __forceinline__ void operator()(const f32x4 (&acc)[2][2][4][2], const pg8::Unit& u, int wr, int wc, int fr, int fq) const {
        const int row0 = u.pm * 256 + wr * 64 + fr, col0 = u.pn * 128 + wc * 32 + 8 * fq;
#pragma unroll
        for (int ai = 0; ai < 2; ++ai)
#pragma unroll
            for (int m = 0; m < 4; ++m) { bf16* rowp = ACT + (size_t)(row0 + ai * 128 + m * 16) * DEXP + col0; float r[8];
#pragma unroll
                for (int n = 0; n < 2; ++n)
#pragma unroll
                    for (int i = 0; i < 4; ++i) { const float gt = acc[ai][0][m][n][i], up = acc[ai][1][m][n][i]; r[4 * n + i] = gt * sigmoidf_(gt) * up; }
                v4u w; w.x = pg8::cvt_pk_bf16(r[0], r[1]); w.y = pg8::cvt_pk_bf16(r[2], r[3]); w.z = pg8::cvt_pk_bf16(r[4], r[5]); w.w = pg8::cvt_pk_bf16(r[6], r[7]);
                *(v4u*)rowp = w; }
    }
};
struct EpiMoe2 {
    static constexpr bool PERM = true, HOOK = false;
    static constexpr int NAI = 2;
    bf16* YS;
    __device__ __forceinline__ void operator()(const f32x4 (&acc)[2][2][4][2], const pg8::Unit& u, int wr, int wc, int fr, int fq) const {
        const int row0 = u.pm * 256 + wr * 64 + fr, col0 = u.pn * 256 + wc * 32 + 8 * fq;
#pragma unroll
        for (int ai = 0; ai < 2; ++ai)
#pragma unroll
            for (int m = 0; m < 4; ++m) { bf16* rowp = YS + (size_t)(row0 + ai * 128 + m * 16) * DM + col0;
#pragma unroll
                for (int bj = 0; bj < 2; ++bj) { const f32x4 v0 = acc[ai][bj][m][0], v1 = acc[ai][bj][m][1];
                    v4u w; w.x = pg8::cvt_pk_bf16(v0[0], v0[1]); w.y = pg8::cvt_pk_bf16(v0[2], v0[3]); w.z = pg8::cvt_pk_bf16(v1[0], v1[1]); w.w = pg8::cvt_pk_bf16(v1[2], v1[3]);
                    *(v4u*)(rowp + bj * 128) = w; } }
    }
};

__device__ __forceinline__ void qk_head8(v4u& w, const float* gain, const f32x2* rope  , int lane, float post) {
    float x[8] = {bf_lo(w.x), bf_hi(w.x), bf_lo(w.y), bf_hi(w.y), bf_lo(w.z), bf_hi(w.z), bf_lo(w.w), bf_hi(w.w)};
    float ss = 0.f;
#pragma unroll
    for (int e = 0; e < 8; ++e) ss += x[e] * x[e];
    ss += __shfl_xor(ss, 1); ss += __shfl_xor(ss, 2); ss += __shfl_xor(ss, 4);
    const float rstd = rsq_(ss * (1.0f / 64.0f) + EPS);
    const int j = lane & 7;
#pragma unroll
    for (int e = 0; e < 8; ++e) x[e] = x[e] * rstd * gain[j * 8 + e];
    if (rope) {
#pragma unroll
        for (int e = 0; e < 8; ++e) { const float part = __shfl_xor(x[e], 4); const f32x2 cs = rope[(j & 3) * 8 + e];
            x[e] = (j < 4) ? (x[e] * cs.x - part * cs.y) : (x[e] * cs.x + part * cs.y); }
    }
#pragma unroll
    for (int e = 0; e < 8; ++e) x[e] *= post;
    w.x = pk2(x[0], x[1]); w.y = pk2(x[2], x[3]); w.z = pk2(x[4], x[5]); w.w = pk2(x[6], x[7]);
}
__device__ __forceinline__ void phase_qknorm(Frame& F, const Args& A, int l, bool commit = true, bool dummy = false) {
    bf16* P = (bf16*)(F.ws + WS_P); bf16* DP = dummy ? (bf16*)(F.ws + WS_OUTS) : P; const int dpw = dummy ? 2048 : PW; const float* gq = A.in[I_GQK] + (size_t)l * 4 * 64; const f32x2* ROPE = (const f32x2*)(F.ws + WS_ROPE);
    for (int lr0 = F.gw; lr0 < TG; lr0 += 2 * F.NGW) {
        v4u w[2][4]; bool ok[2];
#pragma unroll
        for (int k = 0; k < 2; ++k) { const int lr = lr0 + k * F.NGW; ok[k] = lr < TG; if (ok[k]) { bf16* prow = P + (size_t)lr * PW;
            w[k][0] = *((v4u*)(prow + C_AQ) + F.lane); w[k][1] = *((v4u*)(prow + C_AK) + (F.lane & 15)); w[k][2] = *((v4u*)(prow + C_BQ) + F.lane); w[k][3] = *((v4u*)(prow + C_BK) + F.lane); } }
#pragma unroll
        for (int k = 0; k < 2; ++k) if (ok[k]) { const int lr = lr0 + k * F.NGW, t = lr % TPS; bf16* prow = DP + (size_t)lr * dpw; const f32x2* rp = (t < NLAT) ? ROPE + (size_t)t * 32 : nullptr;
            qk_head8(w[k][0], gq, rp, F.lane, QSCALE); qk_head8(w[k][1], gq + 64, rp, F.lane, 1.0f); qk_head8(w[k][2], gq + 128, nullptr, F.lane, QSCALE); qk_head8(w[k][3], gq + 192, nullptr, F.lane, 1.0f);
            if (commit) { *((v4u*)(prow + C_AQ) + F.lane) = w[k][0]; if (F.lane < 16) *((v4u*)(prow + C_AK) + F.lane) = w[k][1]; *((v4u*)(prow + C_BQ) + F.lane) = w[k][2]; *((v4u*)(prow + C_BK) + F.lane) = w[k][3]; } }
    }
}

__device__ __forceinline__ void phase_mlstm_finish(Frame& F, const Args& A, int l) {
    const bf16* HD = (const bf16*)(F.ws + WS_HDIR); const bf16* P = (const bf16*)(F.ws + WS_P); bf16* OUTS = (bf16*)(F.ws + WS_OUTS); const float* gm = A.in[I_GML] + (size_t)l * 512 + F.lane * 8;
    const f32x4 g0 = *(const f32x4*)gm, g1 = *(const f32x4*)(gm + 4);
    const float gg[8] = {g0.x, g0.y, g0.z, g0.w, g1.x, g1.y, g1.z, g1.w};
    for (int lr0 = F.gw; lr0 < TG; lr0 += 2 * F.NGW) {
        v4u ra[2], rb[2], ro[2]; bool ok[2];
#pragma unroll
        for (int k = 0; k < 2; ++k) { const int lr = lr0 + k * F.NGW; ok[k] = lr < TG && !(l == DEPTH - 1 && (lr % TPS) >= NLAT); if (ok[k]) {
            ra[k] = *((const v4u*)(HD + (size_t)lr * 512) + F.lane); rb[k] = *((const v4u*)(HD + ((size_t)TG + lr) * 512) + F.lane); ro[k] = *((const v4u*)(P + (size_t)lr * PW + C_CO) + F.lane); } }
#pragma unroll
        for (int k = 0; k < 2; ++k) if (ok[k]) { const int lr = lr0 + k * F.NGW; const v4u a = ra[k], b = rb[k], og = ro[k];
            float h[8] = {bf_lo(a.x) + bf_lo(b.x), bf_hi(a.x) + bf_hi(b.x), bf_lo(a.y) + bf_lo(b.y), bf_hi(a.y) + bf_hi(b.y), bf_lo(a.z) + bf_lo(b.z), bf_hi(a.z) + bf_hi(b.z), bf_lo(a.w) + bf_lo(b.w), bf_hi(a.w) + bf_hi(b.w)};
            const float o[8] = {bf_lo(og.x), bf_hi(og.x), bf_lo(og.y), bf_hi(og.y), bf_lo(og.z), bf_hi(og.z), bf_lo(og.w), bf_hi(og.w)};
            float ss = 0.f;
#pragma unroll
            for (int e = 0; e < 8; ++e) ss += h[e] * h[e];
            ss = row16_sum(ss);
            const float rstd = rsq_(ss * (1.0f / 128.0f) + EPS);
#pragma unroll
            for (int e = 0; e < 8; ++e) h[e] = h[e] * rstd * gg[e] * sigmoidf_(o[e]);
            *((v4u*)(OUTS + (size_t)lr * OW + 1024) + F.lane) = (v4u){pk2(h[0], h[1]), pk2(h[2], h[3]), pk2(h[4], h[5]), pk2(h[6], h[7])}; }
    }
}

__device__ __forceinline__ void phase_norm2_route(Frame& F, const Args& A, int l, int g, bool commit = true) {
    const float* xlat = (l == 0) ? A.in[I_X] : F.out; const float* xctx = (l == 0) ? A.in[I_CTX] : (const float*)(F.ws + WS_XC); bf16* Y = (bf16*)(F.ws + WS_Y);
    const float* MOD = (const float*)(F.ws + WS_MOD); bf16* H = (bf16*)(F.ws + WS_H); unsigned* TOK = (unsigned*)(F.ws + WS_TOK);
    const float* gn = A.in[I_GNORM] + (size_t)(l * 2 + 1) * 1024;
    const bf16* WR = (const bf16*)(F.ws + WS_WR) + (size_t)l * 2 * 48 * 1024;
    unsigned* ecnt = F.ctl + CW_ECNT + 64 * (l * 2 + g); int* LIST = (int*)(F.ws + WS_LIST);
    constexpr int TP2 = 2064;
    LAS unsigned char* THI = F.lds; LAS unsigned char* TLO = F.lds + 16 * TP2;
    LAS float* part = (LAS float*)(F.lds + 66048);
    LAS float* LG = (LAS float*)(F.lds + 90624);
    LAS unsigned* rec = (LAS unsigned*)(F.lds + 93696);
    LAS unsigned* blkcnt = (LAS unsigned*)(F.lds + 98304); LAS unsigned* blkbase = blkcnt + 32;
    const int w = F.wave, fr = F.lane & 15, fq = F.lane >> 4;
    const int g_lo = ((int)blockIdx.x * (TG / 16)) / F.G, g_hi = (((int)blockIdx.x + 1) * (TG / 16)) / F.G;
    LAS float* MDL = (LAS float*)(F.lds + 102400);
    LAS float* GNL = (LAS float*)(F.lds + 102400 + 24576);
    int md_bl = -1;
    bf16x8 bh[4][3], bo[4][3];
#pragma unroll
    for (int ks = 0; ks < 4; ++ks)
#pragma unroll
        for (int nt = 0; nt < 3; ++nt) { const bf16* p = WR + (size_t)(16 * nt + fr) * 1024 + 128 * w + 32 * ks + 8 * fq; bh[ks][nt] = *(const bf16x8*)p; bo[ks][nt] = *(const bf16x8*)(p + 48 * 1024); }
    if (F.tid < 32) blkcnt[F.tid] = 0u;
    for (int i = F.tid; i < 1024; i += 512) GNL[i] = gn[i];
    for (int i = F.tid; i < 3072; i += 512) MDL[3072 + i] = MOD[((size_t)l * 17 + 16) * 6144 + 2048 + i];
    __syncthreads();
    f32x4 xv[2][4]; v2u yv[2][4];
#define RT_LOAD(gi_) do { const int lr0_ = (gi_) * 16; if ((gi_) < g_hi && !(l == DEPTH - 1 && (lr0_ % TPS) >= NLAT)) { _Pragma("unroll") for (int rr = 0; rr < 2; ++rr) { \
        const int lr_ = lr0_ + 2 * w + rr, bl_ = lr_ / TPS, t_ = lr_ % TPS, b_ = g * GBS + bl_; \
        const float* src_ = (t_ < NLAT) ? xlat + ((size_t)b_ * NLAT + t_) * DM : xctx + ((size_t)b_ * NCTX + (t_ - NLAT)) * DM; \
        _Pragma("unroll") for (int j = 0; j < 4; ++j) { xv[rr][j] = ((const f32x4*)src_)[F.lane + 64 * j]; yv[rr][j] = ((const v2u*)(Y + (size_t)lr_ * DM))[F.lane + 64 * j]; } } } } while (0)
    float rbias0, rbias1;
    { const int n0_ = F.tid % 48, n1_ = (F.tid + 512) % 48;
      rbias0 = (n0_ < 4) ? A.in[I_BGROUP][l * 4 + n0_] : (n0_ < 36) ? A.in[I_BROUTER][l * 32 + n0_ - 4] : 0.f;
      rbias1 = (n1_ < 4) ? A.in[I_BGROUP][l * 4 + n1_] : (n1_ < 36) ? A.in[I_BROUTER][l * 32 + n1_ - 4] : 0.f; }
    RT_LOAD(g_lo);
    int it = 0;
    for (int gi = g_lo; gi < g_hi; ++gi, ++it) {
        const int lr0 = gi * 16; const bool valid = !(l == DEPTH - 1 && (lr0 % TPS) >= NLAT);
        if (lr0 / TPS != md_bl) { md_bl = lr0 / TPS; __syncthreads();
            for (int i = F.tid; i < 3072; i += 512) MDL[i] = MOD[((size_t)l * 17 + g * GBS + md_bl) * 6144 + 2048 + i];
            __syncthreads(); }
        if (valid) {
#pragma unroll
            for (int rr = 0; rr < 2; ++rr) {
                const int r = 2 * w + rr, lr = lr0 + r, bl = lr / TPS, t = lr % TPS, b = g * GBS + bl;
                const LAS float* md = MDL + ((t < NLAT) ? 0 : 3072); (void)b;
                f32x4 v[4]; float s = 0.f;
#pragma unroll
                for (int j = 0; j < 4; ++j) { const v2u yy = yv[rr][j]; const f32x4 g1 = ((const LAS f32x4*)md)[F.lane + 64 * j]; v[j] = xv[rr][j];
                    v[j].x += g1.x * bf_lo(yy.x); v[j].y += g1.y * bf_hi(yy.x); v[j].z += g1.z * bf_lo(yy.y); v[j].w += g1.w * bf_hi(yy.y);
                    s += (v[j].x * v[j].x + v[j].y * v[j].y) + (v[j].z * v[j].z + v[j].w * v[j].w); }
                const float rstd = rsq_(wave_sum(s) * (1.0f / DM) + EPS);
                v2u* o8 = (v2u*)(H + (size_t)lr * DM) + F.lane;
                if (commit) { v2u* y8 = (v2u*)(Y + (size_t)lr * DM) + F.lane;
#pragma unroll
                    for (int j = 0; j < 4; ++j) y8[64 * j] = (v2u){pk2(v[j].x, v[j].y), pk2(v[j].z, v[j].w)}; }
#pragma unroll
                for (int j = 0; j < 4; ++j) { const f32x4 gg = ((const LAS f32x4*)GNL)[F.lane + 64 * j], sh = ((const LAS f32x4*)(md + 1024))[F.lane + 64 * j], sc = ((const LAS f32x4*)(md + 2048))[F.lane + 64 * j];
                    const f32x4 y = (v[j] * rstd * gg) * (1.0f + sc) + sh;
                    const unsigned h0 = pk2(y.x, y.y), h1 = pk2(y.z, y.w);
                    const unsigned l0 = pk2(y.x - bf_lo(h0), y.y - bf_hi(h0)), l1 = pk2(y.z - bf_lo(h1), y.w - bf_hi(h1));
                    o8[64 * j] = (v2u){h0, h1};
                    *(LAS v2u*)(THI + r * TP2 + (64 * j + F.lane) * 8) = (v2u){h0, h1}; *(LAS v2u*)(TLO + r * TP2 + (64 * j + F.lane) * 8) = (v2u){l0, l1}; }
            }
        }
        RT_LOAD(gi + 1);
        LDS_BARRIER();
        if (valid) {
            f32x4 acc[3];
#pragma unroll
            for (int nt = 0; nt < 3; ++nt) acc[nt] = (f32x4){0.f, 0.f, 0.f, 0.f};
#pragma unroll
            for (int ks = 0; ks < 4; ++ks) { const bf16x8 ah = *(const LAS bf16x8*)(THI + fr * TP2 + (128 * w + 32 * ks + 8 * fq) * 2), al = *(const LAS bf16x8*)(TLO + fr * TP2 + (128 * w + 32 * ks + 8 * fq) * 2);
#pragma unroll
                for (int nt = 0; nt < 3; ++nt) { acc[nt] = __builtin_amdgcn_mfma_f32_16x16x32_bf16(ah, bh[ks][nt], acc[nt], 0, 0, 0); acc[nt] = __builtin_amdgcn_mfma_f32_16x16x32_bf16(ah, bo[ks][nt], acc[nt], 0, 0, 0);
                    acc[nt] = __builtin_amdgcn_mfma_f32_16x16x32_bf16(al, bh[ks][nt], acc[nt], 0, 0, 0); } }
#pragma unroll
            for (int nt = 0; nt < 3; ++nt)
#pragma unroll
                for (int i = 0; i < 4; ++i) part[(w * 16 + 4 * fq + i) * 48 + 16 * nt + fr] = acc[nt][i];
        }
        LDS_BARRIER();
        if (valid) for (int idx = F.tid; idx < 768; idx += 512) { const int row = idx / 48, n = idx % 48; float s = 0.f;
#pragma unroll
            for (int w8 = 0; w8 < 8; ++w8) s += part[(w8 * 16 + row) * 48 + n];
            LG[idx] = s + ((idx < 512) ? rbias0 : rbias1); }
        LDS_BARRIER();
        if (F.tid < 16) {
            const int li = it * 16 + F.tid;
            if (!valid) rec[li * 8] = 0xffffffffu;
            else {
                const LAS float* lg = LG + F.tid * 48;
                int gs = 0; float gm = lg[0];
#pragma unroll
                for (int o = 1; o < 4; ++o) if (lg[o] > gm) { gm = lg[o]; gs = o; }
                float gden = 0.f;
#pragma unroll
                for (int o = 0; o < 4; ++o) gden += expf(lg[o] - gm);
                const float pgs = 1.0f / gden;
                const LAS float* ls = lg + 4 + gs * 8;
                int i0 = 0; float m0 = ls[0];
#pragma unroll
                for (int k = 1; k < 8; ++k) if (ls[k] > m0) { m0 = ls[k]; i0 = k; }
                int i1 = -1; float m1 = -INFINITY;
#pragma unroll
                for (int k = 0; k < 8; ++k) if (k != i0 && ls[k] > m1) { m1 = ls[k]; i1 = k; }
                const float ed = expf(m1 - m0); const float w0 = pgs / (1.0f + ed), w1 = pgs * ed / (1.0f + ed);
                const unsigned e0 = gs * 8 + i0, e1 = gs * 8 + i1;
                const unsigned r0 = atomicAdd((unsigned*)(blkcnt + e0), 1u), r1 = atomicAdd((unsigned*)(blkcnt + e1), 1u);
                rec[li * 8 + 0] = e0; rec[li * 8 + 1] = r0; rec[li * 8 + 2] = e1; rec[li * 8 + 3] = r1; rec[li * 8 + 4] = __float_as_uint(w0); rec[li * 8 + 5] = __float_as_uint(w1);
            }
        }
    }
#undef RT_LOAD
    __syncthreads();
    if (F.tid < 32) { const unsigned n = blkcnt[F.tid]; blkbase[F.tid] = (n && commit) ? __hip_atomic_fetch_add(ecnt + F.tid, n, RLX_AGENT) : 0u; }
    __syncthreads();
    for (int li = F.tid; li < it * 16; li += 512) { const int lr = (g_lo + (li >> 4)) * 16 + (li & 15);
        const unsigned e0 = rec[li * 8 + 0]; if (e0 == 0xffffffffu) continue;
        const unsigned e1 = rec[li * 8 + 2];
        v4u a; a.x = e0; a.y = blkbase[e0] + rec[li * 8 + 1]; a.z = e1; a.w = blkbase[e1] + rec[li * 8 + 3];
        v4u bb; bb.x = rec[li * 8 + 4]; bb.y = rec[li * 8 + 5]; bb.z = 0u; bb.w = 0u;
        if (commit) { *(v4u*)(TOK + (size_t)lr * 8) = a; *(v4u*)(TOK + (size_t)lr * 8 + 4) = bb; LIST[(size_t)e0 * LIST_CAP + a.y] = lr; LIST[(size_t)e1 * LIST_CAP + a.w] = lr; } }
    __syncthreads();
}

__device__ __forceinline__ void moe_tables(Frame& F, const Args& A, int l, int g, LAS int* eoff, LAS int* tile_e) {
    const unsigned* ecnt = F.ctl + CW_ECNT + 64 * (l * 2 + g);
    __syncthreads();
    if (F.tid < 32) eoff[400 + F.tid] = (int)__hip_atomic_load(ecnt + F.tid, RLX_AGENT);
    __syncthreads();
    if (F.tid < 33) { int off = 0; for (int e = 0; e < F.tid; ++e) off += (eoff[400 + e] + 255) & ~255; eoff[F.tid] = off; }
    __syncthreads();
    for (int rt = F.tid; rt < XS_ROWS / 256; rt += 512) { int e = 31; for (int k = 31; k >= 0; --k) if (rt * 256 < eoff[k + 1]) e = k; tile_e[rt] = e; }
    __syncthreads();
}
__device__ __forceinline__ void phase_moe_combine(Frame& F, const Args& A, int l, int g, bool commit = true, bool next_norm = false) {
    const float* xlat_s = (l == 0) ? A.in[I_X] : F.out; const float* xctx_s = (l == 0) ? A.in[I_CTX] : (const float*)(F.ws + WS_XC);
    float* xlat = F.out; float* xctx = (float*)(F.ws + WS_XC); const float* MOD = (const float*)(F.ws + WS_MOD);
    const bf16* YS = (const bf16*)(F.ws + WS_YS); const bf16* Y = (const bf16*)(F.ws + WS_Y); const unsigned* TOK = (const unsigned*)(F.ws + WS_TOK);
    bf16* H = (bf16*)(F.ws + WS_H); const float* gn1 = A.in[I_GNORM] + (size_t)((l + 1 < DEPTH ? l + 1 : l) * 2 + 0) * 1024;
    LAS int* eoff = (LAS int*)(F.lds + LDSX_OFF); LAS int* tile_e = eoff + 64; if (MK_PER_PHASE) moe_tables(F, A, l, g, eoff, tile_e); else __syncthreads();
    int bl, r_lo, r_hi; row_range(F, bl, r_lo, r_hi);
    LAS float* MDL = (LAS float*)F.lds;
    LAS float* GNL = MDL + 8192;
    for (int i = F.tid; i < 1024; i += 512) {
#pragma unroll
        for (int sl = 0; sl < 2; ++sl) { const float* mr = MOD + ((size_t)l * 17 + (sl ? 16 : g * GBS + bl)) * 6144; LAS float* d = MDL + sl * 4096;
            d[i] = mr[2048 + i]; d[1024 + i] = mr[5120 + i]; d[2048 + i] = next_norm ? mr[17 * 6144 + i] : 0.f; d[3072 + i] = next_norm ? mr[17 * 6144 + 1024 + i] : 0.f; }
        GNL[i] = gn1[i]; }
    __syncthreads();
    for (int lr0 = r_lo + F.wave; lr0 < r_hi; lr0 += 16) {
        v4u bb[2]; v4u ta[2]; bool ok[2]; size_t ro[2]; bool lat[2]; const LAS float* md[2];
#pragma unroll
        for (int k = 0; k < 2; ++k) { const int lr = lr0 + 8 * k; const int t = lr - bl * TPS, b = g * GBS + bl; ok[k] = lr < r_hi && !(l == DEPTH - 1 && t >= NLAT); lat[k] = t < NLAT;
            ro[k] = lat[k] ? ((size_t)b * NLAT + t) * DM : ((size_t)b * NCTX + (t - NLAT)) * DM; md[k] = MDL + (lat[k] ? 0 : 4096);
            if (ok[k]) { ta[k] = *(const v4u*)(TOK + (size_t)lr * 8); bb[k] = *(const v4u*)(TOK + (size_t)lr * 8 + 4); } }
        v2u ya[2][4], yc[2][4], yy[2][4]; f32x4 xv[2][4];
#pragma unroll
        for (int k = 0; k < 2; ++k) if (ok[k]) { const int lr = lr0 + 8 * k;
            const unsigned p0 = (unsigned)eoff[ta[k].x] + ta[k].y, p1 = (unsigned)eoff[ta[k].z] + ta[k].w;
            const v2u* y0 = (const v2u*)(YS + (size_t)p0 * DM) + F.lane; const v2u* y1 = (const v2u*)(YS + (size_t)p1 * DM) + F.lane; const v2u* yp = (const v2u*)(Y + (size_t)lr * DM) + F.lane;
#pragma unroll
            for (int j = 0; j < 4; ++j) { ya[k][j] = y0[64 * j]; yc[k][j] = y1[64 * j]; yy[k][j] = yp[64 * j]; } }
#pragma unroll
        for (int k = 0; k < 2; ++k) if (ok[k]) { const float w0 = __uint_as_float(bb[k].x), w1 = __uint_as_float(bb[k].y); f32x4* xo = (f32x4*)((lat[k] ? xlat : xctx) + ro[k]) + F.lane;
#pragma unroll
            for (int j = 0; j < 4; ++j) { const v2u a = ya[k][j], c = yc[k][j], y = yy[k][j]; const f32x4 g2 = ((const LAS f32x4*)(md[k] + 1024))[F.lane + 64 * j]; f32x4 x = (f32x4){bf_lo(y.x), bf_hi(y.x), bf_lo(y.y), bf_hi(y.y)};
                x.x += g2.x * (w0 * bf_lo(a.x) + w1 * bf_lo(c.x)); x.y += g2.y * (w0 * bf_hi(a.x) + w1 * bf_hi(c.x));
                x.z += g2.z * (w0 * bf_lo(a.y) + w1 * bf_lo(c.y)); x.w += g2.w * (w0 * bf_hi(a.y) + w1 * bf_hi(c.y)); if (commit) xo[64 * j] = x; xv[k][j] = x; }
            if (next_norm) {
                const int lr = lr0 + 8 * k; float s = 0.f;
#pragma unroll
                for (int j = 0; j < 4; ++j) s += (xv[k][j].x * xv[k][j].x + xv[k][j].y * xv[k][j].y) + (xv[k][j].z * xv[k][j].z + xv[k][j].w * xv[k][j].w);
                const float rstd = rsq_(wave_sum(s) * (1.0f / DM) + EPS); const LAS float* mdn = md[k] + 2048;
                v2u* o8 = (v2u*)(H + (size_t)lr * DM) + F.lane;
#pragma unroll
                for (int j = 0; j < 4; ++j) { const f32x4 gg = ((const LAS f32x4*)GNL)[F.lane + 64 * j], sh = ((const LAS f32x4*)mdn)[F.lane + 64 * j], sc = ((const LAS f32x4*)(mdn + 1024))[F.lane + 64 * j];
                    const f32x4 yv = (xv[k][j] * rstd * gg) * (1.0f + sc) + sh; o8[64 * j] = (v2u){pk2(yv.x, yv.y), pk2(yv.z, yv.w)}; } } }
    }
}
namespace ml {
constexpr int QS_OFF = 0, QP = 272;
constexpr int KS_OFF = 17408;
constexpr int KG_OFF = 34816, KGP = 320;
constexpr int VS_OFF = 55296, VSP = 320;
constexpr int SS_OFF = 75776, TP = 144;
constexpr int CT_OFF = 84992;
constexpr int HS_OFF = 119808, HP = 272;
constexpr int NV_OFF = 137216;
constexpr int GA_OFF = 137728, GA_SZ = 1536;
constexpr int DQ_OFF = GA_OFF + 2 * GA_SZ;
constexpr int NVB_OFF = DQ_OFF + 256;
constexpr int GTS_OFF = NVB_OFF + 256;
static_assert(GTS_OFF + 4096 <= LDSCTL_OFF, "mLSTM LDS map");
constexpr int NCHUNK = TPS / 64;
constexpr float KSCALE = 0.08838834764831845f;
__device__ __forceinline__ int crow(int r, int hi) { return (r & 3) + 8 * (r >> 2) + 4 * hi; }
__device__ __forceinline__ f32x16 mfma32(bf16x8 a, bf16x8 b, f32x16 c) { return __builtin_amdgcn_mfma_f32_32x32x16_bf16(a, b, c, 0, 0, 0); }
__device__ __forceinline__ int tokrow(int p, int dir) { return dir == 0 ? (p < NCTX ? NLAT + p : p - NCTX) : (p < NCTX ? NLAT + NCTX - 1 - p : TPS - 1 - p); }
typedef short s16x4_ __attribute__((ext_vector_type(4)));
__device__ __forceinline__ bf16x8 trfrag(const LAS unsigned char* p, int koff, int pitch) {
    const s16x4_ lo = __builtin_bit_cast(s16x4_, __builtin_amdgcn_ds_read_tr16_b64_v4i16((LAS s16x4_*)(p + koff)));
    const s16x4_ hi = __builtin_bit_cast(s16x4_, __builtin_amdgcn_ds_read_tr16_b64_v4i16((LAS s16x4_*)(p + koff + 8 * pitch)));
    return (bf16x8){lo[0], lo[1], lo[2], lo[3], hi[0], hi[1], hi[2], hi[3]};
}
__device__ __forceinline__ bf16x8 rowfrag_perm(const LAS unsigned char* p, int ks) {
    const s16x4_ lo = *(const LAS s16x4_*)(p + 32 * ks), hi = *(const LAS s16x4_*)(p + 32 * ks + 16);
    return (bf16x8){lo[0], lo[1], lo[2], lo[3], hi[0], hi[1], hi[2], hi[3]};
}
}
struct MlRegs { v4u q0, q1, k0, k1, v0, v1; f32x4 g4; };
struct MlCtx { LAS unsigned char* L; const bf16* P; const float* GT; bf16* HD; int h, dir, tid, lane, w, r32, hi; };
__device__ __forceinline__ void ml_load(const MlCtx& c, MlRegs& r, int j) {
    using namespace ml;
    const int jj = j;
    const int s0 = c.tid >> 4, ch = c.tid & 15;
    const bf16* p0 = c.P + (size_t)tokrow(jj * 64 + s0, c.dir) * PW + c.h * 128 + ch * 8;
    const bf16* p1 = c.P + (size_t)tokrow(jj * 64 + s0 + 32, c.dir) * PW + c.h * 128 + ch * 8;
    r.q0 = *(const v4u*)(p0 + C_CQ); r.q1 = *(const v4u*)(p1 + C_CQ); r.k0 = *(const v4u*)(p0 + C_CK); r.k1 = *(const v4u*)(p1 + C_CK);
    r.v0 = *(const v4u*)(p0 + C_CV); r.v1 = *(const v4u*)(p1 + C_CV);
    const int rlo = c.dir == 0 ? tokrow(jj * 64, 0) : tokrow(jj * 64 + 63, 1);
    r.g4 = *(const f32x4*)(c.GT + (size_t)rlo * 16 + (c.tid & 255) * 4);
}
__device__ __forceinline__ void ml_scan(const MlCtx& c, int gb, float& m_carry) {
    using namespace ml;
    LAS float* ga = (LAS float*)(c.L + GA_OFF + gb * GA_SZ); const int lane = c.lane;
    const LAS float* gt = (const LAS float*)(c.L + GTS_OFF) + (c.dir == 0 ? lane : 63 - lane) * 16 + c.dir * 8 + c.h;
    const float rig = gt[0], rfp = gt[4];
    const float lf = fminf(rfp, 0.f) - __logf(1.0f + __expf(-fabsf(rfp)));
    const float b = wave_scan_add(lf);
    const float u = rig - b; const float pm = wave_scan_max(u);
    const float Mt = fmaxf(m_carry, pm); const float bend = lane63(b), M63 = lane63(Mt);
    ga[lane] = u; ga[64 + lane] = Mt; ga[128 + lane] = __expf(m_carry - Mt); ga[192 + lane] = __expf(-(b + Mt)); ga[256 + lane] = __expf(u - M63) * KSCALE;
    if (lane == 0) ga[320] = __expf(m_carry - M63);
    m_carry = bend + M63;
}
__device__ __forceinline__ void ml_stage_gates(const MlCtx& c, const MlRegs& r) { if (c.tid < 256) *(LAS f32x4*)(c.L + ml::GTS_OFF + c.tid * 16) = r.g4; }
__device__ __forceinline__ void ml_stage_qk(const MlCtx& c, const MlRegs& r) {
    using namespace ml;
    LAS unsigned char* L = c.L; const int s0 = c.tid >> 4, ch = c.tid & 15;
    *(LAS v4u*)(L + QS_OFF + s0 * QP + ch * 16) = r.q0; *(LAS v4u*)(L + QS_OFF + (s0 + 32) * QP + ch * 16) = r.q1;
    *(LAS v4u*)(L + KS_OFF + s0 * QP + ch * 16) = r.k0; *(LAS v4u*)(L + KS_OFF + (s0 + 32) * QP + ch * 16) = r.k1;
}
__device__ __forceinline__ void ml_stage_kgvs(const MlCtx& c, const MlRegs& r, int gb) {
    using namespace ml;
    LAS unsigned char* L = c.L; const int s0 = c.tid >> 4, ch = c.tid & 15;
    const LAS float* gsp = (const LAS float*)(L + GA_OFF + gb * GA_SZ) + 256;
    const float gs0 = gsp[s0], gs1 = gsp[s0 + 32];
    v4u g0, g1;
    g0.x = pk2(bf_lo(r.k0.x) * gs0, bf_hi(r.k0.x) * gs0); g0.y = pk2(bf_lo(r.k0.y) * gs0, bf_hi(r.k0.y) * gs0); g0.z = pk2(bf_lo(r.k0.z) * gs0, bf_hi(r.k0.z) * gs0); g0.w = pk2(bf_lo(r.k0.w) * gs0, bf_hi(r.k0.w) * gs0);
    g1.x = pk2(bf_lo(r.k1.x) * gs1, bf_hi(r.k1.x) * gs1); g1.y = pk2(bf_lo(r.k1.y) * gs1, bf_hi(r.k1.y) * gs1); g1.z = pk2(bf_lo(r.k1.z) * gs1, bf_hi(r.k1.z) * gs1); g1.w = pk2(bf_lo(r.k1.w) * gs1, bf_hi(r.k1.w) * gs1);
    *(LAS v4u*)(L + KG_OFF + s0 * KGP + ch * 16) = g0; *(LAS v4u*)(L + KG_OFF + (s0 + 32) * KGP + ch * 16) = g1;
    *(LAS v4u*)(L + VS_OFF + s0 * VSP + ch * 16) = r.v0; *(LAS v4u*)(L + VS_OFF + (s0 + 32) * VSP + ch * 16) = r.v1;
}
__device__ __forceinline__ void ml_step(const MlCtx& c, int j, MlRegs& rl, const MlRegs& rs, f32x16& cacc0, f32x16& cacc1, float& m_carry) {
    using namespace ml;
    int tid = c.tid; asm volatile("" : "+v"(tid));
    LAS unsigned char* L = c.L; const int lane = tid & 63, w = c.w, r32 = lane & 31, hi = lane >> 5;
    const int gb = j & 1; const int hstep = c.dir ? -1 : 1;
    LAS float* ga = (LAS float*)(L + GA_OFF + gb * GA_SZ);
    unsigned one2 = 0x3F803F80u; asm volatile("" : "+v"(one2));
    const bf16x8 ones = __builtin_bit_cast(bf16x8, (v4u){one2, one2, one2, one2});
    ml_stage_kgvs(c, rl, gb);
    ml_load(c, rl, (j + 2 < NCHUNK) ? j + 2 : NCHUNK - 1);
    f32x16 hacc0, hacc1;
    ml_stage_gates(c, rs);
    if (j > 0) { const int hp0 = tokrow((j - 1) * 64, c.dir); const int t = tid >> 4, ch = tid & 15;
        const v4u hv0 = *(const LAS v4u*)(L + HS_OFF + t * HP + ch * 16), hv1 = *(const LAS v4u*)(L + HS_OFF + (t + 32) * HP + ch * 16);
        *(v4u*)(c.HD + (size_t)(hp0 + hstep * t) * 512 + ch * 8) = hv0; *(v4u*)(c.HD + (size_t)(hp0 + hstep * (t + 32)) * 512 + ch * 8) = hv1; }
    if (w < 4) {
        const int tb = w >> 1, dbp = w & 1;
#pragma unroll
        for (int r = 0; r < 16; ++r) { hacc0[r] = 0.f; hacc1[r] = 0.f; }
        bf16x8 fa[8], fb[8];
#pragma unroll
        for (int ks = 0; ks < 8; ++ks) { fa[ks] = *(const LAS bf16x8*)(L + QS_OFF + (32 * tb + r32) * QP + (16 * ks + 8 * hi) * 2); fb[ks] = *(const LAS bf16x8*)(L + CT_OFF + (64 * dbp + r32) * QP + (16 * ks + 8 * hi) * 2); }
        __builtin_amdgcn_sched_barrier(0);
#pragma unroll
        for (int ks = 0; ks < 8; ++ks) hacc0 = mfma32(fa[ks], fb[ks], hacc0);
#pragma unroll
        for (int ks = 0; ks < 8; ++ks) fb[ks] = *(const LAS bf16x8*)(L + CT_OFF + (64 * dbp + 32 + r32) * QP + (16 * ks + 8 * hi) * 2);
        __builtin_amdgcn_sched_barrier(0);
#pragma unroll
        for (int ks = 0; ks < 8; ++ks) hacc1 = mfma32(fa[ks], fb[ks], hacc1);
    } else if (w < 7) {
        const int tb = (w == 4) ? 0 : 1, sb = (w == 6) ? 1 : 0;
        f32x16 sacc;
#pragma unroll
        for (int r = 0; r < 16; ++r) sacc[r] = 0.f;
        bf16x8 fa[8], fb[8];
#pragma unroll
        for (int ks = 0; ks < 8; ++ks) { fa[ks] = *(const LAS bf16x8*)(L + QS_OFF + (32 * tb + r32) * QP + (16 * ks + 8 * hi) * 2); fb[ks] = *(const LAS bf16x8*)(L + KS_OFF + (32 * sb + r32) * QP + (16 * ks + 8 * hi) * 2); }
        const int s = 32 * sb + r32; const float us = ga[s];
        f32x4 mtv[4];
#pragma unroll
        for (int gq = 0; gq < 4; ++gq) mtv[gq] = *(const LAS f32x4*)(ga + 64 + 32 * tb + 8 * gq + 4 * hi);
        __builtin_amdgcn_sched_barrier(0);
#pragma unroll
        for (int ks = 0; ks < 8; ++ks) sacc = mfma32(fa[ks], fb[ks], sacc);
#pragma unroll
        for (int gq = 0; gq < 4; ++gq) { const f32x4 mt = mtv[gq];
#pragma unroll
            for (int i = 0; i < 4; ++i) { const int t = 32 * tb + 8 * gq + 4 * hi + i; const float val = (s <= t) ? sacc[4 * gq + i] * KSCALE * __expf(us - mt[i]) : 0.f;
                *(LAS bf16*)(L + SS_OFF + t * TP + s * 2) = (bf16)f2bf(val); } }
    } else {
        {
            const int fr = lane & 15, fq = lane >> 4;
            typedef float f32x4_ __attribute__((ext_vector_type(4)));
            bf16x8 nb[4];
#pragma unroll
            for (int ks = 0; ks < 4; ++ks) nb[ks] = *(const LAS bf16x8*)(L + NVB_OFF + (32 * ks + 8 * fq) * 2);
            bf16x8 qa[4][4];
#pragma unroll
            for (int rb = 0; rb < 4; ++rb)
#pragma unroll
                for (int ks = 0; ks < 4; ++ks) qa[rb][ks] = *(const LAS bf16x8*)(L + QS_OFF + (16 * rb + fr) * QP + (32 * ks + 8 * fq) * 2);
            __builtin_amdgcn_sched_barrier(0);
#pragma unroll
            for (int rb = 0; rb < 4; ++rb) { f32x4_ d = {0.f, 0.f, 0.f, 0.f};
#pragma unroll
                for (int ks = 0; ks < 4; ++ks) d = __builtin_amdgcn_mfma_f32_16x16x32_bf16(qa[rb][ks], nb[ks], d, 0, 0, 0);
                if (fr == 0) *(LAS f32x4_*)(L + DQ_OFF + (16 * rb + 4 * fq) * 4) = d; }
        }
        { const int row = lane >> 1, half = lane & 1; unsigned z = 0u; asm volatile("" : "+v"(z)); *(LAS v4u*)(L + SS_OFF + row * TP + 64 + half * 32) = (v4u){z, z, z, z}; *(LAS v4u*)(L + SS_OFF + row * TP + 64 + half * 32 + 16) = (v4u){z, z, z, z}; }
    }
    LDS_BARRIER();
    const int q4 = (lane & 15) >> 2, p4 = lane & 3, h16 = (lane >> 4) & 1;
    const int dbp = w & 1;
    const LAS unsigned char* vtr_ = L + VS_OFF + (4 * hi + q4) * VSP + (16 * h16 + 4 * p4) * 2 + 128 * dbp;
    if (w < 4) {
        const int tb = w >> 1;
        f32x4 wv[4];
#pragma unroll
        for (int gq = 0; gq < 4; ++gq) { wv[gq] = *(const LAS f32x4*)(ga + 128 + 32 * tb + 8 * gq + 4 * hi);
#pragma unroll
            for (int i = 0; i < 4; ++i) { hacc0[4 * gq + i] *= wv[gq][i]; hacc1[4 * gq + i] *= wv[gq][i]; } }
        f32x16 racc;
#pragma unroll
        for (int r = 0; r < 16; ++r) racc[r] = 0.f;
        const LAS unsigned char* sp = L + SS_OFF + (32 * tb + r32) * TP + 8 * hi;
        bf16x8 fa[4], fb0[4], fb1[4];
#pragma unroll
        for (int ks = 0; ks < 4; ++ks) { fa[ks] = rowfrag_perm(sp, ks); fb0[ks] = trfrag(vtr_, 16 * ks * VSP, VSP); fb1[ks] = trfrag(vtr_, 16 * ks * VSP + 64, VSP); }
        __builtin_amdgcn_sched_barrier(0);
#pragma unroll
        for (int ks = 0; ks < 4; ++ks) { hacc0 = mfma32(fa[ks], fb0[ks], hacc0); hacc1 = mfma32(fa[ks], fb1[ks], hacc1); racc = mfma32(fa[ks], ones, racc); }
#pragma unroll
        for (int gq = 0; gq < 4; ++gq) { const f32x4 dqv = *(const LAS f32x4*)(L + DQ_OFF + (32 * tb + 8 * gq + 4 * hi) * 4), emv = *(const LAS f32x4*)(ga + 192 + 32 * tb + 8 * gq + 4 * hi);
#pragma unroll
            for (int i = 0; i < 4; ++i) { const int t = 32 * tb + 8 * gq + 4 * hi + i; const float den = wv[gq][i] * dqv[i] + racc[4 * gq + i];
                const float inv = __builtin_amdgcn_rcpf(fmaxf(fabsf(den), emv[i]));
                *(LAS bf16*)(L + HS_OFF + t * HP + (64 * dbp + r32) * 2) = (bf16)f2bf(hacc0[4 * gq + i] * inv);
                *(LAS bf16*)(L + HS_OFF + t * HP + (64 * dbp + 32 + r32) * 2) = (bf16)f2bf(hacc1[4 * gq + i] * inv); } }
    }
    {
        const int kb = w >> 1; const float gi = ga[320];
        const LAS unsigned char* ktr_ = L + KG_OFF + (4 * hi + q4) * KGP + (16 * h16 + 4 * p4) * 2;
#pragma unroll
        for (int r = 0; r < 16; ++r) { cacc0[r] *= gi; cacc1[r] *= gi; }
        bf16x8 ca[4], cb0[4], cb1[4];
#pragma unroll
        for (int ks = 0; ks < 4; ++ks) { ca[ks] = trfrag(ktr_, 16 * ks * KGP + 64 * kb, KGP); cb0[ks] = trfrag(vtr_, 16 * ks * VSP, VSP); cb1[ks] = trfrag(vtr_, 16 * ks * VSP + 64, VSP); }
        __builtin_amdgcn_sched_barrier(0);
#pragma unroll
        for (int ks = 0; ks < 4; ++ks) { cacc0 = mfma32(ca[ks], cb0[ks], cacc0); cacc1 = mfma32(ca[ks], cb1[ks], cacc1); }
#pragma unroll
        for (int gq = 0; gq < 4; ++gq) {
            *(LAS v2u*)(L + CT_OFF + (64 * dbp + r32) * QP + (32 * kb + 8 * gq + 4 * hi) * 2) = (v2u){pk2(cacc0[4 * gq], cacc0[4 * gq + 1]), pk2(cacc0[4 * gq + 2], cacc0[4 * gq + 3])};
            *(LAS v2u*)(L + CT_OFF + (64 * dbp + 32 + r32) * QP + (32 * kb + 8 * gq + 4 * hi) * 2) = (v2u){pk2(cacc1[4 * gq], cacc1[4 * gq + 1]), pk2(cacc1[4 * gq + 2], cacc1[4 * gq + 3])}; }
        if (w == 6) {
#pragma unroll
            for (int kb2 = 0; kb2 < 4; ++kb2) { f32x16 nacc; bf16x8 nf[4];
#pragma unroll
                for (int ks = 0; ks < 4; ++ks) nf[ks] = trfrag(ktr_, 16 * ks * KGP + 64 * kb2, KGP);
#pragma unroll
                for (int r = 0; r < 16; ++r) nacc[r] = 0.f;
                __builtin_amdgcn_sched_barrier(0);
#pragma unroll
                for (int ks = 0; ks < 4; ++ks) nacc = mfma32(ones, nf[ks], nacc);
                if (hi == 0) { LAS float* nv = (LAS float*)(L + NV_OFF); const int dk = 32 * kb2 + r32; const float nn = gi * nv[dk] + nacc[0]; nv[dk] = nn; *(LAS bf16*)(L + NVB_OFF + dk * 2) = (bf16)f2bf(nn); } }
        }
        if (w == 7 && j + 1 < NCHUNK) ml_scan(c, gb ^ 1, m_carry);
    }
    if (j + 1 < NCHUNK) ml_stage_qk(c, rs);
    LDS_BARRIER();
}
__device__ __forceinline__ void mlstm_chain(Frame& F, const Args& A, int l, int bl, int h, int dir) {
    using namespace ml;
    MlCtx c; c.L = F.lds; c.tid = F.tid; c.lane = F.lane; c.w = F.wave; c.r32 = F.lane & 31; c.hi = F.lane >> 5; c.h = h; c.dir = dir;
    c.P = (const bf16*)(F.ws + WS_P) + (size_t)bl * TPS * PW;
    c.GT = (const float*)(F.ws + WS_GATES) + (size_t)bl * TPS * 16;
    c.HD = (bf16*)(F.ws + WS_HDIR) + ((size_t)dir * TG + (size_t)bl * TPS) * 512 + h * 128;
    f32x16 cacc0, cacc1;
#pragma unroll
    for (int r = 0; r < 16; ++r) { cacc0[r] = 0.f; cacc1[r] = 0.f; }
    __syncthreads();
    { unsigned z = 0u; asm volatile("" : "+v"(z));
      for (int i = c.tid; i < (128 * QP) / 16; i += 512) *(LAS v4u*)(c.L + CT_OFF + i * 16) = (v4u){z, z, z, z}; }
    if (c.tid < 128) { ((LAS float*)(c.L + NV_OFF))[c.tid] = 0.f; *(LAS bf16*)(c.L + NVB_OFF + c.tid * 2) = (bf16)0; }
    float m_carry = 0.f;
    MlRegs ra, rb;
    ml_load(c, ra, 0); ml_load(c, rb, 1);
    ml_stage_gates(c, ra);
    __syncthreads();
    if (c.w == 7) ml_scan(c, 0, m_carry);
    __syncthreads();
    ml_stage_qk(c, ra);
    __syncthreads();
    for (int j = 0; j < NCHUNK; j += 2) {
        ml_step(c, j, ra, rb, cacc0, cacc1, m_carry);
        ml_step(c, j + 1, rb, ra, cacc0, cacc1, m_carry);
    }
    { const int hp0 = tokrow((NCHUNK - 1) * 64, dir), hstep = dir ? -1 : 1; const int t = c.tid >> 4, ch = c.tid & 15;
      const v4u hv0 = *(const LAS v4u*)(c.L + HS_OFF + t * HP + ch * 16), hv1 = *(const LAS v4u*)(c.L + HS_OFF + (t + 32) * HP + ch * 16);
      *(v4u*)(c.HD + (size_t)(hp0 + hstep * t) * 512 + ch * 8) = hv0; *(v4u*)(c.HD + (size_t)(hp0 + hstep * (t + 32)) * 512 + ch * 8) = hv1; }
    __syncthreads();
}
#define MLPROBE ((DBL_MASK >> 20) & 1)
constexpr int NA_TAB_OFF = 131072, NA_TAB_STRIDE = 2560;
__device__ __forceinline__ void phase_mixers(Frame& F, const Args& A, int l, int g, int r1 = 1, int r2 = 1, int r3 = 1) {
    unsigned* q0 = F.ctl + CW_Q + 64 * ((l * 2 + g) * 4);
    const bf16* P = (const bf16*)(F.ws + WS_P); bf16* OUTS = (bf16*)(F.ws + WS_OUTS);
    char* shm = (char*)(F.lds + RING_OFF);
    const bool ctxq = (l < DEPTH - 1);
    const int nch = GBS * 8, nstat = ((int)F.G > nch) ? (int)F.G - nch : 0;
    for (int rep = 0; rep < r1; ++rep) { for (int i = (int)blockIdx.x; i < nch; i += F.G) mlstm_chain(F, A, l, i >> 3, (i >> 1) & 3, i & 1); }
    const int nU = 1024 + (ctxq ? 128 : 0);
    for (int rep = 0; rep < r2; ++rep) { unsigned* q = q0 + rep * 4096; for (int i = ((int)blockIdx.x >= nch) ? (int)blockIdx.x - nch : dequeue(F, q + 64, 17) + nstat; i < nU; ) {
        const unsigned nxq = dq_issue(F, q + 64);
        const bf16 *Qw, *Kh, *Vh; bf16* Ow; int NT, nA;
        if (i < 1024) { const int g4 = i & 3, qb = (i >> 2) & 15, kvh = (i >> 6) & 1, bl = i >> 7, h = kvh * 4 + g4; const size_t r0 = (size_t)bl * TPS;
            Qw = P + (r0 + qb * 256) * PW + C_AQ + h * 64; Kh = P + r0 * PW + C_AK + kvh * 64; Vh = P + r0 * PW + C_AV + kvh * 64; Ow = OUTS + (r0 + qb * 256) * OW + h * 64; NT = TPS / 64; nA = TPS / 64; }
        else if (i < 1088) { const int jj = i - 1024, h = jj & 7, bl = jj >> 3, kvh = h >> 2; const size_t r0 = (size_t)bl * TPS + NLAT;
            Qw = P + r0 * PW + C_AQ + h * 64; Kh = P + r0 * PW + C_AK + kvh * 64; Vh = P + r0 * PW + C_AV + kvh * 64; Ow = OUTS + r0 * OW + h * 64; NT = 4; nA = 4; }
        else { const int jj = i - 1088, h = jj & 7, bl = jj >> 3; const size_t r0 = (size_t)bl * TPS + NLAT;
            Qw = P + r0 * PW + C_BQ + h * 64; Kh = P + r0 * PW + C_BK + h * 64; Vh = P + r0 * PW + C_BV + h * 64; Ow = OUTS + r0 * OW + 512 + h * 64; NT = 4; nA = 4; }
        attn_body::attn_unit<0, 1000>(Qw, PW, Kh, Vh, PW, NT, nA, 0, Ow, OW, shm, (attn_body::lds_cptr)(F.lds + NA_TAB_OFF + 256), 0, 0);
        i = dq_take(F, nxq, 17) + nstat;
    } }
    int tab_h = -1;
    for (int rep = 0; rep < r3; ++rep) { unsigned* q = q0 + rep * 4096; for (int i = dequeue(F, q + 128, 18); i < 1024; ) {
        const unsigned nxq = dq_issue(F, q + 128);
        const int rg = ((i >> 8) << 2) | (i & 3), h = (i >> 5) & 7, bl = (i >> 2) & 7; const size_t r0 = (size_t)bl * TPS;
        if (h != tab_h) { tab_h = h;
            for (int idx = F.tid; idx < NA_TAB_STRIDE / 4; idx += 512) { const int r = idx - 64, dr = r >> 5, dc = r & 31;
                float v = 0.f; if (r >= 0 && r < 480) v = (dc < 31) ? A.in[I_RPB][((size_t)l * 8 + h) * 15 * 31 + dr * 31 + dc] * LOG2E : -INFINITY;
                ((LAS float*)(F.lds + NA_TAB_OFF))[idx] = v; }
            __syncthreads(); }
        attn_body::na_unit<0>(P + r0 * PW, h, rg, OUTS + r0 * OW, shm, (attn_body::lds_cptr)(F.lds + NA_TAB_OFF + 256));
        i = dq_take(F, nxq, 18);
    } }
}

#ifndef MK_PER_PHASE
#define MK_PER_PHASE 0
#endif
#ifndef PHASE_MASK
#define PHASE_MASK 0xffff
#endif
#define PHM(k) ((PHASE_MASK >> (k)) & 1)
#ifndef DBL_MASK
#define DBL_MASK 0
#endif
#define DBL(k) ((DBL_MASK >> (k)) & 1)
constexpr int NPHASE = 2 + NGRP * DEPTH * 9;
__global__ void __launch_bounds__(512, 2) fwd_kernel(Args A) {
    extern __shared__ __attribute__((aligned(16))) unsigned char lds[];
    Frame F;
    F.lds = (LAS unsigned char*)lds;
    F.MISC = (volatile LAS unsigned*)(F.lds + LDSCTL_OFF);
    F.tid = threadIdx.x; F.lane = F.tid & 63; F.wave = __builtin_amdgcn_readfirstlane(F.tid >> 6);
    F.G = gridDim.x; F.gw = blockIdx.x * 8 + F.wave; F.NGW = F.G * 8;
    F.ws = A.ws; F.ctl = (unsigned*)(A.ws + WS_CTL); F.out = A.out;
    A.in[I_X] = A.in[0]; A.in[I_C] = A.in[1]; A.in[I_CTX] = A.in[2]; A.in[I_CCTX] = A.in[3]; A.in[I_WMOD] = A.in[4]; A.in[I_BMOD] = A.in[5]; A.in[I_GNORM] = A.in[6]; A.in[I_WIN] = A.in[7];
    A.in[I_BMERGE] = A.in[8]; A.in[I_GQK] = A.in[9]; A.in[I_RPB] = A.in[10]; A.in[I_BMLSTM] = A.in[11]; A.in[I_GML] = A.in[12]; A.in[I_WBRANCH] = A.in[13]; A.in[I_WOUT] = A.in[14];
    A.in[I_WGROUP] = A.in[15]; A.in[I_BGROUP] = A.in[16]; A.in[I_WROUTER] = A.in[17]; A.in[I_BROUTER] = A.in[18]; A.in[I_WGU] = A.in[19]; A.in[I_WDN] = A.in[20];
    for (int u = F.tid; u < 128; u += 512) ((LAS unsigned*)(F.lds + LDSCTL_OFF))[u] = 0u;
    __syncthreads();
    XcdBarrier bar; bar.bar = F.ctl + CW_BAR; bar.x = 0; bar.st = nullptr;
    if (!MK_PER_PHASE) bar = xcd_barrier_post(F.ctl + CW_BAR, F.MISC + 8);
    const int lo = A.ph_lo, hi = A.ph_hi; int ph = 0;
#define SEAM() do { if (!MK_PER_PHASE) { if (ph + 1 < hi) { xcd_barrier(bar); if (DBL(19)) xcd_barrier(bar); } } } while (0)
#define ON() (ph >= lo && ph < hi && refresh(F))
    if (PHM(0) && ON()) { p0_prologue(F, A); if (DBL(0)) { __syncthreads(); p0_prologue(F, A); } SEAM(); } ++ph;
    for (int g = 0; g < NGRP; ++g) {
        for (int l = 0; l < DEPTH; ++l) {
            const bool skipctx = (l == DEPTH - 1); const int nMrows = skipctx ? GBS * 16 : RTG;
            if (l == 0 && g == 0) { if (PHM(1) && ON()) { phase_norm1(F, A, l, g); if (DBL(1)) phase_norm1(F, A, l, g); SEAM(); } ++ph; }
            if (PHM(2) && ON()) {
                DenseOrder S{RTG, 30, RTG * 30, F.G, (int)blockIdx.x, false, (const char*)(F.ws + WS_H), (const char*)(F.ws + WS_WIN + l * WIN_L), (size_t)256 * 1024 * 2, (size_t)256 * 1024 * 2};
                EpiInproj E{(bf16*)(F.ws + WS_P), (float*)(F.ws + WS_GATES), A.in[I_BMLSTM] + l * 16, (bf16*)(F.ws + WS_SG), A.in[I_BMERGE] + l * 3072, A.in[I_GQK] + (size_t)l * 256, (const f32x2*)(F.ws + WS_ROPE), (LAS float*)(F.lds + LDSX_OFF), (const LAS unsigned*)(F.lds + LDSX_OFF + 8192)};
                { LAS unsigned* rl = (LAS unsigned*)(F.lds + LDSX_OFF + 8192); const f32x2* rg = (const f32x2*)(F.ws + WS_ROPE);
                  for (int i = F.tid; i < 64 * 16; i += 512) { const f32x2 cs = rg[(size_t)((i >> 4) * 64) * 32 + (i & 15)];
                      rl[i] = (unsigned)__builtin_bit_cast(unsigned short, (_Float16)cs.x) | ((unsigned)__builtin_bit_cast(unsigned short, (_Float16)cs.y) << 16); }
                  __syncthreads(); }
                for (int rep_ = 0; rep_ < 1 + DBL(2); ++rep_) { pg8::gemm_phase<EpiInproj, DenseOrder, true, true>(F.lds + RING_OFF, pg8::Gemm{1024, 1024, 1024}, S, E); }
                SEAM(); } ++ph;
            if (PHM(4) && ON()) { phase_mixers(F, A, l, g, 1 + DBL(16), 1 + DBL(17), 1 + DBL(18)); SEAM(); } ++ph;
            if (PHM(5) && ON()) { phase_mlstm_finish(F, A, l); if (DBL(5)) phase_mlstm_finish(F, A, l); SEAM(); } ++ph;
            const int nUd = nMrows * 4, remd = nUd % F.G, ntaild = (remd > 0 && 2 * remd <= F.G) ? 2 * remd : 0, ncapd = ntaild ? nUd - remd : (1 << 30);
            if (PHM(7) && ON()) {
                DenseOrder S{nMrows, 4, nMrows * 4, F.G, (int)blockIdx.x, skipctx, (const char*)(F.ws + WS_OUTS), (const char*)(F.ws + WS_WBR + l * WBR_L), (size_t)256 * OW * 2, (size_t)256 * 1536 * 2, ncapd};
                EpiBranch E{(const bf16*)(F.ws + WS_SG), (bf16*)(F.ws + WS_MERGED)};
                for (int rep_ = 0; rep_ < 1 + DBL(7); ++rep_) { pg8::gemm_phase<EpiBranch, DenseOrder, true, true>(F.lds + RING_OFF, pg8::Gemm{OW, 1536, 1536}, S, E); }
                if (ntaild) { DenseOrder S0 = S; S0.ncap = 1 << 30; DenseTail T{S0, ntaild}; EpiBranchT<1> E1{(const bf16*)(F.ws + WS_SG), (bf16*)(F.ws + WS_MERGED)};
                    pg8::gemm_phase<EpiBranchT<1>, DenseTail, true, true>(F.lds + RING_OFF, pg8::Gemm{OW, 1536, 1536}, T, E1); }
                SEAM(); } ++ph;
            if (PHM(8) && ON()) {
                DenseOrder S{nMrows, 4, nMrows * 4, F.G, (int)blockIdx.x, skipctx, (const char*)(F.ws + WS_MERGED), (const char*)(F.ws + WS_WOUT + l * WOUT_L), (size_t)256 * MGP * 2, (size_t)256 * 1024 * 2, ncapd};
                EpiWout E{(bf16*)(F.ws + WS_Y)};
                for (int rep_ = 0; rep_ < 1 + DBL(8); ++rep_) { pg8::gemm_phase<EpiWout, DenseOrder, true, true>(F.lds + RING_OFF, pg8::Gemm{MGP, 1024, 1024}, S, E); }
                if (ntaild) { DenseOrder S0 = S; S0.ncap = 1 << 30; DenseTail T{S0, ntaild}; EpiWoutT<1> E1{(bf16*)(F.ws + WS_Y)};
                    pg8::gemm_phase<EpiWoutT<1>, DenseTail, true, true>(F.lds + RING_OFF, pg8::Gemm{MGP, 1024, 1024}, T, E1); }
                SEAM(); } ++ph;
            if (PHM(9) && ON()) { phase_norm2_route(F, A, l, g); if (DBL(9)) phase_norm2_route(F, A, l, g, F.G == 12345); SEAM(); } ++ph;
            if (PHM(11) && ON()) {
                LAS int* eoff = (LAS int*)(F.lds + LDSX_OFF); LAS int* tile_e = eoff + 64; moe_tables(F, A, l, g, eoff, tile_e);
                MoeOrder S{eoff[32] / 256, 2, F.G, (int)blockIdx.x, tile_e, eoff, F.ctl + CW_ECNT + 64 * (l * 2 + g), (const int*)(F.ws + WS_LIST), (const char*)(F.ws + WS_H), (size_t)0, (const char*)(F.ws + WS_WGU + l * WGU_L), (size_t)512 * 1024 * 2, (size_t)256 * 1024 * 2};
                EpiMoe1 E{(bf16*)(F.ws + WS_ACT)};
                for (int rep_ = 0; rep_ < 1 + DBL(11); ++rep_) { pg8::gemm_phase<EpiMoe1, MoeOrder, true, true, true>(F.lds + RING_OFF, pg8::Gemm{1024, 1024, 1024}, S, E); }
                SEAM(); } ++ph;
            if (PHM(12) && ON()) {
                LAS int* eoff = (LAS int*)(F.lds + LDSX_OFF); LAS int* tile_e = eoff + 64; if (MK_PER_PHASE) moe_tables(F, A, l, g, eoff, tile_e);
                MoeOrder S{eoff[32] / 256, 4, F.G, (int)blockIdx.x, tile_e, eoff, F.ctl + CW_ECNT + 64 * (l * 2 + g), (const int*)nullptr, (const char*)(F.ws + WS_ACT), (size_t)256 * 256 * 2, (const char*)(F.ws + WS_WDN + l * WDN_L), (size_t)1024 * 256 * 2, (size_t)256 * 256 * 2};
                EpiMoe2 E{(bf16*)(F.ws + WS_YS)};
                for (int rep_ = 0; rep_ < 1 + DBL(12); ++rep_) { pg8::gemm_phase<EpiMoe2, MoeOrder, true, true>(F.lds + RING_OFF, pg8::Gemm{256, 256, 256}, S, E); }
                SEAM(); } ++ph;
            if (PHM(13) && ON()) { phase_moe_combine(F, A, l, g, true, l + 1 < DEPTH); if (DBL(13) && l == 0) phase_moe_combine(F, A, l, g, true, true);
                if (l == DEPTH - 1 && g + 1 < NGRP) { phase_norm1(F, A, 0, g + 1); if (DBL(1)) phase_norm1(F, A, 0, g + 1); }
                SEAM(); } ++ph;
        }
    }
#undef SEAM
#undef ON
}

extern "C" void kernel_launch(void* const* d_in, const int* in_sizes, int n_in, void* d_out, int out_size, void* d_ws, size_t ws_size, hipStream_t stream) {
    static int grid = 0;
    if (grid == 0) {
        if (n_in != 21 || out_size != NB * NLAT * DM || ws_size < WS_END) { fprintf(stderr, "kernel_launch: unexpected shapes (n_in %d, out %d, ws %zu)\n", n_in, out_size, ws_size); grid = -1; return; }
        int dev = 0, cus = 0, per_cu = 0;
        if (hipGetDevice(&dev) != hipSuccess || hipDeviceGetAttribute(&cus, hipDeviceAttributeMultiprocessorCount, dev) != hipSuccess) { grid = -1; return; }
        if (hipFuncSetAttribute((const void*)fwd_kernel, hipFuncAttributeMaxDynamicSharedMemorySize, LDS_BYTES) != hipSuccess) { fprintf(stderr, "kernel_launch: hipFuncSetAttribute failed\n"); grid = -1; return; }
        if (hipOccupancyMaxActiveBlocksPerMultiprocessor(&per_cu, (const void*)fwd_kernel, 512, LDS_BYTES) != hipSuccess || per_cu < 1) fprintf(stderr, "kernel_launch: occupancy query reports %d\n", per_cu);
        (void)hipGetLastError();
        grid = cus;
    }
    if (grid < 0) return;
    (void)in_sizes;
    if (hipMemsetAsync((char*)d_ws + WS_CTL, 0, CTL_ZERO_BYTES, stream) != hipSuccess) return;
    Args a{};
    for (int i = 0; i < 21; ++i) a.in[i] = (const float*)d_in[i];
    a.out = (float*)d_out; a.ws = (unsigned char*)d_ws;
#if MK_PER_PHASE
    for (int p = 0; p < NPHASE; ++p) { a.ph_lo = p; a.ph_hi = p + 1; hipLaunchKernelGGL(fwd_kernel, dim3(grid), dim3(512), LDS_BYTES, stream, a); }
#else
    a.ph_lo = 0; a.ph_hi = NPHASE;
    hipLaunchKernelGGL(fwd_kernel, dim3(grid), dim3(512), LDS_BYTES, stream, a);
#endif
}
```
